# Optimizing an MI355X kernel written in HIP

```python
import math
import jax, jax.numpy as jnp
from jax import lax
import numpy as np

D_MODEL = 1024
BATCH = 2
SEQ = 8192
DEPTH = 4

A_HEADS = 4
A_QK_DIM = 64
A_V_DIM = 2 * A_QK_DIM
B_Q_HEADS = 8
B_KV_HEADS = 2
B_HEAD_DIM = 64
WINDOW = 128
BAND_BLOCK = 128
C_HEADS = 4
C_Q_RANK = 384
C_KV_RANK = 256
C_NOPE_DIM = 128
C_ROPE_DIM = 64
C_V_DIM = 128
ROPE_THETA = 10000.0
Q_BLOCK = 128
MIX_WIDTH = 512
N_BRANCH = 3
D_FF = 2816
EPS = 1e-6
NEG_INF = -1e30

A_QK_COLS = A_HEADS * 2 * A_QK_DIM
A_V_COLS = A_HEADS * A_V_DIM
B_Q_COLS = B_Q_HEADS * B_HEAD_DIM
B_KV_COLS = B_KV_HEADS * B_HEAD_DIM
IN_SPLIT_SIZES = (A_QK_COLS, A_QK_COLS, A_V_COLS, B_Q_COLS, B_KV_COLS, B_KV_COLS, C_Q_RANK, C_KV_RANK, C_ROPE_DIM)
IN_COLS = sum(IN_SPLIT_SIZES)

kernel_name = "hybrid_diff_window_mla_macaron"


def rms_norm(x, g):
    x32 = x.astype(jnp.float32)
    y = x32 * lax.rsqrt(jnp.mean(x32 * x32, axis=-1, keepdims=True) + EPS) * g.astype(jnp.float32)
    return y.astype(x.dtype)


def swiglu(h, w13, w2):
    a, g = jnp.split(h @ w13, 2, axis=-1)
    return (jax.nn.silu(a) * g) @ w2


def alibi_slopes(n):
    return 2.0 ** (-8.0 * jnp.arange(1, n + 1, dtype=jnp.float32) / n)


def rope(x, cos, sin):
    x1, x2 = jnp.split(x, 2, axis=-1)
    c = cos[None, :, None, :].astype(x.dtype)
    s = sin[None, :, None, :].astype(x.dtype)
    return jnp.concatenate([x1 * c - x2 * s, x1 * s + x2 * c], axis=-1)


def _split_cols(z):
    outs, off = [], 0
    for size in IN_SPLIT_SIZES:
        outs.append(z[..., off:off + size])
        off += size
    return outs


def _query_blocks(t):
    b, s = t.shape[:2]
    return jnp.moveaxis(t.reshape((b, s // Q_BLOCK, Q_BLOCK) + t.shape[2:]), 1, 0)


def _from_blocks(t):
    t = jnp.moveaxis(t, 0, 1)
    return t.reshape((t.shape[0], t.shape[1] * t.shape[2]) + t.shape[3:])


def diff_attention(q, k, v, lam, lam_init, subln_g, slopes):
    b, s_len = q.shape[:2]
    scale = A_QK_DIM ** -0.5
    key_pos = jnp.arange(s_len, dtype=jnp.float32)

    def block(args):
        qb, start = args
        sc = jnp.einsum('bqhmd,bkhmd->bhmqk', qb, k).astype(jnp.float32) * scale
        qpos = start + jnp.arange(Q_BLOCK, dtype=jnp.float32)
        dist = jnp.abs(qpos[:, None] - key_pos[None, :])
        sc = sc - slopes[None, :, None, None, None] * dist
        p = jax.nn.softmax(sc, axis=-1).astype(v.dtype)
        o = jnp.einsum('bhmqk,bkhe->bqhme', p, v)
        return (o[..., 0, :] - lam * o[..., 1, :]).astype(v.dtype)

    starts = jnp.arange(s_len // Q_BLOCK, dtype=jnp.float32) * Q_BLOCK
    o = _from_blocks(lax.map(block, (_query_blocks(q), starts)))
    o = rms_norm(o, subln_g) * (1.0 - lam_init)
    return o.reshape(b, s_len, A_HEADS * A_V_DIM)


def window_gqa(q, k, v, sinks, slopes):
    b, s_len = q.shape[:2]
    nb = s_len // BAND_BLOCK
    g = B_Q_HEADS // B_KV_HEADS
    qb = q.reshape(b, nb, BAND_BLOCK, B_KV_HEADS, g, B_HEAD_DIM)

    def band(t):
        tp = jnp.pad(t, ((0, 0), (BAND_BLOCK, BAND_BLOCK), (0, 0), (0, 0)))
        tp = tp.reshape(b, nb + 2, BAND_BLOCK, B_KV_HEADS, B_HEAD_DIM)
        return jnp.concatenate([tp[:, :-2], tp[:, 1:-1], tp[:, 2:]], axis=2)

    kb, vb = band(k), band(v)
    sc = jnp.einsum('bnqhgd,bnkhd->bnhgqk', qb, kb).astype(jnp.float32) * (B_HEAD_DIM ** -0.5)
    qi = jnp.arange(BAND_BLOCK)
    kj = jnp.arange(3 * BAND_BLOCK) - BAND_BLOCK
    rel = kj[None, :] - qi[:, None]
    kpos = jnp.arange(nb)[:, None] * BAND_BLOCK + kj[None, :]
    valid = (jnp.abs(rel) <= WINDOW)[None] & ((kpos >= 0) & (kpos < s_len))[:, None, :]
    bias = -slopes.reshape(B_KV_HEADS, g)[:, :, None, None] * jnp.abs(rel).astype(jnp.float32)
    sc = jnp.where(valid[None, :, None, None], sc + bias, NEG_INF)
    sink = jnp.broadcast_to(sinks.astype(jnp.float32).reshape(B_KV_HEADS, g)[None, None, :, :, None, None], sc.shape[:-1] + (1,))
    p = jax.nn.softmax(jnp.concatenate([sc, sink], axis=-1), axis=-1)[..., :-1].astype(v.dtype)
    o = jnp.einsum('bnhgqk,bnkhd->bnqhgd', p, vb)
    return o.reshape(b, s_len, B_Q_HEADS * B_HEAD_DIM)


def mla(c_q, c_kv, k_rope, q_norm_g, w_uq, kv_norm_g, w_ukv, cos, sin):
    b, s_len = c_q.shape[:2]
    q = jnp.einsum('bsr,rhe->bshe', rms_norm(c_q, q_norm_g), w_uq)
    q_nope, q_pe = q[..., :C_NOPE_DIM], rope(q[..., C_NOPE_DIM:], cos, sin)
    kv = jnp.einsum('bsr,rhe->bshe', rms_norm(c_kv, kv_norm_g), w_ukv)
    k_nope, v = kv[..., :C_NOPE_DIM], kv[..., C_NOPE_DIM:]
    k_pe = rope(k_rope[:, :, None, :], cos, sin)[:, :, 0, :]
    scale = (C_NOPE_DIM + C_ROPE_DIM) ** -0.5

    def block(args):
        qn, qp = args
        sc = (jnp.einsum('bqhd,bkhd->bhqk', qn, k_nope) + jnp.einsum('bqhd,bkd->bhqk', qp, k_pe)).astype(jnp.float32) * scale
        p = jax.nn.softmax(sc, axis=-1).astype(v.dtype)
        return jnp.einsum('bhqk,bkhd->bqhd', p, v)

    o = _from_blocks(lax.map(block, (_query_blocks(q_nope), _query_blocks(q_pe))))
    return o.reshape(b, s_len, C_HEADS * C_V_DIM)


def setup_inputs(seed: int = 0) -> dict:
    key = jax.random.key(seed)
    ks = jax.random.split(key, 24)

    def nrm(k, shape, scale):
        return jax.random.normal(k, shape, jnp.float32) * scale

    def gain(k, shape):
        return 1.0 + 0.05 * jax.random.normal(k, shape, jnp.float32)

    L, D, F = DEPTH, D_MODEL, D_FF
    return {
        "x": nrm(ks[0], (BATCH, SEQ, D), 1.0),
        "ffn1_norm": gain(ks[1], (L, D)),
        "ffn1_w13": nrm(ks[2], (L, D, 2 * F), D ** -0.5),
        "ffn1_w2": nrm(ks[3], (L, F, D), F ** -0.5),
        "mix_norm": gain(ks[4], (L, D)),
        "w_in": nrm(ks[5], (L, D, IN_COLS), D ** -0.5),
        "w_gate": nrm(ks[6], (L, D, N_BRANCH * D), D ** -0.5),
        "b_gate": nrm(ks[7], (L, N_BRANCH * D), 0.01),
        "a_lambda": nrm(ks[8], (L, 4, A_QK_DIM), 0.1),
        "a_subln": gain(ks[9], (L, A_V_DIM)),
        "b_sinks": nrm(ks[10], (L, B_Q_HEADS), 0.5),
        "c_q_norm": gain(ks[11], (L, C_Q_RANK)),
        "c_w_uq": nrm(ks[12], (L, C_Q_RANK, C_HEADS, C_NOPE_DIM + C_ROPE_DIM), C_Q_RANK ** -0.5),
        "c_kv_norm": gain(ks[13], (L, C_KV_RANK)),
        "c_w_ukv": nrm(ks[14], (L, C_KV_RANK, C_HEADS, C_NOPE_DIM + C_V_DIM), C_KV_RANK ** -0.5),
        "w_branch": nrm(ks[15], (L, N_BRANCH, MIX_WIDTH, D), MIX_WIDTH ** -0.5),
        "w_out": nrm(ks[16], (L, D, D), D ** -0.5),
        "ffn2_norm": gain(ks[17], (L, D)),
        "ffn2_w13": nrm(ks[18], (L, D, 2 * F), D ** -0.5),
        "ffn2_w2": nrm(ks[19], (L, F, D), F ** -0.5),
        "final_norm": gain(ks[20], (D,)),
    }


def reference(x, ffn1_norm, ffn1_w13, ffn1_w2, mix_norm, w_in, w_gate, b_gate, a_lambda, a_subln, b_sinks, c_q_norm, c_w_uq, c_kv_norm, c_w_ukv, w_branch, w_out, ffn2_norm, ffn2_w13, ffn2_w2, final_norm):
    b, s_len, _ = x.shape
    pos = jnp.arange(s_len, dtype=jnp.float32)
    inv_freq = ROPE_THETA ** (-jnp.arange(0, C_ROPE_DIM, 2, dtype=jnp.float32) / C_ROPE_DIM)
    ang = pos[:, None] * inv_freq[None, :]
    cos, sin = jnp.cos(ang), jnp.sin(ang)
    slopes_a = alibi_slopes(A_HEADS)
    slopes_b = alibi_slopes(B_Q_HEADS)

    for l in range(DEPTH):
        x = x + 0.5 * swiglu(rms_norm(x, ffn1_norm[l]), ffn1_w13[l], ffn1_w2[l])

        h = rms_norm(x, mix_norm[l])
        aq, ak, av, bq, bk, bv, cq, ckv, ckr = _split_cols(h @ w_in[l])

        lam_init = 0.8 - 0.6 * math.exp(-0.3 * l)
        lp = a_lambda[l].astype(jnp.float32)
        lam = jnp.exp(jnp.sum(lp[0] * lp[1])) - jnp.exp(jnp.sum(lp[2] * lp[3])) + lam_init
        oa = diff_attention(aq.reshape(b, s_len, A_HEADS, 2, A_QK_DIM),
                            ak.reshape(b, s_len, A_HEADS, 2, A_QK_DIM),
                            av.reshape(b, s_len, A_HEADS, A_V_DIM),
                            lam, lam_init, a_subln[l], slopes_a)
        ob = window_gqa(bq.reshape(b, s_len, B_Q_HEADS, B_HEAD_DIM),
                        bk.reshape(b, s_len, B_KV_HEADS, B_HEAD_DIM),
                        bv.reshape(b, s_len, B_KV_HEADS, B_HEAD_DIM),
                        b_sinks[l], slopes_b)
        oc = mla(cq, ckv, ckr, c_q_norm[l], c_w_uq[l], c_kv_norm[l], c_w_ukv[l], cos, sin)

        branches = jnp.stack([oa, ob, oc], axis=2)
        proj = jnp.einsum('bsnw,nwd->bsnd', branches, w_branch[l])
        gates = jax.nn.sigmoid(h @ w_gate[l] + b_gate[l]).reshape(b, s_len, N_BRANCH, D_MODEL)
        x = x + jnp.sum(gates * proj, axis=2) @ w_out[l]

        x = x + 0.5 * swiglu(rms_norm(x, ffn2_norm[l]), ffn2_w13[l], ffn2_w2[l])

    return rms_norm(x, final_norm)
```

```cpp
#include <hip/hip_runtime.h>
#include <hip/hip_cooperative_groups.h>
#include <cstdio>
#include <cstdint>
namespace cg = cooperative_groups;

#define LAS __attribute__((address_space(3)))
#define GAS __attribute__((address_space(1)))
typedef unsigned short bf16_t;
typedef short bf16x8 __attribute__((ext_vector_type(8)));
typedef short s16x4 __attribute__((ext_vector_type(4)));
typedef float f32x4 __attribute__((ext_vector_type(4)));
typedef float f32x16 __attribute__((ext_vector_type(16)));
typedef unsigned u32x4 __attribute__((ext_vector_type(4)));
typedef unsigned u32x2 __attribute__((ext_vector_type(2)));

constexpr int M_TOK = 16384, SEQ = 8192, DM = 1024, FF = 2816, DEPTH = 4;
constexpr int ZC = 3072;
constexpr int Z_AQ = 0, Z_AK = 512, Z_AV = 1024, Z_BQ = 1536, Z_BK = 2048, Z_BV = 2176, Z_CQ = 2304, Z_CKV = 2688, Z_CKR = 2944;
constexpr float EPS = 1e-6f;
constexpr float LOG2E = 1.4426950408889634f;

constexpr size_t MiB = 1u << 20;
constexpr size_t WS_W13A = 0, WS_W2A = 11 * MiB, WS_W13B = 33 * MiB / 2, WS_W2B = 55 * MiB / 2, WS_WIG = 33 * MiB, WS_WUQ = 45 * MiB,
                 WS_WUKV = 46 * MiB, WS_WB = 47 * MiB, WS_WO = 50 * MiB;
constexpr size_t WS_BAR = 54 * MiB, BAR_BYTES = 65536;
constexpr size_t WS_XB = 56 * MiB, WS_SSQ = 88 * MiB, WS_SSQZ = 89 * MiB, WS_ROPE = 91 * MiB;
constexpr size_t WS_R0 = 96 * MiB;
constexpr size_t WS_G = 192 * MiB, WS_QC = 288 * MiB, WS_KC = 312 * MiB, WS_VC = 336 * MiB, WS_O3 = 352 * MiB, WS_SCR = 400 * MiB, WS_END = 432 * MiB;

typedef float f32x2_t __attribute__((ext_vector_type(2)));
typedef __bf16 bf16x2_t __attribute__((ext_vector_type(2)));
__device__ __forceinline__ unsigned cvt_pk_bf16(float lo, float hi) { f32x2_t v = {lo, hi}; bf16x2_t b = __builtin_convertvector(v, bf16x2_t); return __builtin_bit_cast(unsigned, b); }
__device__ __forceinline__ int lane_id() { int r; asm volatile("v_mbcnt_lo_u32_b32 %0, -1, 0\n\tv_mbcnt_hi_u32_b32 %0, -1, %0" : "=v"(r)); return r; }
__device__ __forceinline__ float uni(float x) { return __int_as_float(__builtin_amdgcn_readfirstlane(__float_as_int(x))); }
__device__ __forceinline__ float bf16_lo(unsigned w) { return __uint_as_float(w << 16); }
__device__ __forceinline__ float bf16_hi(unsigned w) { return __uint_as_float(w & 0xffff0000u); }
__device__ __forceinline__ float fast_rsq(float x) { return __builtin_amdgcn_rsqf(x); }
__device__ __forceinline__ float sum4(f32x4 a) { return (a.x + a.y) + (a.z + a.w); }
__device__ __forceinline__ float dot4(f32x4 a) { return (a.x * a.x + a.y * a.y) + (a.z * a.z + a.w * a.w); }

namespace pg8 {
constexpr int BM = 256, BK = 64, HALF = 128, HTB = HALF * BK * 2, STAGE_BYTES = 8 * HTB, NXCD = 8, WGM = 8;
__host__ __device__ __forceinline__ int lds_byte(int r, int c) { const int st = (r >> 4) * 2 + (c >> 5), rr = r & 15, cc = c & 31, ob = rr * 64 + cc * 2; return st * 1024 + (ob ^ (((ob >> 9) & 1) << 5)); }
__host__ __device__ __forceinline__ void stage_rc(int b, int& R, int& C) { const int st = b / 1024, sb = b % 1024, swz = sb ^ (((sb >> 9) & 1) << 5); R = (st >> 1) * 16 + swz / 64; C = (st & 1) * 32 + (swz % 64) / 2; }
__host__ __device__ __forceinline__ int perm32(int rho) { const int n = rho >> 4, i = rho & 15; return 8 * (i >> 2) + 4 * n + (i & 3); }

struct Unit { int pm, pn; };
struct Gemm { const bf16_t* A; const bf16_t* Bt; int M, N, K, lda, a_pn_shift, a_pn_stride; };

struct StaticOrder {
    int nM, nN, nwg, G, c;
    __device__ void init(int M, int N, int G_, int c_) { nM = M / BM; nN = N / BM; nwg = nM * nN; G = G_; c = c_; }
    __device__ bool next(int i, Unit& u) const {
        const long L = (long)i * G + c; if (L >= nwg) return false;
        int wgid = (int)L; { const int q = nwg / NXCD, r = nwg % NXCD, xcd = wgid % NXCD, off = wgid / NXCD; wgid = (xcd < r ? xcd * (q + 1) : r * (q + 1) + (xcd - r) * q) + off; }
        const int nig = WGM * nN, gid = wgid / nig, fm = gid * WGM, gsz = (nM - fm) < WGM ? (nM - fm) : WGM;
        u.pm = fm + ((wgid % nig) % gsz); u.pn = (wgid % nig) / gsz; return true;
    }
};
struct BranchOrder {
    StaticOrder so;
    __device__ void init(int G_, int c_) { so.init(M_TOK, DM, G_, c_); }
    __device__ bool next(int i, Unit& u) const { const int j = i / 3, n = i - 3 * j; Unit b; if (!so.next(j, b)) return false; u.pm = b.pm; u.pn = n * 4 + b.pn; return true; }
};

template <class Epi, class Sched>
__device__ __forceinline__ void gemm_phase(LAS unsigned char* lds, const Gemm g, const Sched& S, const Epi& E, int wave_) {
    int tid = wave_ * 64 + lane_id(); asm volatile("" : "+v"(tid));
    const int wid = __builtin_amdgcn_readfirstlane(tid >> 6), lane = tid & 63, wr = wid >> 2, wc = wid & 3, fr = lane & 15, fq = lane >> 4;
    const int K = g.K, nt = K / BK, lda = g.lda;
    const bf16_t* gA = g.A; const bf16_t* gB = g.Bt; asm volatile("" : "+s"(gA), "+s"(gB));
    unsigned voffA[2], voffB[2];
#pragma unroll
    for (int i = 0; i < 2; ++i) { int R, C; stage_rc(tid * 16 + i * 8192, R, C); const int Rb = Epi::PERM ? ((R & ~31) + perm32(R & 31)) : R;
        voffA[i] = (unsigned)(R * lda + C) * 2u; voffB[i] = (unsigned)(Rb * K + C) * 2u; }
    const size_t kstep = (size_t)(BK * 2);
    const size_t hstepA = (size_t)HALF * lda * 2, hstepB = (size_t)HALF * K * 2;
    const size_t tstepA = 2 * hstepA, tstepB = 2 * hstepB;
    const unsigned ldsw = (unsigned)wid * 1024u;
    const int aoff = lds_byte(wr * 64 + fr, fq * 8), boff = lds_byte(wc * 32 + fr, fq * 8);
#define PG8_SA(b, h) (((b) * 2 + (h)) * HTB)
#define PG8_SB(b, h) ((4 + (b) * 2 + (h)) * HTB)
#define PG8_STAGE(bufoff, gbase, voff) do { _Pragma("unroll") for (int _i = 0; _i < 2; ++_i) \
        __builtin_amdgcn_global_load_lds((const unsigned*)((const char*)(gbase) + (voff)[_i]), (LAS unsigned*)(lds + (bufoff) + ldsw + _i * 8192), 16, 0, 0); } while (0)
#define PG8_LDA(dst, b, h) do { _Pragma("unroll") for (int m = 0; m < 4; ++m) _Pragma("unroll") for (int k = 0; k < 2; ++k) dst[m][k] = *(const LAS bf16x8*)(lds + PG8_SA(b, h) + aoff + m * 2048 + k * 1024); } while (0)
#define PG8_LDB(dst, b, h) do { _Pragma("unroll") for (int n = 0; n < 2; ++n) _Pragma("unroll") for (int k = 0; k < 2; ++k) dst[n][k] = *(const LAS bf16x8*)(lds + PG8_SB(b, h) + boff + n * 2048 + k * 1024); } while (0)
#define PG8_MMA(ai, bj, At, Bt) do { __builtin_amdgcn_s_setprio(1); _Pragma("unroll") for (int m = 0; m < 4; ++m) _Pragma("unroll") for (int n = 0; n < 2; ++n) _Pragma("unroll") for (int k = 0; k < 2; ++k) \
        acc[ai][bj][m][n] = __builtin_amdgcn_mfma_f32_16x16x32_bf16(Bt[n][k], At[m][k], acc[ai][bj][m][n], 0, 0, 0); __builtin_amdgcn_s_setprio(0); } while (0)
#define PG8_WAIT_V(n) asm volatile("s_waitcnt vmcnt(" #n ")" ::: "memory")
#define PG8_WAIT_L(n) asm volatile("s_waitcnt lgkmcnt(" #n ")" ::: "memory")
#define PG8_BAR __builtin_amdgcn_s_barrier()
#define PG8_SCHED __builtin_amdgcn_sched_barrier(0)
#define PG8_APTR(u) ((const char*)gA + (size_t)(u).pm * tstepA + (size_t)((u).pn >> g.a_pn_shift) * (size_t)g.a_pn_stride)
    Unit cur, nxt; int ui = 0;
    if (!S.next(0, cur)) return;
    f32x4 acc[2][2][4][2];
#pragma unroll
    for (int a = 0; a < 2; ++a)
#pragma unroll
        for (int b = 0; b < 2; ++b)
#pragma unroll
            for (int m = 0; m < 4; ++m)
#pragma unroll
                for (int n = 0; n < 2; ++n) acc[a][b][m][n] = (f32x4){0.f, 0.f, 0.f, 0.f};
    bf16x8 At[4][2], B0[2][2], B1[2][2];
    const char* cA = PG8_APTR(cur); const char* cB = (const char*)gB + (size_t)cur.pn * tstepB;
    PG8_STAGE(PG8_SB(0, 0), cB, voffB); PG8_STAGE(PG8_SB(0, 1), cB + hstepB, voffB); PG8_STAGE(PG8_SA(0, 0), cA, voffA); PG8_STAGE(PG8_SA(0, 1), cA + hstepA, voffA);
    if (wr == 1) PG8_BAR;
    PG8_WAIT_V(2); PG8_BAR;
    PG8_STAGE(PG8_SB(1, 0), cB + kstep, voffB); PG8_STAGE(PG8_SA(1, 0), cA + kstep, voffA); PG8_STAGE(PG8_SB(1, 1), cB + hstepB + kstep, voffB);
    PG8_WAIT_V(6); PG8_BAR;
    for (;;) {
        const bool has_next = S.next(ui + 1, nxt);
        const char* nA = has_next ? PG8_APTR(nxt) : cA; const char* nB = has_next ? (const char*)gB + (size_t)nxt.pn * tstepB : cB;
        for (int t = 0; t < nt; t += 2) {
            const bool last = (t == nt - 2);
            const char* a1 = cA + (size_t)(t + 1) * kstep;
            const char* a2 = last ? nA : cA + (size_t)(t + 2) * kstep; const char* b2 = last ? nB : cB + (size_t)(t + 2) * kstep;
            const char* a3 = a2 + kstep; const char* b3 = b2 + kstep;
            PG8_LDB(B0, 0, 0); PG8_LDB(B1, 0, 1); PG8_SCHED; PG8_LDA(At, 0, 0); PG8_STAGE(PG8_SA(1, 1), a1 + hstepA, voffA);
            PG8_WAIT_V(8); PG8_WAIT_L(0); PG8_BAR; PG8_MMA(0, 0, At, B0); PG8_MMA(0, 1, At, B1); PG8_BAR; PG8_SCHED;
            PG8_LDA(At, 0, 1); PG8_STAGE(PG8_SB(0, 0), b2, voffB); PG8_STAGE(PG8_SB(0, 1), b2 + hstepB, voffB); PG8_STAGE(PG8_SA(0, 0), a2, voffA);
            PG8_WAIT_V(8); PG8_WAIT_L(0); PG8_BAR; PG8_MMA(1, 0, At, B0); PG8_MMA(1, 1, At, B1); PG8_BAR; PG8_SCHED;
            PG8_LDB(B0, 1, 0); PG8_LDB(B1, 1, 1); PG8_SCHED; PG8_LDA(At, 1, 0); PG8_STAGE(PG8_SA(0, 1), a2 + hstepA, voffA);
            PG8_WAIT_V(8); PG8_WAIT_L(0); PG8_BAR; PG8_MMA(0, 0, At, B0); PG8_MMA(0, 1, At, B1); PG8_BAR; PG8_SCHED;
            PG8_LDA(At, 1, 1); PG8_STAGE(PG8_SB(1, 0), b3, voffB); PG8_STAGE(PG8_SB(1, 1), b3 + hstepB, voffB); PG8_STAGE(PG8_SA(1, 0), a3, voffA);
            PG8_WAIT_V(8); PG8_WAIT_L(0); PG8_BAR; PG8_MMA(1, 0, At, B0); PG8_MMA(1, 1, At, B1); PG8_BAR; PG8_SCHED;
        }
        if (wr == 0) PG8_BAR;
        E(acc, cur, wr, wc, fr, fq);
        if (!has_next) break;
#pragma unroll
        for (int a = 0; a < 2; ++a)
#pragma unroll
            for (int b = 0; b < 2; ++b)
#pragma unroll
                for (int m = 0; m < 4; ++m)
#pragma unroll
                    for (int n = 0; n < 2; ++n) acc[a][b][m][n] = (f32x4){0.f, 0.f, 0.f, 0.f};
        cur = nxt; cA = nA; cB = nB; ++ui;
        if (wr == 1) PG8_BAR;
    }
    PG8_WAIT_V(0);
    PG8_BAR;
#undef PG8_SA
#undef PG8_SB
#undef PG8_STAGE
#undef PG8_LDA
#undef PG8_LDB
#undef PG8_MMA
#undef PG8_WAIT_V
#undef PG8_WAIT_L
#undef PG8_BAR
#undef PG8_SCHED
#undef PG8_APTR
}
}

typedef f32x4 Acc[2][2][4][2];
__device__ __forceinline__ float rinv_sum(const float* p, int n4, float invn) {
    float s = 0.f;
#pragma unroll
    for (int i = 0; i < 5; ++i) if (i < n4) s += sum4(*(const f32x4*)(p + 4 * i));
    return fast_rsq(s * invn + EPS);
}
__device__ __forceinline__ float silu_mul(float a, float g) { return a * __builtin_amdgcn_rcpf(1.f + __builtin_amdgcn_exp2f(-a * LOG2E)) * g; }
__device__ __forceinline__ float sigmoidf(float a) { return __builtin_amdgcn_rcpf(1.f + __builtin_amdgcn_exp2f(-a * LOG2E)); }
__device__ __forceinline__ u32x4 pack8(f32x4 v0, f32x4 v1) { u32x4 w; w.x = cvt_pk_bf16(v0[0], v0[1]); w.y = cvt_pk_bf16(v0[2], v0[3]); w.z = cvt_pk_bf16(v1[0], v1[1]); w.w = cvt_pk_bf16(v1[2], v1[3]); return w; }

struct EpiSwiGLU {
    static constexpr bool PERM = true;
    bf16_t* H; const float* ssq;
    __device__ __forceinline__ void operator()(const Acc& acc, const pg8::Unit& u, int wr, int wc, int fr, int fq) const {
        const int row0 = u.pm * 256 + wr * 64 + fr, col0 = u.pn * 128 + wc * 32 + 8 * fq;
#pragma unroll
        for (int ai = 0; ai < 2; ++ai)
#pragma unroll
            for (int m = 0; m < 4; ++m) { const int row = row0 + ai * 128 + m * 16; const float r = rinv_sum(ssq + (size_t)row * 16, 4, 1.f / DM);
                f32x4 h0, h1;
#pragma unroll
                for (int j = 0; j < 4; ++j) { h0[j] = silu_mul(acc[ai][0][m][0][j] * r, acc[ai][1][m][0][j] * r); h1[j] = silu_mul(acc[ai][0][m][1][j] * r, acc[ai][1][m][1][j] * r); }
                *(u32x4*)(H + (size_t)row * FF + col0) = pack8(h0, h1); asm volatile("" ::: "memory"); }
    }
};
struct EpiResid {
    static constexpr bool PERM = false;
    float* x; bf16_t* xb; float* ssq; float coef;
    __device__ __forceinline__ void operator()(const Acc& acc, const pg8::Unit& u, int wr, int wc, int fr, int fq) const {
        const int row0 = u.pm * 256 + wr * 64 + fr, col0 = u.pn * 256 + wc * 32 + 4 * fq;
#pragma unroll
        for (int ai = 0; ai < 2; ++ai) {
            f32x4 xv[4][2][2];
#pragma unroll
            for (int m = 0; m < 4; ++m)
#pragma unroll
                for (int bj = 0; bj < 2; ++bj)
#pragma unroll
                    for (int n = 0; n < 2; ++n) xv[m][bj][n] = *(const f32x4*)(x + (size_t)(row0 + ai * 128 + m * 16) * DM + col0 + bj * 128 + n * 16);
#pragma unroll
            for (int m = 0; m < 4; ++m) { const int row = row0 + ai * 128 + m * 16; float s = 0.f;
#pragma unroll
                for (int bj = 0; bj < 2; ++bj)
#pragma unroll
                    for (int n = 0; n < 2; ++n) { const size_t off = (size_t)row * DM + col0 + bj * 128 + n * 16;
                        const f32x4 v = xv[m][bj][n] + acc[ai][bj][m][n] * coef;
                        *(f32x4*)(x + off) = v; s += dot4(v);
                        u32x2 w; w.x = cvt_pk_bf16(v[0], v[1]); w.y = cvt_pk_bf16(v[2], v[3]); *(u32x2*)(xb + off) = w; }
                s += __shfl_xor(s, 16); s += __shfl_xor(s, 32);
                if (fq == 0) ssq[(size_t)row * 16 + u.pn * 4 + wc] = s; }
            asm volatile("" ::: "memory"); }
    }
};
struct EpiInProj {
    static constexpr bool PERM = true;
    bf16_t* Z; bf16_t* Gt; bf16_t* KC; const float* ssq; float* ssqz; const float* bgate; const float* ropeC; const float* ropeS;
    __device__ __forceinline__ void operator()(const Acc& acc, const pg8::Unit& u, int wr, int wc, int fr, int fq) const {
        const int row0 = u.pm * 256 + wr * 64 + fr, cw = wc * 32 + 8 * fq;
        if (u.pn < 12) {
#pragma unroll
            for (int ai = 0; ai < 2; ++ai)
#pragma unroll
                for (int m = 0; m < 4; ++m) { const int row = row0 + ai * 128 + m * 16; const float r = rinv_sum(ssq + (size_t)row * 16, 4, 1.f / DM);
#pragma unroll
                    for (int bj = 0; bj < 2; ++bj) { f32x4 v0 = acc[ai][bj][m][0] * r, v1 = acc[ai][bj][m][1] * r;
                        if (u.pn >= 9) { float s = dot4(v0) + dot4(v1); s += __shfl_xor(s, 16); s += __shfl_xor(s, 32);
                            if (fq == 0) ssqz[(size_t)row * 24 + (u.pn - 9) * 8 + bj * 4 + wc] = s; }
                        if (u.pn == 11 && bj == 1 && wc < 2) {
                            const int pos = row & (SEQ - 1), j0 = 16 * wc + 4 * fq;
                            const f32x4 c = *(const f32x4*)(ropeC + pos * 32 + j0), s = *(const f32x4*)(ropeS + pos * 32 + j0);
                            f32x4 o0, o1;
                            o0[0] = v0[0] * c[0] - v0[1] * s[0]; o0[1] = v0[0] * s[0] + v0[1] * c[0]; o0[2] = v0[2] * c[1] - v0[3] * s[1]; o0[3] = v0[2] * s[1] + v0[3] * c[1];
                            o1[0] = v1[0] * c[2] - v1[1] * s[2]; o1[1] = v1[0] * s[2] + v1[1] * c[2]; o1[2] = v1[2] * c[3] - v1[3] * s[3]; o1[3] = v1[2] * s[3] + v1[3] * c[3];
                            const u32x4 w = pack8(o0, o1);
#pragma unroll
                            for (int h = 0; h < 4; ++h) *(u32x4*)(KC + (size_t)row * 768 + h * 192 + 128 + cw) = w;
                        }
                        *(u32x4*)(Z + (size_t)row * ZC + u.pn * 256 + bj * 128 + cw) = pack8(v0, v1); } asm volatile("" ::: "memory"); }
        } else {
            const int gc0 = (u.pn - 12) * 256 + cw;
#pragma unroll
            for (int bj = 0; bj < 2; ++bj) { const f32x4 b0 = *(const f32x4*)(bgate + gc0 + bj * 128), b1 = *(const f32x4*)(bgate + gc0 + bj * 128 + 4);
#pragma unroll
                for (int ai = 0; ai < 2; ++ai)
#pragma unroll
                    for (int m = 0; m < 4; ++m) { const int row = row0 + ai * 128 + m * 16; const float r = rinv_sum(ssq + (size_t)row * 16, 4, 1.f / DM);
                        f32x4 v0 = acc[ai][bj][m][0] * r + b0, v1 = acc[ai][bj][m][1] * r + b1;
#pragma unroll
                        for (int j = 0; j < 4; ++j) { v0[j] = sigmoidf(v0[j]); v1[j] = sigmoidf(v1[j]); }
                        *(u32x4*)(Gt + (size_t)row * 3072 + gc0 + bj * 128) = pack8(v0, v1); asm volatile("" ::: "memory"); } }
        }
    }
};
struct EpiUQ {
    static constexpr bool PERM = true;
    bf16_t* QC; const float* ssqz; const float* ropeC; const float* ropeS;
    __device__ __forceinline__ void operator()(const Acc& acc, const pg8::Unit& u, int wr, int wc, int fr, int fq) const {
        const int row0 = u.pm * 256 + wr * 64 + fr;
#pragma unroll
        for (int ai = 0; ai < 2; ++ai)
#pragma unroll
            for (int m = 0; m < 4; ++m) { const int row = row0 + ai * 128 + m * 16; const float r = rinv_sum(ssqz + (size_t)row * 24, 3, 1.f / 384.f);
#pragma unroll
                for (int bj = 0; bj < 2; ++bj) { const int c = u.pn * 256 + bj * 128 + wc * 32 + 8 * fq; const int e = c % 192;
                    f32x4 v0 = acc[ai][bj][m][0] * r, v1 = acc[ai][bj][m][1] * r;
                    if (e >= 128) { const int pos = row & (SEQ - 1), j0 = (e - 128) >> 1;
                        const f32x4 cc = *(const f32x4*)(ropeC + pos * 32 + j0), s = *(const f32x4*)(ropeS + pos * 32 + j0);
                        f32x4 o0, o1;
                        o0[0] = v0[0] * cc[0] - v0[1] * s[0]; o0[1] = v0[0] * s[0] + v0[1] * cc[0]; o0[2] = v0[2] * cc[1] - v0[3] * s[1]; o0[3] = v0[2] * s[1] + v0[3] * cc[1];
                        o1[0] = v1[0] * cc[2] - v1[1] * s[2]; o1[1] = v1[0] * s[2] + v1[1] * cc[2]; o1[2] = v1[2] * cc[3] - v1[3] * s[3]; o1[3] = v1[2] * s[3] + v1[3] * cc[3];
                        v0 = o0; v1 = o1; }
                    *(u32x4*)(QC + (size_t)row * 768 + c) = pack8(v0, v1); } asm volatile("" ::: "memory"); }
    }
};
struct EpiUKV {
    static constexpr bool PERM = true;
    bf16_t* KC; bf16_t* VC; const float* ssqz;
    __device__ __forceinline__ void operator()(const Acc& acc, const pg8::Unit& u, int wr, int wc, int fr, int fq) const {
        const int row0 = u.pm * 256 + wr * 64 + fr, cw = wc * 32 + 8 * fq, h = u.pn;
#pragma unroll
        for (int ai = 0; ai < 2; ++ai)
#pragma unroll
            for (int m = 0; m < 4; ++m) { const int row = row0 + ai * 128 + m * 16; const float r = rinv_sum(ssqz + (size_t)row * 24 + 12, 2, 1.f / 256.f);
                *(u32x4*)(KC + (size_t)row * 768 + h * 192 + cw) = pack8(acc[ai][0][m][0] * r, acc[ai][0][m][1] * r);
                *(u32x4*)(VC + (size_t)row * 512 + h * 128 + cw) = pack8(acc[ai][1][m][0] * r, acc[ai][1][m][1] * r); asm volatile("" ::: "memory"); }
    }
};
struct EpiGateAcc {
    static constexpr bool PERM = false;
    const bf16_t* Gt; float* mg; bf16_t* MB;
    __device__ __forceinline__ void operator()(const Acc& acc, const pg8::Unit& u, int wr, int wc, int fr, int fq) const {
        const int nb = u.pn >> 2, pno = u.pn & 3;
        const int row0 = u.pm * 256 + wr * 64 + fr, col0 = pno * 256 + wc * 32 + 4 * fq;
#pragma unroll
        for (int ai = 0; ai < 2; ++ai)
#pragma unroll
            for (int m = 0; m < 4; ++m) { const int row = row0 + ai * 128 + m * 16;
#pragma unroll
                for (int bj = 0; bj < 2; ++bj)
#pragma unroll
                    for (int n = 0; n < 2; ++n) { const int col = col0 + bj * 128 + n * 16; const size_t off = (size_t)row * DM + col;
                        const u32x2 gw = *(const u32x2*)(Gt + (size_t)row * 3072 + nb * 1024 + col);
                        f32x4 v = acc[ai][bj][m][n]; v[0] *= bf16_lo(gw.x); v[1] *= bf16_hi(gw.x); v[2] *= bf16_lo(gw.y); v[3] *= bf16_hi(gw.y);
                        if (nb > 0) v += *(const f32x4*)(mg + off);
                        if (nb < 2) *(f32x4*)(mg + off) = v;
                        else { u32x2 w; w.x = cvt_pk_bf16(v[0], v[1]); w.y = cvt_pk_bf16(v[2], v[3]); *(u32x2*)(MB + off) = w; } } asm volatile("" ::: "memory"); }
    }
};

#ifdef A_SIMPLE
#define ATT_A_BODY att::attn_body_simple<64, 128, 1, ZC, ZC, ZC>
#else
#define ATT_A_BODY att::attn_body<64, 128, 1, 2, ZC, ZC, ZC>
#endif
namespace att {
#define SBAR() __builtin_amdgcn_sched_barrier(0)
__device__ __forceinline__ int crow(int r, int hi) { return (r & 3) + 8 * (r >> 2) + 4 * hi; }
template <int DQK> __device__ __forceinline__ int kswz(int row, int colB) { return row * (DQK * 2) + (colB ^ (((row >> 1) & 7) << 4)); }
template <int DV> __device__ __forceinline__ int v_st(int k, int c) { constexpr int NCB = DV / 32; const int kk = (k & ~0xC) | ((k & 4) << 1) | ((k & 8) >> 1); return ((kk >> 3) * NCB + (c >> 5)) * 512 + ((kk & 7) * 32 + (c & 31)) * 2; }
__device__ __forceinline__ int v_rd_base(int lane) { return ((lane & 3) << 3) | (((lane >> 2) & 3) << 6) | (((lane >> 4) & 1) << 5) | (((lane >> 5) & 1) << 8); }
template <int DV> constexpr int v_rd_off(int d0, int ks, int half) { return d0 * 512 + ks * (2 * (DV / 32) * 512) + half * ((DV / 32) * 512); }
template <int OFF> __device__ __forceinline__ s16x4 tr_read(int vb) { s16x4 r; asm volatile("ds_read_b64_tr_b16 %0, %1 offset:%2" : "=&v"(r) : "v"(vb), "i"(OFF) : "memory"); return r; }

__device__ __forceinline__ void partialSM(f32x16& p0, f32x16& p1, float& m_reg, float& mn, float& alpha, float C, float thr) {
    float pmax = p0[0];
#pragma unroll
    for (int r = 1; r < 16; ++r) pmax = fmaxf(pmax, p0[r]);
#pragma unroll
    for (int r = 0; r < 16; ++r) pmax = fmaxf(pmax, p1[r]);
    { auto rr = __builtin_amdgcn_permlane32_swap(__float_as_uint(pmax), __float_as_uint(pmax), false, false); pmax = fmaxf(__uint_as_float(rr[0]), __uint_as_float(rr[1])); }
    if (__builtin_expect(__all(pmax - m_reg <= thr), 1)) { mn = m_reg; alpha = 1.f; }
    else { mn = fmaxf(m_reg, pmax); alpha = __builtin_amdgcn_exp2f((m_reg - mn) * C); m_reg = mn; }
    const float mnC = mn < -1e29f ? 0.f : -mn * C;
#pragma unroll
    for (int r = 0; r < 16; ++r) p0[r] = fmaf(p0[r], C, mnC);
#pragma unroll
    for (int r = 0; r < 16; ++r) p1[r] = fmaf(p1[r], C, mnC);
#pragma unroll
    for (int r = 0; r < 16; ++r) p0[r] = __builtin_amdgcn_exp2f(p0[r]);
}
__device__ __forceinline__ void finishSM(f32x16& p0, f32x16& p1, float alpha, float& l_reg, bf16x8& pa0, bf16x8& pa1, bf16x8& pa2, bf16x8& pa3) {
#pragma unroll
    for (int r = 0; r < 16; ++r) p1[r] = __builtin_amdgcn_exp2f(p1[r]);
    float ps = 0;
#pragma unroll
    for (int r = 0; r < 16; ++r) ps += p0[r];
#pragma unroll
    for (int r = 0; r < 16; ++r) ps += p1[r];
    { auto rr = __builtin_amdgcn_permlane32_swap(__float_as_uint(ps), __float_as_uint(ps), false, false); ps = __uint_as_float(rr[0]) + __uint_as_float(rr[1]); }
    l_reg = l_reg * alpha + ps;
#define PK4(P, BASE, OUT) do { unsigned a0 = cvt_pk_bf16(P[BASE + 0], P[BASE + 1]), a1 = cvt_pk_bf16(P[BASE + 2], P[BASE + 3]);   \
    unsigned b0 = cvt_pk_bf16(P[BASE + 4], P[BASE + 5]), b1 = cvt_pk_bf16(P[BASE + 6], P[BASE + 7]);                              \
    auto r0 = __builtin_amdgcn_permlane32_swap(a0, b0, false, false); auto r1 = __builtin_amdgcn_permlane32_swap(a1, b1, false, false); \
    u32x4 w = {r0[0], r1[0], r0[1], r1[1]}; OUT = *reinterpret_cast<bf16x8*>(&w); } while (0)
    PK4(p0, 0, pa0); PK4(p0, 8, pa1); PK4(p1, 0, pa2); PK4(p1, 8, pa3);
#undef PK4
}
template <int DQK, int MODE, int NQR = DQK / 16> __device__ __forceinline__ void qkt(f32x16& p0, f32x16& p1, LAS const char* Ks, const bf16x8* qr, int r32, int hi, float dq, float sl, LAS const char* qlds = nullptr) {
    p0 = f32x16{}; p1 = f32x16{};
    if (NQR < DQK / 16) asm volatile("" : "+v"(qlds));
    const int x_ = ((r32 >> 1) & 7) << 4; int kb[4];
#pragma unroll
    for (int j = 0; j < 4; ++j) kb[j] = r32 * (DQK * 2) + ((j * 32 + hi * 16) ^ x_);
#pragma unroll
    for (int d0 = 0; d0 < DQK / 16; ++d0) {
        bf16x8 qf; if (d0 < NQR) qf = qr[d0 < NQR ? d0 : 0]; else qf = *(LAS const bf16x8*)(qlds + (d0 - NQR) * 1024);
        const bf16x8 b0 = *(LAS const bf16x8*)(Ks + kb[d0 & 3] + (d0 >> 2) * 128);
        const bf16x8 b1 = *(LAS const bf16x8*)(Ks + kb[d0 & 3] + (d0 >> 2) * 128 + 32 * (DQK * 2));
        p0 = __builtin_amdgcn_mfma_f32_32x32x16_bf16(b0, qf, p0, 0, 0, 0);
        p1 = __builtin_amdgcn_mfma_f32_32x32x16_bf16(b1, qf, p1, 0, 0, 0); }
    if (MODE != 0) {
#pragma unroll
        for (int r = 0; r < 16; ++r) { const float c = (float)((r & 3) + 8 * (r >> 2)); const float d0 = fabsf(dq - c), d1 = fabsf(dq - 32.f - c);
            if (MODE == 1) { p0[r] = fmaf(-sl, d0, p0[r]); p1[r] = fmaf(-sl, d1, p1[r]); }
            else { p0[r] = d0 > 128.f ? -1e30f : fmaf(-sl, d0, p0[r]); p1[r] = d1 > 128.f ? -1e30f : fmaf(-sl, d1, p1[r]); } }
    }
}
template <int D0, int DV> __device__ __forceinline__ void pv_one(f32x16& od, int vb, bf16x8 pa0, bf16x8 pa1, bf16x8 pa2, bf16x8 pa3) {
    const s16x4 l0 = tr_read<v_rd_off<DV>(D0, 0, 0)>(vb), h0 = tr_read<v_rd_off<DV>(D0, 0, 1)>(vb), l1 = tr_read<v_rd_off<DV>(D0, 1, 0)>(vb), h1 = tr_read<v_rd_off<DV>(D0, 1, 1)>(vb);
    const s16x4 l2 = tr_read<v_rd_off<DV>(D0, 2, 0)>(vb), h2 = tr_read<v_rd_off<DV>(D0, 2, 1)>(vb), l3 = tr_read<v_rd_off<DV>(D0, 3, 0)>(vb), h3 = tr_read<v_rd_off<DV>(D0, 3, 1)>(vb);
    asm volatile("s_waitcnt lgkmcnt(0)" ::: "memory"); SBAR();
#define PK(L, H) (bf16x8){L[0], L[1], L[2], L[3], H[0], H[1], H[2], H[3]}
    od = __builtin_amdgcn_mfma_f32_32x32x16_bf16(pa0, PK(l0, h0), od, 0, 0, 0);
    od = __builtin_amdgcn_mfma_f32_32x32x16_bf16(pa1, PK(l1, h1), od, 0, 0, 0);
    od = __builtin_amdgcn_mfma_f32_32x32x16_bf16(pa2, PK(l2, h2), od, 0, 0, 0);
    od = __builtin_amdgcn_mfma_f32_32x32x16_bf16(pa3, PK(l3, h3), od, 0, 0, 0);
#undef PK
}
template <int DV> __device__ __forceinline__ void pv_all(f32x16* o, int vb, bf16x8 pa0, bf16x8 pa1, bf16x8 pa2, bf16x8 pa3) {
    pv_one<0, DV>(o[0], vb, pa0, pa1, pa2, pa3); pv_one<1, DV>(o[1], vb, pa0, pa1, pa2, pa3);
    if constexpr (DV == 128) { pv_one<2, DV>(o[2], vb, pa0, pa1, pa2, pa3); pv_one<3, DV>(o[3], vb, pa0, pa1, pa2, pa3); }
}

template <int DQK, int DV, int MODE, int SD, int LDQ, int LDK, int LDV, int NQL = 0, class Epi>
__device__ __forceinline__ void attn_body(const bf16_t* __restrict__ Qb, const bf16_t* __restrict__ Kh, const bf16_t* __restrict__ Vh, int kstart, int NT, int qpos0,
                                          float scale, float slope, float sinkl2, LAS char* lds, const Epi& epi, int wave_) {
    asm volatile("" : "+s"(Qb), "+s"(Kh), "+s"(Vh));
    constexpr int SHM_V = 64 * DV * 2, SHM_K = 64 * DQK * 2, NQ = DQK / 16, NO = DV / 32;
    constexpr int KCH = DQK / 8, NKC = 64 * KCH / 512, VCH = DV / 8, NVC = 64 * VCH / 512;
    int tid = wave_ * 64 + lane_id(); asm volatile("" : "+v"(tid));
    const int wid = tid >> 6, lane = tid & 63, r32 = lane & 31, hi = lane >> 5;
    LAS char* V_lds = lds; LAS char* K_lds = lds + 2 * SHM_V;
    LAS float* wsf = (LAS float*)(lds + 2 * SHM_V + 2 * SHM_K) + wid * 64; LAS float* li_l = wsf; LAS float* al_l = wsf + 32;
    const float C = scale * LOG2E, thr = 8.f / scale, sl = slope / scale;
    const float dq0 = (float)(qpos0 + wid * 32 + r32 - kstart - 4 * hi);
    constexpr int NQR = NQ - NQL;
    LAS char* qlds = lds + 2 * SHM_V + 2 * SHM_K + 2048 + wid * (NQL * 1024) + lane * 16;
    float m_reg = -1e30f, l_reg = 0; f32x16 o[NO]; bf16x8 qr[NQR > 0 ? NQR : 1];
#pragma unroll
    for (int d = 0; d < NO; ++d) o[d] = f32x16{};
    const GAS bf16_t* Qw = (const GAS bf16_t*)Qb + (size_t)(wid * 32 + r32) * LDQ + hi * 8;
#pragma unroll
    for (int d0 = 0; d0 < NQ; ++d0) { const bf16x8 qv = *(const GAS bf16x8*)(Qw + d0 * 16); if (d0 < NQR) qr[d0 < NQR ? d0 : 0] = qv; else *(LAS bf16x8*)(qlds + (d0 - NQR) * 1024) = qv; }
    int koff[NKC], kst[NKC], voff[NVC], vst[NVC];
#pragma unroll
    for (int i = 0; i < NKC; ++i) { const int c = tid + 512 * i, row = c / KCH, c8 = c % KCH; koff[i] = row * LDK + c8 * 8; kst[i] = kswz<DQK>(row, c8 * 16); }
#pragma unroll
    for (int i = 0; i < NVC; ++i) { const int c = tid + 512 * i, row = c / VCH, c8 = c % VCH; voff[i] = row * LDV + c8 * 8; vst[i] = v_st<DV>(row, c8 * 8); }
    const int vb0 = (int)(unsigned)(size_t)V_lds + v_rd_base(lane);
    struct { bf16x8 k[NKC]; bf16x8 v[NVC]; } sr_[SD];
    const GAS bf16_t* Kp = (const GAS bf16_t*)Kh + (size_t)kstart * LDK; const GAS bf16_t* Vp = (const GAS bf16_t*)Vh + (size_t)kstart * LDV;
#define SLOAD(i, k0) do { if constexpr (NQL > 0) { int t_ = tid; asm volatile("" : "+v"(t_)); \
      _Pragma("unroll") for (int _c = 0; _c < NVC; ++_c) { const int c_ = t_ + 512 * _c; sr_[i].v[_c] = *(const GAS bf16x8*)(Vp + (size_t)((k0) + c_ / VCH) * LDV + (c_ % VCH) * 8); } \
      _Pragma("unroll") for (int _c = 0; _c < NKC; ++_c) { const int c_ = t_ + 512 * _c; sr_[i].k[_c] = *(const GAS bf16x8*)(Kp + (size_t)((k0) + c_ / KCH) * LDK + (c_ % KCH) * 8); } } else { \
    _Pragma("unroll") for (int _c = 0; _c < NVC; ++_c) sr_[i].v[_c] = *(const GAS bf16x8*)(Vp + (size_t)(k0) * LDV + voff[_c]); \
    _Pragma("unroll") for (int _c = 0; _c < NKC; ++_c) sr_[i].k[_c] = *(const GAS bf16x8*)(Kp + (size_t)(k0) * LDK + koff[_c]); } } while (0)
#define SWRITE(b, i) do { if constexpr (NQL > 0) { int t_ = tid; asm volatile("" : "+v"(t_)); \
      _Pragma("unroll") for (int _c = 0; _c < NVC; ++_c) { const int c_ = t_ + 512 * _c; *(LAS bf16x8*)(V_lds + (b) * SHM_V + v_st<DV>(c_ / VCH, (c_ % VCH) * 8)) = sr_[i].v[_c]; } \
      _Pragma("unroll") for (int _c = 0; _c < NKC; ++_c) { const int c_ = t_ + 512 * _c; *(LAS bf16x8*)(K_lds + (b) * SHM_K + kswz<DQK>(c_ / KCH, (c_ % KCH) * 16)) = sr_[i].k[_c]; } } else { \
    _Pragma("unroll") for (int _c = 0; _c < NVC; ++_c) *(LAS bf16x8*)(V_lds + (b) * SHM_V + vst[_c]) = sr_[i].v[_c]; \
    _Pragma("unroll") for (int _c = 0; _c < NKC; ++_c) *(LAS bf16x8*)(K_lds + (b) * SHM_K + kst[_c]) = sr_[i].k[_c]; } } while (0)
#define RESC(a) do { if (__any((a) < 1.f)) { if (hi == 0) al_l[r32] = (a); asm volatile("s_waitcnt lgkmcnt(0)" ::: "memory"); \
    _Pragma("unroll") for (int d = 0; d < NO; ++d) _Pragma("unroll") for (int r = 0; r < 16; ++r) o[d][r] *= al_l[crow(r, hi)]; } } while (0)
    f32x16 pA0, pA1, pB0, pB1; float mnA, mnB, alA, alB; bf16x8 pa0, pa1, pa2, pa3;
    constexpr int SE = 0, SO = SD - 1;
    __syncthreads();
    SLOAD(SE, 0); asm volatile("s_waitcnt vmcnt(0)" ::: "memory"); SWRITE(0, SE); __syncthreads();
    qkt<DQK, MODE, NQR>(pA0, pA1, K_lds, qr, r32, hi, dq0, sl, qlds); partialSM(pA0, pA1, m_reg, mnA, alA, C, thr);
    SLOAD(SO, 64); if constexpr (SD == 2) { if (2 < NT) SLOAD(SE, 128); }
    SWRITE(1, SO); __syncthreads();
    for (int j = 1; j + 1 < NT; j += 2) {
        SBAR(); qkt<DQK, MODE, NQR>(pB0, pB1, K_lds + SHM_K, qr, r32, hi, dq0 - 64.f * (float)j, sl, qlds);
        finishSM(pA0, pA1, alA, l_reg, pa0, pa1, pa2, pa3); SBAR();
        SLOAD(SO, (j + SD) * 64); SBAR();
        pv_all<DV>(o, vb0, pa0, pa1, pa2, pa3); partialSM(pB0, pB1, m_reg, mnB, alB, C, thr);
        __syncthreads(); SWRITE(0, SE);
        RESC(alB); __syncthreads();
        SBAR(); qkt<DQK, MODE, NQR>(pA0, pA1, K_lds, qr, r32, hi, dq0 - 64.f * (float)(j + 1), sl, qlds);
        finishSM(pB0, pB1, alB, l_reg, pa0, pa1, pa2, pa3); SBAR();
        if (SD == 1 || j + 3 < NT) SLOAD(SE, (j + 1 + SD) * 64); SBAR();
        pv_all<DV>(o, vb0 + SHM_V, pa0, pa1, pa2, pa3); partialSM(pA0, pA1, m_reg, mnA, alA, C, thr);
        __syncthreads(); SWRITE(1, SO);
        RESC(alA); __syncthreads();
    }
    SBAR(); qkt<DQK, MODE, NQR>(pB0, pB1, K_lds + SHM_K, qr, r32, hi, dq0 - 64.f * (float)(NT - 1), sl, qlds);
    finishSM(pA0, pA1, alA, l_reg, pa0, pa1, pa2, pa3); SBAR();
    pv_all<DV>(o, vb0, pa0, pa1, pa2, pa3); partialSM(pB0, pB1, m_reg, mnB, alB, C, thr);
    __syncthreads(); RESC(alB);
    finishSM(pB0, pB1, alB, l_reg, pa0, pa1, pa2, pa3); SBAR();
    pv_all<DV>(o, vb0 + SHM_V, pa0, pa1, pa2, pa3);
    if (MODE == 2) l_reg += __builtin_amdgcn_exp2f(sinkl2 - m_reg * C);
    if (hi == 0) li_l[r32] = l_reg; asm volatile("s_waitcnt lgkmcnt(0)" ::: "memory");
    float rli[16];
#pragma unroll
    for (int r = 0; r < 16; ++r) rli[r] = __builtin_amdgcn_rcpf(li_l[crow(r, hi)]);
    epi(o, rli, wid, r32, hi);
#undef SLOAD
#undef SWRITE
#undef RESC
}

template <int DQK, int DV, int MODE, int LDQ, int LDK, int LDV, class Epi>
__device__ __forceinline__ void attn_body_simple(const bf16_t* __restrict__ Qb, const bf16_t* __restrict__ Kh, const bf16_t* __restrict__ Vh, int kstart, int NT, int qpos0,
                                                 float scale, float slope, float sinkl2, LAS char* lds, const Epi& epi, int wave_) {
    asm volatile("" : "+s"(Qb), "+s"(Kh), "+s"(Vh));
    constexpr int SHM_V = 64 * DV * 2, SHM_K = 64 * DQK * 2, NQ = DQK / 16, NO = DV / 32;
    constexpr int KCH = DQK / 8, NKC = 64 * KCH / 512, VCH = DV / 8, NVC = 64 * VCH / 512;
    int tid = wave_ * 64 + lane_id(); asm volatile("" : "+v"(tid));
    const int wid = tid >> 6, lane = tid & 63, r32 = lane & 31, hi = lane >> 5;
    LAS char* V_lds = lds; LAS char* K_lds = lds + 3 * SHM_V;
    LAS float* wsf = (LAS float*)(lds + 3 * SHM_V + 3 * SHM_K) + wid * 64; LAS float* li_l = wsf; LAS float* al_l = wsf + 32;
    const float C = scale * LOG2E, thr = 8.f / scale, sl = slope / scale;
    const float dq0 = (float)(qpos0 + wid * 32 + r32 - kstart - 4 * hi);
    float m_reg = -1e30f, l_reg = 0; f32x16 o[NO]; bf16x8 qr[NQ];
#pragma unroll
    for (int d = 0; d < NO; ++d) o[d] = f32x16{};
    const GAS bf16_t* Qw = (const GAS bf16_t*)Qb + (size_t)(wid * 32 + r32) * LDQ + hi * 8;
#pragma unroll
    for (int d0 = 0; d0 < NQ; ++d0) qr[d0] = *(const GAS bf16x8*)(Qw + d0 * 16);
    const int vb0 = (int)(unsigned)(size_t)V_lds + v_rd_base(lane);
    bf16x8 sk[NKC], sv[NVC];
    const GAS bf16_t* Kp = (const GAS bf16_t*)Kh + (size_t)kstart * LDK; const GAS bf16_t* Vp = (const GAS bf16_t*)Vh + (size_t)kstart * LDV;
#define S1LOAD(k0) do { _Pragma("unroll") for (int _c = 0; _c < NVC; ++_c) { const int c_ = tid + 512 * _c; sv[_c] = *(const GAS bf16x8*)(Vp + (size_t)((k0) + c_ / VCH) * LDV + (c_ % VCH) * 8); } \
    _Pragma("unroll") for (int _c = 0; _c < NKC; ++_c) { const int c_ = tid + 512 * _c; sk[_c] = *(const GAS bf16x8*)(Kp + (size_t)((k0) + c_ / KCH) * LDK + (c_ % KCH) * 8); } } while (0)
#define S1WRITE(b) do { _Pragma("unroll") for (int _c = 0; _c < NVC; ++_c) { const int c_ = tid + 512 * _c; *(LAS bf16x8*)(V_lds + (b) * SHM_V + v_st<DV>(c_ / VCH, (c_ % VCH) * 8)) = sv[_c]; } \
    _Pragma("unroll") for (int _c = 0; _c < NKC; ++_c) { const int c_ = tid + 512 * _c; *(LAS bf16x8*)(K_lds + (b) * SHM_K + kswz<DQK>(c_ / KCH, (c_ % KCH) * 16)) = sk[_c]; } } while (0)
    __syncthreads();
    S1LOAD(0); S1WRITE(0); S1LOAD(64); S1WRITE(1);
    if (2 < NT) S1LOAD(128);
    int slot = 0;
    for (int j = 0; j < NT; ++j) {
        __syncthreads();
        { const int wslot = slot == 0 ? 2 : slot - 1;
          if (j + 2 < NT) { S1WRITE(wslot); if (j + 3 < NT) S1LOAD((j + 3) * 64); } }
        f32x16 p0, p1; float mn, al; bf16x8 pa0, pa1, pa2, pa3;
        qkt<DQK, MODE>(p0, p1, K_lds + slot * SHM_K, qr, r32, hi, dq0 - 64.f * (float)j, sl);
        partialSM(p0, p1, m_reg, mn, al, C, thr);
        finishSM(p0, p1, al, l_reg, pa0, pa1, pa2, pa3);
        if (__any(al < 1.f)) { if (hi == 0) al_l[r32] = al; asm volatile("s_waitcnt lgkmcnt(0)" ::: "memory");
#pragma unroll
            for (int d = 0; d < NO; ++d)
#pragma unroll
                for (int r = 0; r < 16; ++r) o[d][r] *= al_l[crow(r, hi)]; }
        SBAR();
        pv_all<DV>(o, vb0 + slot * SHM_V, pa0, pa1, pa2, pa3);
        slot = slot == 2 ? 0 : slot + 1;
    }
#undef S1LOAD
#undef S1WRITE
    if (MODE == 2) l_reg += __builtin_amdgcn_exp2f(sinkl2 - m_reg * C);
    if (hi == 0) li_l[r32] = l_reg; asm volatile("s_waitcnt lgkmcnt(0)" ::: "memory");
    float rli[16];
#pragma unroll
    for (int r = 0; r < 16; ++r) rli[r] = __builtin_amdgcn_rcpf(li_l[crow(r, hi)]);
    epi(o, rli, wid, r32, hi);
}

template <int NO> struct EpiStoreBf16 {
    bf16_t* O; int ldo;
    __device__ __forceinline__ void operator()(const f32x16* o, const float* rli, int wid, int r32, int hi) const {
        bf16_t* Ob = O; asm volatile("" : "+s"(Ob));
#pragma unroll
        for (int r = 0; r < 16; ++r) { GAS bf16_t* p = (GAS bf16_t*)Ob + (size_t)(wid * 32 + crow(r, hi)) * ldo + r32;
#pragma unroll
            for (int d0 = 0; d0 < NO; ++d0) p[d0 * 32] = (bf16_t)(cvt_pk_bf16(o[d0][r] * rli[r], 0.f) & 0xffffu); }
    }
};
struct EpiDiff0 {
    float* scr;
    __device__ __forceinline__ void operator()(const f32x16* o, const float* rli, int wid, int r32, int hi) const {
        float* sb = scr; asm volatile("" : "+s"(sb));
        int t_ = wid * 64 + hi * 32 + r32; GAS f32x4* p = (GAS f32x4*)(sb + t_ * 64);
#pragma unroll
        for (int d0 = 0; d0 < 4; ++d0)
#pragma unroll
            for (int q = 0; q < 4; ++q) { f32x4 v;
#pragma unroll
                for (int i = 0; i < 4; ++i) v[i] = o[d0][4 * q + i] * rli[4 * q + i];
                p[d0 * 4 + q] = v; }
    }
};
struct EpiDiff1 {
    const float* scr; bf16_t* O; int ldo; const float* g; float lam, oscale;
    __device__ __forceinline__ void operator()(const f32x16* o, const float* rli, int wid, int r32, int hi) const {
        const float* sb = scr; bf16_t* Ob = O; asm volatile("" : "+s"(sb), "+s"(Ob));
        int t_ = wid * 64 + hi * 32 + r32; const GAS f32x4* p = (const GAS f32x4*)(sb + t_ * 64); float gv[4];
#pragma unroll
        for (int d0 = 0; d0 < 4; ++d0) gv[d0] = g[d0 * 32 + r32] * oscale;
#pragma unroll
        for (int q = 0; q < 4; ++q) { f32x4 t[4];
#pragma unroll
            for (int d0 = 0; d0 < 4; ++d0) t[d0] = p[d0 * 4 + q];
#pragma unroll
            for (int i = 0; i < 4; ++i) { const int r = 4 * q + i; float s = 0.f;
#pragma unroll
                for (int d0 = 0; d0 < 4; ++d0) { t[d0][i] -= lam * (o[d0][r] * rli[r]); s += t[d0][i] * t[d0][i]; }
                s += __shfl_xor(s, 1); s += __shfl_xor(s, 2); s += __shfl_xor(s, 4); s += __shfl_xor(s, 8); s += __shfl_xor(s, 16);
                const float rn = fast_rsq(s * (1.f / 128.f) + EPS);
                GAS bf16_t* qp = (GAS bf16_t*)Ob + (size_t)(wid * 32 + crow(r, hi)) * ldo + r32;
#pragma unroll
                for (int d0 = 0; d0 < 4; ++d0) qp[d0 * 32] = (bf16_t)(cvt_pk_bf16(t[d0][i] * rn * gv[d0], 0.f) & 0xffffu); }
            asm volatile("" ::: "memory"); }
    }
};
}

__device__ __forceinline__ float wave_sum(float v) {
#pragma unroll
    for (int o = 1; o < 64; o <<= 1) v += __shfl_xor(v, o);
    return v;
}
template <int MODE> __device__ __forceinline__ int src_col(int n) {
    if (MODE == 1) { const int t = n >> 8, j = n & 255; return j < 128 ? t * 128 + j : FF + t * 128 + (j - 128); }
    if (MODE == 2) { if (n < Z_CKR) return n; if (n < 3008) { const int e = n - Z_CKR; return Z_CKR + (e >> 1) + 32 * (e & 1); } return -1; }
    if (MODE == 3) { const int h = n / 192, e = n - h * 192; if (e < 128) return n; const int e2 = e - 128; return h * 192 + 128 + (e2 >> 1) + 32 * (e2 & 1); }
    return n;
}
template <int MODE> __device__ __forceinline__ void tr_item(const float* __restrict__ W, int K, int Nsrc, const float* __restrict__ gain, bf16_t* WT, int nblk, LAS float* scr, int item, int lane) {
    const int kb = item / nblk, nb = item - kb * nblk, k0 = 64 * kb, n0 = 32 * nb;
    const int sc0 = src_col<MODE>(n0), sc31 = src_col<MODE>(n0 + 31);
    if (sc0 >= 0 && sc31 == sc0 + 31 && (sc0 & 3) == 0) {
        const int row8 = lane >> 3, n4 = (lane & 7) * 4;
#pragma unroll
        for (int i = 0; i < 8; ++i) { const int kk = 8 * i + row8; f32x4 v = *(const f32x4*)(W + (size_t)(k0 + kk) * Nsrc + sc0 + n4);
            if (gain) v = v * gain[k0 + kk];
            LAS float* d = scr + kk * 33 + n4; d[0] = v[0]; d[1] = v[1]; d[2] = v[2]; d[3] = v[3]; }
    } else {
        const int sc = src_col<MODE>(n0 + (lane & 31));
#pragma unroll
        for (int i = 0; i < 32; ++i) { const int kk = 2 * i + (lane >> 5); float v = 0.f;
            if (sc >= 0) { v = W[(size_t)(k0 + kk) * Nsrc + sc]; if (gain) v *= gain[k0 + kk]; }
            scr[kk * 33 + (lane & 31)] = v; }
    }
    asm volatile("s_waitcnt lgkmcnt(0)" ::: "memory");
    const int c = lane & 7;
#pragma unroll
    for (int j = 0; j < 4; ++j) { const int n = (lane >> 3) + 8 * j; const LAS float* s = scr + (8 * c) * 33 + n;
        u32x4 o; o.x = cvt_pk_bf16(s[0 * 33], s[1 * 33]); o.y = cvt_pk_bf16(s[2 * 33], s[3 * 33]); o.z = cvt_pk_bf16(s[4 * 33], s[5 * 33]); o.w = cvt_pk_bf16(s[6 * 33], s[7 * 33]);
        *(u32x4*)(WT + (size_t)(n0 + n) * K + k0 + 8 * c) = o; }
    asm volatile("s_waitcnt lgkmcnt(0)" ::: "memory");
}

struct Args { const float* in[21]; float* out; unsigned char* ws; int ph_lo, ph_hi; };
enum { I_X = 0, I_F1N, I_F1W13, I_F1W2, I_MIXN, I_WIN, I_WGATE, I_BGATE, I_ALAM, I_ASUB, I_BSINK, I_CQN, I_CWUQ, I_CKVN, I_CWUKV, I_WBR, I_WOUT, I_F2N, I_F2W13, I_F2W2, I_FINN };

constexpr int LDS_BYTES = 155648;

struct TrDesc { const float* W; const float* gain; bf16_t* WT; int K, Nsrc, nblk, mode, r; };
__device__ __forceinline__ int src_col_rt(int mode, int n) { return mode == 1 ? src_col<1>(n) : mode == 2 ? src_col<2>(n) : mode == 3 ? src_col<3>(n) : n; }
__device__ __forceinline__ bool tr_decode(const Args& a, int l, unsigned char* ws, int it, TrDesc& d) {
    constexpr int I_W13 = (DM / 64) * (2 * FF / 32), I_W2 = (FF / 64) * (DM / 32), I_IN = (DM / 64) * (3072 / 32), I_GT = I_IN,
                  I_UQ = (384 / 64) * (768 / 32), I_UKV = (256 / 64) * (1024 / 32), I_BR = (512 / 64) * (1024 / 32), I_OUT = (DM / 64) * (DM / 32);
    constexpr int NITEMS = 2 * I_W13 + 2 * I_W2 + I_IN + I_GT + I_UQ + I_UKV + 3 * I_BR + I_OUT;
    if (it >= NITEMS) return false;
    int r = it;
#define TR_SET(W_, K_, NS_, G_, WT_, NB_, M_) do { d.W = (W_); d.K = (K_); d.Nsrc = (NS_); d.gain = (G_); d.WT = (WT_); d.nblk = (NB_); d.mode = (M_); d.r = r; return true; } while (0)
    if (r < I_W13) TR_SET(a.in[I_F1W13] + (size_t)l * DM * 2 * FF, DM, 2 * FF, a.in[I_F1N] + l * DM, (bf16_t*)(ws + WS_W13A), 2 * FF / 32, 1); r -= I_W13;
    if (r < I_W13) TR_SET(a.in[I_F2W13] + (size_t)l * DM * 2 * FF, DM, 2 * FF, a.in[I_F2N] + l * DM, (bf16_t*)(ws + WS_W13B), 2 * FF / 32, 1); r -= I_W13;
    if (r < I_W2) TR_SET(a.in[I_F1W2] + (size_t)l * FF * DM, FF, DM, nullptr, (bf16_t*)(ws + WS_W2A), DM / 32, 0); r -= I_W2;
    if (r < I_W2) TR_SET(a.in[I_F2W2] + (size_t)l * FF * DM, FF, DM, nullptr, (bf16_t*)(ws + WS_W2B), DM / 32, 0); r -= I_W2;
    if (r < I_IN) TR_SET(a.in[I_WIN] + (size_t)l * DM * 3008, DM, 3008, a.in[I_MIXN] + l * DM, (bf16_t*)(ws + WS_WIG), 3072 / 32, 2); r -= I_IN;
    if (r < I_GT) TR_SET(a.in[I_WGATE] + (size_t)l * DM * 3072, DM, 3072, a.in[I_MIXN] + l * DM, (bf16_t*)(ws + WS_WIG) + (size_t)3072 * DM, 3072 / 32, 0); r -= I_GT;
    if (r < I_UQ) TR_SET(a.in[I_CWUQ] + (size_t)l * 384 * 768, 384, 768, a.in[I_CQN] + l * 384, (bf16_t*)(ws + WS_WUQ), 768 / 32, 3); r -= I_UQ;
    if (r < I_UKV) TR_SET(a.in[I_CWUKV] + (size_t)l * 256 * 1024, 256, 1024, a.in[I_CKVN] + l * 256, (bf16_t*)(ws + WS_WUKV), 1024 / 32, 0); r -= I_UKV;
    if (r < 3 * I_BR) { const int n = r / I_BR; r -= n * I_BR; TR_SET(a.in[I_WBR] + ((size_t)l * 3 + n) * 512 * 1024, 512, 1024, nullptr, (bf16_t*)(ws + WS_WB) + (size_t)n * 1024 * 512, 1024 / 32, 0); } r -= 3 * I_BR;
    TR_SET(a.in[I_WOUT] + (size_t)l * DM * DM, DM, DM, nullptr, (bf16_t*)(ws + WS_WO), DM / 32, 0);
#undef TR_SET
}
__device__ __forceinline__ bool tr_load(const TrDesc& d, int lane, f32x4 (&v)[8]) {
    const int kb = d.r / d.nblk, nb = d.r - kb * d.nblk, k0 = 64 * kb, n0 = 32 * nb;
    const int sc0 = src_col_rt(d.mode, n0), sc31 = src_col_rt(d.mode, n0 + 31);
    const bool vec = sc0 >= 0 && sc31 == sc0 + 31 && (sc0 & 3) == 0;
    if (vec) { const int row8 = lane >> 3, n4 = (lane & 7) * 4;
#pragma unroll
        for (int i = 0; i < 8; ++i) { const int kk = 8 * i + row8; v[i] = *(const f32x4*)(d.W + (size_t)(k0 + kk) * d.Nsrc + sc0 + n4); } }
    return vec;
}
__device__ __forceinline__ void tr_finish(const TrDesc& d, bool vec, int lane, const f32x4 (&v)[8], LAS float* scr) {
    const int kb = d.r / d.nblk, nb = d.r - kb * d.nblk, k0 = 64 * kb, n0 = 32 * nb;
    if (vec) { const int row8 = lane >> 3, n4 = (lane & 7) * 4;
#pragma unroll
        for (int i = 0; i < 8; ++i) { const int kk = 8 * i + row8; const f32x4 x = d.gain ? v[i] * d.gain[k0 + kk] : v[i]; LAS float* p = scr + kk * 33 + n4; p[0] = x[0]; p[1] = x[1]; p[2] = x[2]; p[3] = x[3]; }
    } else { const int sc = src_col_rt(d.mode, n0 + (lane & 31));
#pragma unroll 8
        for (int i = 0; i < 32; ++i) { const int kk = 2 * i + (lane >> 5); float x = 0.f;
            if (sc >= 0) { x = d.W[(size_t)(k0 + kk) * d.Nsrc + sc]; if (d.gain) x *= d.gain[k0 + kk]; }
            scr[kk * 33 + (lane & 31)] = x; } }
    asm volatile("s_waitcnt lgkmcnt(0)" ::: "memory");
    const int c = lane & 7;
#pragma unroll
    for (int j = 0; j < 4; ++j) { const int n = (lane >> 3) + 8 * j; const LAS float* s = scr + (8 * c) * 33 + n;
        u32x4 o; o.x = cvt_pk_bf16(s[0 * 33], s[1 * 33]); o.y = cvt_pk_bf16(s[2 * 33], s[3 * 33]); o.z = cvt_pk_bf16(s[4 * 33], s[5 * 33]); o.w = cvt_pk_bf16(s[6 * 33], s[7 * 33]);
        *(u32x4*)(d.WT + (size_t)(n0 + n) * d.K + k0 + 8 * c) = o; }
    asm volatile("s_waitcnt lgkmcnt(0)" ::: "memory");
}
__device__ __forceinline__ void convert_layer(const Args& a, int l, LAS unsigned char* lds, int gw, int NGW, int wave) {
    int lane = lane_id(); asm volatile("" : "+v"(lane));
    LAS float* scr0 = (LAS float*)(lds + wave * 17408); LAS float* scr1 = scr0 + 64 * 33 + 32;
    unsigned char* ws = a.ws; asm volatile("" : "+s"(ws));
    for (int it = gw; ; it += 2 * NGW) {
        TrDesc d0, d1; f32x4 v0[8], v1[8];
        if (!tr_decode(a, l, ws, it, d0)) break;
        const bool has1 = tr_decode(a, l, ws, it + NGW, d1);
        const bool vec0 = tr_load(d0, lane, v0);
        bool vec1 = false; if (has1) vec1 = tr_load(d1, lane, v1);
        tr_finish(d0, vec0, lane, v0, scr0);
        if (has1) tr_finish(d1, vec1, lane, v1, scr1);
    }
}

#define XB_TMO      128
#define XB_XCNT(j)  (256  + 64 * (j))
#define XB_XSUB(j)  (1280 + 64 * (j))
#define XB_XGEN(j)  (2304 + 64 * (j))
#define XB_TOP      3328
#define XB_TOPGEN   3392
#define XCD_BAR_WORDS 3456
#define XB_SPIN_CAP (1u << 18)

__device__ __forceinline__ unsigned xb_ld(unsigned* p)              { return __hip_atomic_load(p, __ATOMIC_RELAXED, __HIP_MEMORY_SCOPE_AGENT); }
__device__ __forceinline__ unsigned xb_add(unsigned* p, unsigned v) { return __hip_atomic_fetch_add(p, v, __ATOMIC_RELAXED, __HIP_MEMORY_SCOPE_AGENT); }
__device__ __forceinline__ unsigned xb_xcc_id() { return (unsigned)__builtin_amdgcn_s_getreg((3 << 11) | 20) & 0xFu; }
#define XB_SPIN(cond, bar) do { unsigned _sp = 0; while (cond) { __builtin_amdgcn_s_sleep(1); \
    if ((++_sp & 255u) == 0u) { if (xb_ld(&(bar)[XB_TMO])) break; if (_sp > XB_SPIN_CAP) { atomicAdd(&(bar)[XB_TMO], 1u); break; } } } } while (0)

struct XcdBarrier {
    unsigned* bar; unsigned x;
    volatile LAS unsigned* st;
};

__device__ __forceinline__ XcdBarrier xcd_barrier_post(unsigned* bar, volatile LAS unsigned* st) {
    XcdBarrier b; b.bar = bar; b.x = xb_xcc_id(); b.st = st;
    if (threadIdx.x == 0) (void)xb_add(&bar[XB_XCNT(b.x)], 1u);
    return b;
}
__device__ __forceinline__ void xcd_barrier_complete(unsigned* bar, unsigned x, unsigned& nloc, unsigned& nx) {
    const unsigned G = gridDim.x * gridDim.y * gridDim.z;
    unsigned sum, cnt, mine, sp = 0u;
    for (;;) {
        sum = 0u; cnt = 0u; mine = 0u;
#pragma unroll
        for (unsigned j = 0; j < 16; ++j) { const unsigned c = xb_ld(&bar[XB_XCNT(j)]); sum += c; cnt += (c > 0u) ? 1u : 0u; mine = (j == x) ? c : mine; }
        if (sum == G) break;
        __builtin_amdgcn_s_sleep(1);
        if ((++sp & 255u) == 0u) { if (xb_ld(&bar[XB_TMO])) break; if (sp > XB_SPIN_CAP) { atomicAdd(&bar[XB_TMO], 1u); break; } }
    }
    nloc = mine > 0u ? mine : 1u; nx = cnt > 0u ? cnt : 1u;
}

__device__ __forceinline__ void xcd_barrier(const XcdBarrier& b0_) {
    XcdBarrier b; b.bar = b0_.bar; b.st = b0_.st; b.x = xb_xcc_id(); { unsigned* bb = b.bar; asm volatile("" : "+s"(bb)); b.bar = bb; }
    asm volatile("s_waitcnt vmcnt(0)" ::: "memory");
    __syncthreads();
    if (threadIdx.x == 0) {
        unsigned* bar = b.bar;
        __builtin_amdgcn_s_waitcnt(0);
        unsigned nloc = b.st[0], nx = b.st[1];
        if (nloc == 0u) { xcd_barrier_complete(bar, b.x, nloc, nx); b.st[0] = nloc; b.st[1] = nx; }
        const unsigned old = xb_add(&bar[XB_XSUB(b.x)], 1u);
        const unsigned gen = old / nloc;
        if (old + 1u == (gen + 1u) * nloc) {
            __builtin_amdgcn_fence(__ATOMIC_RELEASE, "agent");
            asm volatile("s_waitcnt vmcnt(0)" ::: "memory");
            const unsigned og = xb_add(&bar[XB_TOP], 1u);
            const unsigned tg = og / nx;
            if (og + 1u == (tg + 1u) * nx) xb_add(&bar[XB_TOPGEN], 1u);
            else XB_SPIN(xb_ld(&bar[XB_TOPGEN]) == tg, bar);
            __builtin_amdgcn_fence(__ATOMIC_ACQUIRE, "agent");
            xb_add(&bar[XB_XGEN(b.x)], 1u);
            asm volatile("s_waitcnt vmcnt(0)" ::: "memory");
        } else {
            XB_SPIN(xb_ld(&bar[XB_XGEN(b.x)]) == gen, bar);
            __builtin_amdgcn_fence(__ATOMIC_ACQUIRE, "agent");
            asm volatile("s_waitcnt vmcnt(0)" ::: "memory");
        }
    }
    __syncthreads();
}


__global__ void __launch_bounds__(512) fwd_megakernel(Args a) {
    extern __shared__ __attribute__((aligned(16))) unsigned char lds_raw[];
    LAS unsigned char* lds = (LAS unsigned char*)lds_raw;
    cg::grid_group grid = cg::this_grid();
#define GSYNC() xcd_barrier(xbar)
    const int wave = __builtin_amdgcn_readfirstlane(threadIdx.x >> 6);
    const int G = gridDim.x, bx = blockIdx.x;
    volatile LAS unsigned* xst = (volatile LAS unsigned*)(lds + LDS_BYTES - 64);
    if (threadIdx.x < 2) xst[threadIdx.x] = 0u;
    __syncthreads();
    grid.sync();
    XcdBarrier xbar = xcd_barrier_post((unsigned*)(a.ws + WS_BAR), xst);
    const int vcu = (G % 8 == 0) ? (bx % 8) * (G / 8) + bx / 8 : bx;
    const int gw = vcu * 8 + wave, NGW = G * 8;
    unsigned char* ws = a.ws;
    float* X = a.out;
    bf16_t* XB = (bf16_t*)(ws + WS_XB); float* SSQ = (float*)(ws + WS_SSQ); float* SSQZ = (float*)(ws + WS_SSQZ);
    float* ROPEC = (float*)(ws + WS_ROPE); float* ROPES = ROPEC + SEQ * 32;
    bf16_t* Z = (bf16_t*)(ws + WS_R0); bf16_t* H = (bf16_t*)(ws + WS_R0); float* MG = (float*)(ws + WS_R0); bf16_t* MB = (bf16_t*)(ws + WS_R0 + 64 * MiB);
    bf16_t* GT = (bf16_t*)(ws + WS_G); bf16_t* QC = (bf16_t*)(ws + WS_QC); bf16_t* KC = (bf16_t*)(ws + WS_KC); bf16_t* VC = (bf16_t*)(ws + WS_VC);
    bf16_t* O3 = (bf16_t*)(ws + WS_O3); float* SCR = (float*)(ws + WS_SCR) + (size_t)bx * (512 * 64);

    {
        const float* xin = a.in[I_X]; const int lane = lane_id();
        for (int m = gw; m < M_TOK; m += NGW) {
            const f32x4* xr = (const f32x4*)(xin + (size_t)m * DM) + lane; f32x4* xo = (f32x4*)(X + (size_t)m * DM) + lane; u32x2* bo = (u32x2*)(XB + (size_t)m * DM) + lane;
            float s = 0.f;
#pragma unroll
            for (int j = 0; j < 4; ++j) { const f32x4 v = xr[64 * j]; xo[64 * j] = v; s += dot4(v); u32x2 w; w.x = cvt_pk_bf16(v[0], v[1]); w.y = cvt_pk_bf16(v[2], v[3]); bo[64 * j] = w; }
            s = wave_sum(s);
            if (lane < 16) SSQ[(size_t)m * 16 + lane] = lane == 0 ? s : 0.f;
        }
        for (int i = gw * 64 + lane; i < SEQ * 32; i += NGW * 64) {
            const int pos = i >> 5, j = i & 31;
            const float inv_freq = (float)exp2(-(double)(2 * j) / 64.0 * 13.287712379549449);
            const float ang = (float)pos * inv_freq;
            const double rev = (double)ang * 0.15915494309189535; const float f = (float)(rev - floor(rev));
            ROPEC[i] = __builtin_amdgcn_cosf(f); ROPES[i] = __builtin_amdgcn_sinf(f);
        }
#ifndef NO_CONV
        convert_layer(a, 0, lds, gw, NGW, wave);
#endif
    }
    GSYNC();

    for (int l = 0; l < DEPTH; ++l) {
#ifndef NO_CONV
        if (l > 0) { convert_layer(a, l, lds, gw, NGW, wave); GSYNC(); }
#endif
        for (int half = 0; half < 2; ++half) {
#ifndef NO_FFNUP
            { pg8::Gemm g{XB, (const bf16_t*)(ws + (half ? WS_W13B : WS_W13A)), M_TOK, 2 * FF, DM, DM, 31, 0}; pg8::StaticOrder S; S.init(M_TOK, 2 * FF, G, bx);
              EpiSwiGLU E{H, SSQ}; pg8::gemm_phase(lds, g, S, E, wave); }
#endif
            GSYNC();
#ifndef NO_FFNDN
            { pg8::Gemm g{H, (const bf16_t*)(ws + (half ? WS_W2B : WS_W2A)), M_TOK, DM, FF, FF, 31, 0}; pg8::StaticOrder S; S.init(M_TOK, DM, G, bx);
              EpiResid E{X, XB, SSQ, 0.5f}; pg8::gemm_phase(lds, g, S, E, wave); }
#endif
            GSYNC();
            if (half == 1) break;
#ifndef NO_INPROJ
            { pg8::Gemm g{XB, (const bf16_t*)(ws + WS_WIG), M_TOK, 6144, DM, DM, 31, 0}; pg8::StaticOrder S; S.init(M_TOK, 6144, G, bx);
              EpiInProj E{Z, GT, KC, SSQ, SSQZ, a.in[I_BGATE] + l * 3072, ROPEC, ROPES}; pg8::gemm_phase(lds, g, S, E, wave); }
#endif
            GSYNC();
#ifndef NO_UQ
            { pg8::Gemm g{Z + Z_CQ, (const bf16_t*)(ws + WS_WUQ), M_TOK, 768, 384, ZC, 31, 0}; pg8::StaticOrder S; S.init(M_TOK, 768, G, bx);
              EpiUQ E{QC, SSQZ, ROPEC, ROPES}; pg8::gemm_phase(lds, g, S, E, wave); }
#endif
#ifndef NO_UKV
            { pg8::Gemm g{Z + Z_CKV, (const bf16_t*)(ws + WS_WUKV), M_TOK, 1024, 256, ZC, 31, 0}; pg8::StaticOrder S; S.init(M_TOK, 1024, G, G - 1 - bx);
              EpiUKV E{KC, VC, SSQZ}; pg8::gemm_phase(lds, g, S, E, wave); }
#endif
            { unsigned* NRM = (unsigned*)(ws + WS_BAR + 32768) + l * 32; const int lane = lane_id(); float mx0 = 0.f, mx1 = 0.f;
              for (int m = gw; m < M_TOK; m += NGW) { const u32x4* zp = (const u32x4*)(Z + (size_t)m * ZC + lane * 16); const u32x4 w0 = zp[0], w1 = zp[1]; float sq = 0.f;
#pragma unroll
                  for (int i = 0; i < 4; ++i) { const float a0 = bf16_lo(w0[i]), a1 = bf16_hi(w0[i]), b0 = bf16_lo(w1[i]), b1 = bf16_hi(w1[i]); sq += (a0 * a0 + a1 * a1) + (b0 * b0 + b1 * b1); }
                  sq += __shfl_xor(sq, 1); sq += __shfl_xor(sq, 2);
                  if (m < SEQ) mx0 = fmaxf(mx0, sq); else mx1 = fmaxf(mx1, sq); }
              if ((lane & 3) == 0) { __hip_atomic_fetch_max(NRM + (lane >> 2), __float_as_uint(mx0), __ATOMIC_RELAXED, __HIP_MEMORY_SCOPE_AGENT);
                                     __hip_atomic_fetch_max(NRM + 16 + (lane >> 2), __float_as_uint(mx1), __ATOMIC_RELAXED, __HIP_MEMORY_SCOPE_AGENT); } }
            GSYNC();
            {
                LAS char* al = (LAS char*)lds;
                const int nslot = (G == 256) ? 6 : (1024 + G - 1) / G;
                for (int k_ = 0; k_ < nslot; ++k_) {
                    int L;
                    if (G == 256) {
                        if (vcu < 128) L = k_ < 2 ? 2 * vcu + k_ : k_ < 4 ? 512 + 2 * vcu + (k_ - 2) : (k_ == 4 && (vcu & 1)) ? 512 + 256 + (vcu >> 1) : -1;
                        else { const int u = (vcu - 128) & 63, hi_ = vcu >= 192, hh = k_ == 0 ? (hi_ ? 2 : 3) : (hi_ ? 1 : 0);
                               L = k_ < 2 ? 256 + (((u >> 5) * 4 + hh) << 5) + (u & 31) : hi_ ? (k_ < 4 ? 512 + 384 + 2 * u + (k_ - 2) : -1) : (k_ == 2 ? 512 + 320 + u : -1); }
                    } else { L = vcu + k_ * G; if (L >= 1024) L = -1; }
                    if (L < 0) continue;
                    if (L < 256) {
#ifndef NO_C
                        const int bh = L >> 5, qb = L & 31, b = bh >> 2, h = bh & 3; const size_t r0 = (size_t)b * SEQ + qb * 256;
                        att::EpiStoreBf16<4> E{O3 + r0 * 1536 + 1024 + h * 128, 1536};
                        att::attn_body_simple<192, 128, 0, 768, 768, 512>(QC + r0 * 768 + h * 192, KC + (size_t)b * SEQ * 768 + h * 192, VC + (size_t)b * SEQ * 512 + h * 128,
                                                                     0, SEQ / 64, qb * 256, 0.07216878364870322f, 0.f, 0.f, al, E, wave);
#endif
                    } else if (L < 512) {
#ifndef NO_A
                        const int u = L - 256, bh = u >> 5, qb = u & 31, b = bh >> 2, h = bh & 3; const size_t r0 = (size_t)b * SEQ + qb * 256;
                        int li = l; asm volatile("" : "+s"(li));
                        const float lam_init = __uint_as_float(li == 0 ? 0x3e4ccccdu : li == 1 ? 0x3eb60549u : li == 2 ? 0x3ef1014cu : 0x3f0e59d5u);
                        const float* lp = a.in[I_ALAM] + l * 256; const int lane = lane_id();
                        const float s01 = wave_sum(lp[lane] * lp[64 + lane]), s23 = wave_sum(lp[128 + lane] * lp[192 + lane]);
                        const float lam = uni(expf(s01) - expf(s23) + lam_init);
                        const float slope = uni(exp2f(-2.f * (float)(h + 1)));
                        const bf16_t* zb = Z + (size_t)b * SEQ * ZC;
                        int ks0, nt0, ks1, nt1;
                        { const unsigned* NRM = (const unsigned*)(ws + WS_BAR + 32768) + l * 32 + b * 16;
#pragma unroll
                          for (int mp = 0; mp < 2; ++mp) {
                              const float q2 = __uint_as_float(__hip_atomic_load(NRM + h * 2 + mp, __ATOMIC_RELAXED, __HIP_MEMORY_SCOPE_AGENT)), k2 = __uint_as_float(__hip_atomic_load(NRM + 8 + h * 2 + mp, __ATOMIC_RELAXED, __HIP_MEMORY_SCOPE_AGENT));
                              const float dmax = uni((2.f * 0.125f * sqrtf(q2 * k2) * 1.01f + 32.f) / slope);
                              const float lo_f = (float)(qb * 256) - dmax, hi_f = (float)(qb * 256 + 256) + dmax;
                              const int lo_i = lo_f <= 0.f ? 0 : ((int)lo_f >> 7) << 7; const int hi_i = hi_f >= (float)SEQ ? SEQ : ((((int)hi_f + 127) >> 7) << 7);
                              const int hi_c = hi_i > SEQ ? SEQ : hi_i;
                              if (mp == 0) { ks0 = lo_i; nt0 = (hi_c - lo_i) >> 6; } else { ks1 = lo_i; nt1 = (hi_c - lo_i) >> 6; } } }
                        { att::EpiDiff0 E{SCR};
                          ATT_A_BODY(Z + r0 * ZC + Z_AQ + h * 128, zb + Z_AK + h * 128, zb + Z_AV + h * 128, ks0, nt0, qb * 256, 0.125f, slope, 0.f, al, E, wave); }
                        { att::EpiDiff1 E{SCR, O3 + r0 * 1536 + h * 128, 1536, a.in[I_ASUB] + l * 128, lam, 1.f - lam_init};
                          ATT_A_BODY(Z + r0 * ZC + Z_AQ + h * 128 + 64, zb + Z_AK + h * 128 + 64, zb + Z_AV + h * 128, ks1, nt1, qb * 256, 0.125f, slope, 0.f, al, E, wave); }
#endif
                    } else {
#ifndef NO_B
                        const int u = L - 512, bh = u >> 5, qb = u & 31, b = bh >> 3, hq = bh & 7; const size_t r0 = (size_t)b * SEQ + qb * 256;
                        const int ks = qb * 256 - 128 < 0 ? 0 : qb * 256 - 128, ke = qb * 256 + 384 > SEQ ? SEQ : qb * 256 + 384;
                        const float slope = uni(exp2f(-(float)(hq + 1))); const float sink = uni(a.in[I_BSINK][l * 8 + hq]);
                        const bf16_t* zb = Z + (size_t)b * SEQ * ZC;
                        att::EpiStoreBf16<2> E{O3 + r0 * 1536 + 512 + hq * 64, 1536};
                        att::attn_body<64, 64, 2, 2, ZC, ZC, ZC>(Z + r0 * ZC + Z_BQ + hq * 64, zb + Z_BK + (hq >> 2) * 64, zb + Z_BV + (hq >> 2) * 64, ks, (ke - ks) / 64, qb * 256, 0.125f, slope, sink * LOG2E, al, E, wave);
#endif
                    }
                }
                __syncthreads();
            }
            GSYNC();
#ifndef NO_BR
            { pg8::Gemm g{O3, (const bf16_t*)(ws + WS_WB), M_TOK, 3072, 512, 1536, 2, 1024}; pg8::BranchOrder S; S.init(G, bx);
              EpiGateAcc E{GT, MG, MB}; pg8::gemm_phase(lds, g, S, E, wave); }
#endif
            GSYNC();
#ifndef NO_WOUT
            { pg8::Gemm g{MB, (const bf16_t*)(ws + WS_WO), M_TOK, DM, DM, DM, 31, 0}; pg8::StaticOrder S; S.init(M_TOK, DM, G, bx);
              EpiResid E{X, XB, SSQ, 1.0f}; pg8::gemm_phase(lds, g, S, E, wave); }
#endif
            GSYNC();
        }
    }
    {
        const float* fg = a.in[I_FINN]; const int lane = lane_id();
        for (int m = gw; m < M_TOK; m += NGW) {
            const float r = rinv_sum(SSQ + (size_t)m * 16, 4, 1.f / DM);
            f32x4* xo = (f32x4*)(X + (size_t)m * DM) + lane; const f32x4* gp = (const f32x4*)fg + lane;
#pragma unroll
            for (int j = 0; j < 4; ++j) { f32x4 v = xo[64 * j]; v = v * r * gp[64 * j]; xo[64 * j] = v; }
        }
    }
}

extern "C" void kernel_launch(void* const* d_in, const int* in_sizes, int n_in, void* d_out, int out_size, void* d_ws, size_t ws_size, hipStream_t stream) {
    static int grid = 0;
    if (grid == 0) {
        if (n_in != 21 || in_sizes[0] != M_TOK * DM || out_size != M_TOK * DM || ws_size < WS_END) {
            fprintf(stderr, "kernel_launch: shape/workspace mismatch (n_in %d, in0 %d, out %d, ws %zu, need %zu)\n", n_in, n_in > 0 ? in_sizes[0] : -1, out_size, ws_size, (size_t)WS_END); grid = -1; return; }
        int dev = 0, cus = 0, per_cu = 0;
        hipGetDevice(&dev); hipDeviceGetAttribute(&cus, hipDeviceAttributeMultiprocessorCount, dev);
        if (hipFuncSetAttribute((const void*)fwd_megakernel, hipFuncAttributeMaxDynamicSharedMemorySize, LDS_BYTES) != hipSuccess) { fprintf(stderr, "kernel_launch: hipFuncSetAttribute failed\n"); grid = -1; return; }
        if (hipOccupancyMaxActiveBlocksPerMultiprocessor(&per_cu, (const void*)fwd_megakernel, 512, LDS_BYTES) != hipSuccess || per_cu < 1) { fprintf(stderr, "kernel_launch: occupancy query failed (%d)\n", per_cu); per_cu = 1; }
        (void)hipGetLastError();
        grid = cus;
    }
    if (grid < 0) return;
    if (hipMemsetAsync((char*)d_ws + WS_BAR, 0, BAR_BYTES, stream) != hipSuccess) { fprintf(stderr, "kernel_launch: memset failed\n"); return; }
    Args a{};
    for (int i = 0; i < 21; ++i) a.in[i] = (const float*)d_in[i];
    a.out = (float*)d_out; a.ws = (unsigned char*)d_ws; a.ph_lo = 0; a.ph_hi = 0;
    void* args[] = {&a};
    hipError_t e = hipLaunchCooperativeKernel((const void*)fwd_megakernel, dim3(grid), dim3(512), args, LDS_BYTES, stream);
    if (e != hipSuccess) fprintf(stderr, "cooperative launch failed: %s (grid %d)\n", hipGetErrorString(e), grid);
}
```

```cpp
#include <hip/hip_runtime.h>
#include <hip/hip_cooperative_groups.h>
#include <cstdio>
#include <cstdint>
namespace cg = cooperative_groups;

#define LAS __attribute__((address_space(3)))
#define GAS __attribute__((address_space(1)))
typedef unsigned short bf16_t;
typedef short bf16x8 __attribute__((ext_vector_type(8)));
typedef short s16x4 __attribute__((ext_vector_type(4)));
typedef float f32x4 __attribute__((ext_vector_type(4)));
typedef float f32x16 __attribute__((ext_vector_type(16)));
typedef unsigned u32x4 __attribute__((ext_vector_type(4)));
typedef unsigned u32x2 __attribute__((ext_vector_type(2)));

constexpr int M_TOK = 16384, SEQ = 8192, DM = 1024, FF = 2816, DEPTH = 4;
constexpr int ZC = 3072;
constexpr int Z_AQ = 0, Z_AK = 512, Z_AV = 1024, Z_BQ = 1536, Z_BK = 2048, Z_BV = 2176, Z_CQ = 2304, Z_CKV = 2688, Z_CKR = 2944;
constexpr float EPS = 1e-6f;
constexpr float LOG2E = 1.4426950408889634f;

constexpr size_t MiB = 1u << 20;
constexpr size_t WS_W13A = 0, WS_W2A = 11 * MiB, WS_W13B = 33 * MiB / 2, WS_W2B = 55 * MiB / 2, WS_WIG = 33 * MiB, WS_WUQ = 45 * MiB,
                 WS_WUKV = 46 * MiB, WS_WB = 47 * MiB, WS_WO = 50 * MiB;
constexpr size_t WS_BAR = 54 * MiB, BAR_BYTES = 65536;
constexpr size_t WS_XB = 56 * MiB, WS_SSQ = 88 * MiB, WS_SSQZ = 89 * MiB, WS_ROPE = 91 * MiB;
constexpr size_t WS_R0 = 96 * MiB;
constexpr size_t WS_G = 192 * MiB, WS_QC = 288 * MiB, WS_KC = 312 * MiB, WS_VC = 336 * MiB, WS_O3 = 352 * MiB, WS_SCR = 400 * MiB, WS_END = 432 * MiB;

typedef float f32x2_t __attribute__((ext_vector_type(2)));
typedef __bf16 bf16x2_t __attribute__((ext_vector_type(2)));
__device__ __forceinline__ unsigned cvt_pk_bf16(float lo, float hi) { f32x2_t v = {lo, hi}; bf16x2_t b = __builtin_convertvector(v, bf16x2_t); return __builtin_bit_cast(unsigned, b); }
__device__ __forceinline__ int lane_id() { int r; asm volatile("v_mbcnt_lo_u32_b32 %0, -1, 0\n\tv_mbcnt_hi_u32_b32 %0, -1, %0" : "=v"(r)); return r; }
__device__ __forceinline__ float uni(float x) { return __int_as_float(__builtin_amdgcn_readfirstlane(__float_as_int(x))); }
__device__ __forceinline__ float shfl_xor_f(float v, int m) { return __int_as_float(__builtin_amdgcn_ds_bpermute((lane_id() ^ m) << 2, __float_as_int(v))); }
__device__ __forceinline__ float bf16_lo(unsigned w) { return __uint_as_float(w << 16); }
__device__ __forceinline__ float bf16_hi(unsigned w) { return __uint_as_float(w & 0xffff0000u); }
__device__ __forceinline__ float fast_rsq(float x) { return __builtin_amdgcn_rsqf(x); }
__device__ __forceinline__ float sum4(f32x4 a) { return (a.x + a.y) + (a.z + a.w); }
__device__ __forceinline__ float dot4(f32x4 a) { return (a.x * a.x + a.y * a.y) + (a.z * a.z + a.w * a.w); }

namespace pg8 {
constexpr int BM = 256, BK = 64, HALF = 128, HTB = HALF * BK * 2, STAGE_BYTES = 8 * HTB, NXCD = 8, WGM = 8;
__host__ __device__ __forceinline__ int lds_byte(int r, int c) { const int st = (r >> 4) * 2 + (c >> 5), rr = r & 15, cc = c & 31, ob = rr * 64 + cc * 2; return st * 1024 + (ob ^ (((ob >> 9) & 1) << 5)); }
__host__ __device__ __forceinline__ void stage_rc(int b, int& R, int& C) { const int st = b / 1024, sb = b % 1024, swz = sb ^ (((sb >> 9) & 1) << 5); R = (st >> 1) * 16 + swz / 64; C = (st & 1) * 32 + (swz % 64) / 2; }
__host__ __device__ __forceinline__ int perm32(int rho) { const int n = rho >> 4, i = rho & 15; return 8 * (i >> 2) + 4 * n + (i & 3); }

struct Unit { int pm, pn; };
struct Gemm { const bf16_t* A; const bf16_t* Bt; int M, N, K, lda, a_pn_shift, a_pn_stride; };

struct StaticOrder {
    int nM, nN, nwg, G, c;
    __device__ void init(int M, int N, int G_, int c_) { nM = M / BM; nN = N / BM; nwg = nM * nN; G = G_; c = c_; }
    __device__ bool next(int i, Unit& u) const {
        const long L = (long)i * G + c; if (L >= nwg) return false;
        int wgid = (int)L; { const int q = nwg / NXCD, r = nwg % NXCD, xcd = wgid % NXCD, off = wgid / NXCD; wgid = (xcd < r ? xcd * (q + 1) : r * (q + 1) + (xcd - r) * q) + off; }
        const int nig = WGM * nN, gid = wgid / nig, fm = gid * WGM, gsz = (nM - fm) < WGM ? (nM - fm) : WGM;
        u.pm = fm + ((wgid % nig) % gsz); u.pn = (wgid % nig) / gsz; return true;
    }
};
struct BranchOrder {
    StaticOrder so;
    __device__ void init(int G_, int c_) { so.init(M_TOK, DM, G_, c_); }
    __device__ bool next(int i, Unit& u) const { const int j = i / 3, n = i - 3 * j; Unit b; if (!so.next(j, b)) return false; u.pm = b.pm; u.pn = n * 4 + b.pn; return true; }
};

template <class Epi, class Sched>
__device__ __forceinline__ void gemm_phase(LAS unsigned char* lds, const Gemm g, const Sched& S, const Epi& E, int wave_) {
    int tid = wave_ * 64 + lane_id(); asm volatile("" : "+v"(tid));
    const int wid = __builtin_amdgcn_readfirstlane(tid >> 6), lane = tid & 63, wr = wid >> 2, wc = wid & 3, fr = lane & 15, fq = lane >> 4;
    const int K = g.K, nt = K / BK, lda = g.lda;
    const bf16_t* gA = g.A; const bf16_t* gB = g.Bt; asm volatile("" : "+s"(gA), "+s"(gB));
    unsigned voffA[2], voffB[2];
#pragma unroll
    for (int i = 0; i < 2; ++i) { int R, C; stage_rc(tid * 16 + i * 8192, R, C); const int Rb = Epi::PERM ? ((R & ~31) + perm32(R & 31)) : R;
        voffA[i] = (unsigned)(R * lda + C) * 2u; voffB[i] = (unsigned)(Rb * K + C) * 2u; }
    const size_t kstep = (size_t)(BK * 2);
    const size_t hstepA = (size_t)HALF * lda * 2, hstepB = (size_t)HALF * K * 2;
    const size_t tstepA = 2 * hstepA, tstepB = 2 * hstepB;
    const unsigned ldsw = (unsigned)wid * 1024u;
    const int aoff = lds_byte(wr * 64 + fr, fq * 8), boff = lds_byte(wc * 32 + fr, fq * 8);
#define PG8_SA(b, h) (((b) * 2 + (h)) * HTB)
#define PG8_SB(b, h) ((4 + (b) * 2 + (h)) * HTB)
#define PG8_STAGE(bufoff, gbase, voff) do { _Pragma("unroll") for (int _i = 0; _i < 2; ++_i) \
        __builtin_amdgcn_global_load_lds((const unsigned*)((const char*)(gbase) + (voff)[_i]), (LAS unsigned*)(lds + (bufoff) + ldsw + _i * 8192), 16, 0, 0); } while (0)
#define PG8_LDA(dst, b, h) do { _Pragma("unroll") for (int m = 0; m < 4; ++m) _Pragma("unroll") for (int k = 0; k < 2; ++k) dst[m][k] = *(const LAS bf16x8*)(lds + PG8_SA(b, h) + aoff + m * 2048 + k * 1024); } while (0)
#define PG8_LDB(dst, b, h) do { _Pragma("unroll") for (int n = 0; n < 2; ++n) _Pragma("unroll") for (int k = 0; k < 2; ++k) dst[n][k] = *(const LAS bf16x8*)(lds + PG8_SB(b, h) + boff + n * 2048 + k * 1024); } while (0)
#define PG8_MMA(ai, bj, At, Bt) do { __builtin_amdgcn_s_setprio(1); _Pragma("unroll") for (int m = 0; m < 4; ++m) _Pragma("unroll") for (int n = 0; n < 2; ++n) _Pragma("unroll") for (int k = 0; k < 2; ++k) \
        acc[ai][bj][m][n] = __builtin_amdgcn_mfma_f32_16x16x32_bf16(Bt[n][k], At[m][k], acc[ai][bj][m][n], 0, 0, 0); __builtin_amdgcn_s_setprio(0); } while (0)
#define PG8_WAIT_V(n) asm volatile("s_waitcnt vmcnt(" #n ")" ::: "memory")
#define PG8_WAIT_L(n) asm volatile("s_waitcnt lgkmcnt(" #n ")" ::: "memory")
#define PG8_BAR __builtin_amdgcn_s_barrier()
#define PG8_SCHED __builtin_amdgcn_sched_barrier(0)
#define PG8_APTR(u) ((const char*)gA + (size_t)(u).pm * tstepA + (size_t)((u).pn >> g.a_pn_shift) * (size_t)g.a_pn_stride)
    Unit cur, nxt; int ui = 0;
    if (!S.next(0, cur)) return;
    f32x4 acc[2][2][4][2];
#pragma unroll
    for (int a = 0; a < 2; ++a)
#pragma unroll
        for (int b = 0; b < 2; ++b)
#pragma unroll
            for (int m = 0; m < 4; ++m)
#pragma unroll
                for (int n = 0; n < 2; ++n) acc[a][b][m][n] = (f32x4){0.f, 0.f, 0.f, 0.f};
    bf16x8 At[4][2], B0[2][2], B1[2][2];
    const char* cA = PG8_APTR(cur); const char* cB = (const char*)gB + (size_t)cur.pn * tstepB;
    PG8_STAGE(PG8_SB(0, 0), cB, voffB); PG8_STAGE(PG8_SB(0, 1), cB + hstepB, voffB); PG8_STAGE(PG8_SA(0, 0), cA, voffA); PG8_STAGE(PG8_SA(0, 1), cA + hstepA, voffA);
    if (wr == 1) PG8_BAR;
    PG8_WAIT_V(2); PG8_BAR;
    PG8_STAGE(PG8_SB(1, 0), cB + kstep, voffB); PG8_STAGE(PG8_SA(1, 0), cA + kstep, voffA); PG8_STAGE(PG8_SB(1, 1), cB + hstepB + kstep, voffB);
    PG8_WAIT_V(6); PG8_BAR;
    for (;;) {
        const bool has_next = S.next(ui + 1, nxt);
        const char* nA = has_next ? PG8_APTR(nxt) : cA; const char* nB = has_next ? (const char*)gB + (size_t)nxt.pn * tstepB : cB;
        for (int t = 0; t < nt; t += 2) {
            const bool last = (t == nt - 2);
            const char* a1 = cA + (size_t)(t + 1) * kstep;
            const char* a2 = last ? nA : cA + (size_t)(t + 2) * kstep; const char* b2 = last ? nB : cB + (size_t)(t + 2) * kstep;
            const char* a3 = a2 + kstep; const char* b3 = b2 + kstep;
            PG8_LDB(B0, 0, 0); PG8_LDB(B1, 0, 1); PG8_SCHED; PG8_LDA(At, 0, 0); PG8_STAGE(PG8_SA(1, 1), a1 + hstepA, voffA);
            PG8_WAIT_V(8); PG8_WAIT_L(0); PG8_BAR; PG8_MMA(0, 0, At, B0); PG8_MMA(0, 1, At, B1); PG8_BAR; PG8_SCHED;
            PG8_LDA(At, 0, 1); PG8_STAGE(PG8_SB(0, 0), b2, voffB); PG8_STAGE(PG8_SB(0, 1), b2 + hstepB, voffB); PG8_STAGE(PG8_SA(0, 0), a2, voffA);
            PG8_WAIT_V(8); PG8_WAIT_L(0); PG8_BAR; PG8_MMA(1, 0, At, B0); PG8_MMA(1, 1, At, B1); PG8_BAR; PG8_SCHED;
            PG8_LDB(B0, 1, 0); PG8_LDB(B1, 1, 1); PG8_SCHED; PG8_LDA(At, 1, 0); PG8_STAGE(PG8_SA(0, 1), a2 + hstepA, voffA);
            PG8_WAIT_V(8); PG8_WAIT_L(0); PG8_BAR; PG8_MMA(0, 0, At, B0); PG8_MMA(0, 1, At, B1); PG8_BAR; PG8_SCHED;
            PG8_LDA(At, 1, 1); PG8_STAGE(PG8_SB(1, 0), b3, voffB); PG8_STAGE(PG8_SB(1, 1), b3 + hstepB, voffB); PG8_STAGE(PG8_SA(1, 0), a3, voffA);
            PG8_WAIT_V(8); PG8_WAIT_L(0); PG8_BAR; PG8_MMA(1, 0, At, B0); PG8_MMA(1, 1, At, B1); PG8_BAR; PG8_SCHED;
        }
        if (wr == 0) PG8_BAR;
        E(acc, cur, wr, wc, fr, fq);
        if (!has_next) break;
#pragma unroll
        for (int a = 0; a < 2; ++a)
#pragma unroll
            for (int b = 0; b < 2; ++b)
#pragma unroll
                for (int m = 0; m < 4; ++m)
#pragma unroll
                    for (int n = 0; n < 2; ++n) acc[a][b][m][n] = (f32x4){0.f, 0.f, 0.f, 0.f};
        cur = nxt; cA = nA; cB = nB; ++ui;
        if (wr == 1) PG8_BAR;
    }
    PG8_WAIT_V(0);
    PG8_BAR;
#undef PG8_SA
#undef PG8_SB
#undef PG8_STAGE
#undef PG8_LDA
#undef PG8_LDB
#undef PG8_MMA
#undef PG8_WAIT_V
#undef PG8_WAIT_L
#undef PG8_BAR
#undef PG8_SCHED
#undef PG8_APTR
}
}

typedef f32x4 Acc[2][2][4][2];
__device__ __forceinline__ float rinv_sum(const float* p, int n4, float invn) {
    float s = 0.f;
#pragma unroll
    for (int i = 0; i < 5; ++i) if (i < n4) s += sum4(*(const f32x4*)(p + 4 * i));
    return fast_rsq(s * invn + EPS);
}
__device__ __forceinline__ float silu_mul(float a, float g) { return a * __builtin_amdgcn_rcpf(1.f + __builtin_amdgcn_exp2f(-a * LOG2E)) * g; }
__device__ __forceinline__ float sigmoidf(float a) { return __builtin_amdgcn_rcpf(1.f + __builtin_amdgcn_exp2f(-a * LOG2E)); }
__device__ __forceinline__ u32x4 pack8(f32x4 v0, f32x4 v1) { u32x4 w; w.x = cvt_pk_bf16(v0[0], v0[1]); w.y = cvt_pk_bf16(v0[2], v0[3]); w.z = cvt_pk_bf16(v1[0], v1[1]); w.w = cvt_pk_bf16(v1[2], v1[3]); return w; }

struct EpiSwiGLU {
    static constexpr bool PERM = true;
    bf16_t* H; const float* ssq;
    __device__ __forceinline__ void operator()(const Acc& acc, const pg8::Unit& u, int wr, int wc, int fr, int fq) const {
        const int row0 = u.pm * 256 + wr * 64 + fr, col0 = u.pn * 128 + wc * 32 + 8 * fq;
#pragma unroll
        for (int ai = 0; ai < 2; ++ai)
#pragma unroll
            for (int m = 0; m < 4; ++m) { const int row = row0 + ai * 128 + m * 16; const float r = rinv_sum(ssq + (size_t)row * 16, 4, 1.f / DM);
                f32x4 h0, h1;
#pragma unroll
                for (int j = 0; j < 4; ++j) { h0[j] = silu_mul(acc[ai][0][m][0][j] * r, acc[ai][1][m][0][j] * r); h1[j] = silu_mul(acc[ai][0][m][1][j] * r, acc[ai][1][m][1][j] * r); }
                *(u32x4*)(H + (size_t)row * FF + col0) = pack8(h0, h1); asm volatile("" ::: "memory"); }
    }
};
struct EpiResid {
    static constexpr bool PERM = false;
    float* x; bf16_t* xb; float* ssq; float coef;
    __device__ __forceinline__ void operator()(const Acc& acc, const pg8::Unit& u, int wr, int wc, int fr, int fq) const {
        const int row0 = u.pm * 256 + wr * 64 + fr, col0 = u.pn * 256 + wc * 32 + 4 * fq;
#pragma unroll
        for (int ai = 0; ai < 2; ++ai) {
            f32x4 xv[4][2][2];
#pragma unroll
            for (int m = 0; m < 4; ++m)
#pragma unroll
                for (int bj = 0; bj < 2; ++bj)
#pragma unroll
                    for (int n = 0; n < 2; ++n) xv[m][bj][n] = *(const f32x4*)(x + (size_t)(row0 + ai * 128 + m * 16) * DM + col0 + bj * 128 + n * 16);
#pragma unroll
            for (int m = 0; m < 4; ++m) { const int row = row0 + ai * 128 + m * 16; float s = 0.f;
#pragma unroll
                for (int bj = 0; bj < 2; ++bj)
#pragma unroll
                    for (int n = 0; n < 2; ++n) { const size_t off = (size_t)row * DM + col0 + bj * 128 + n * 16;
                        const f32x4 v = xv[m][bj][n] + acc[ai][bj][m][n] * coef;
                        *(f32x4*)(x + off) = v; s += dot4(v);
                        u32x2 w; w.x = cvt_pk_bf16(v[0], v[1]); w.y = cvt_pk_bf16(v[2], v[3]); *(u32x2*)(xb + off) = w; }
                s += shfl_xor_f(s, 16); s += shfl_xor_f(s, 32);
                if (fq == 0) ssq[(size_t)row * 16 + u.pn * 4 + wc] = s; }
            asm volatile("" ::: "memory"); }
    }
};
struct EpiInProj {
    static constexpr bool PERM = true;
    bf16_t* Z; bf16_t* Gt; bf16_t* KC; const float* ssq; float* ssqz; const float* bgate; const float* ropeC; const float* ropeS;
    __device__ __forceinline__ void operator()(const Acc& acc, const pg8::Unit& u, int wr, int wc, int fr, int fq) const {
        const int row0 = u.pm * 256 + wr * 64 + fr, cw = wc * 32 + 8 * fq;
        if (u.pn < 12) {
#pragma unroll
            for (int ai = 0; ai < 2; ++ai)
#pragma unroll
                for (int m = 0; m < 4; ++m) { const int row = row0 + ai * 128 + m * 16; const float r = rinv_sum(ssq + (size_t)row * 16, 4, 1.f / DM);
#pragma unroll
                    for (int bj = 0; bj < 2; ++bj) { f32x4 v0 = acc[ai][bj][m][0] * r, v1 = acc[ai][bj][m][1] * r;
                        if (u.pn >= 9) { float s = dot4(v0) + dot4(v1); s += shfl_xor_f(s, 16); s += shfl_xor_f(s, 32);
                            if (fq == 0) ssqz[(size_t)row * 24 + (u.pn - 9) * 8 + bj * 4 + wc] = s; }
                        if (u.pn == 11 && bj == 1 && wc < 2) {
                            const int pos = row & (SEQ - 1), j0 = 16 * wc + 4 * fq;
                            const f32x4 c = *(const f32x4*)(ropeC + pos * 32 + j0), s = *(const f32x4*)(ropeS + pos * 32 + j0);
                            f32x4 o0, o1;
                            o0[0] = v0[0] * c[0] - v0[1] * s[0]; o0[1] = v0[0] * s[0] + v0[1] * c[0]; o0[2] = v0[2] * c[1] - v0[3] * s[1]; o0[3] = v0[2] * s[1] + v0[3] * c[1];
                            o1[0] = v1[0] * c[2] - v1[1] * s[2]; o1[1] = v1[0] * s[2] + v1[1] * c[2]; o1[2] = v1[2] * c[3] - v1[3] * s[3]; o1[3] = v1[2] * s[3] + v1[3] * c[3];
                            const u32x4 w = pack8(o0, o1);
#pragma unroll
                            for (int h = 0; h < 4; ++h) *(u32x4*)(KC + (size_t)row * 768 + h * 192 + 128 + cw) = w;
                        }
                        *(u32x4*)(Z + (size_t)row * ZC + u.pn * 256 + bj * 128 + cw) = pack8(v0, v1); } asm volatile("" ::: "memory"); }
        } else {
            const int gc0 = (u.pn - 12) * 256 + cw;
#pragma unroll
            for (int bj = 0; bj < 2; ++bj) { const f32x4 b0 = *(const f32x4*)(bgate + gc0 + bj * 128), b1 = *(const f32x4*)(bgate + gc0 + bj * 128 + 4);
#pragma unroll
                for (int ai = 0; ai < 2; ++ai)
#pragma unroll
                    for (int m = 0; m < 4; ++m) { const int row = row0 + ai * 128 + m * 16; const float r = rinv_sum(ssq + (size_t)row * 16, 4, 1.f / DM);
                        f32x4 v0 = acc[ai][bj][m][0] * r + b0, v1 = acc[ai][bj][m][1] * r + b1;
#pragma unroll
                        for (int j = 0; j < 4; ++j) { v0[j] = sigmoidf(v0[j]); v1[j] = sigmoidf(v1[j]); }
                        *(u32x4*)(Gt + (size_t)row * 3072 + gc0 + bj * 128) = pack8(v0, v1); asm volatile("" ::: "memory"); } }
        }
    }
};
struct EpiUQ {
    static constexpr bool PERM = true;
    bf16_t* QC; const float* ssqz; const float* ropeC; const float* ropeS;
    __device__ __forceinline__ void operator()(const Acc& acc, const pg8::Unit& u, int wr, int wc, int fr, int fq) const {
        const int row0 = u.pm * 256 + wr * 64 + fr;
#pragma unroll
        for (int ai = 0; ai < 2; ++ai)
#pragma unroll
            for (int m = 0; m < 4; ++m) { const int row = row0 + ai * 128 + m * 16; const float r = rinv_sum(ssqz + (size_t)row * 24, 3, 1.f / 384.f);
#pragma unroll
                for (int bj = 0; bj < 2; ++bj) { const int c = u.pn * 256 + bj * 128 + wc * 32 + 8 * fq; const int e = c % 192;
                    f32x4 v0 = acc[ai][bj][m][0] * r, v1 = acc[ai][bj][m][1] * r;
                    if (e >= 128) { const int pos = row & (SEQ - 1), j0 = (e - 128) >> 1;
                        const f32x4 cc = *(const f32x4*)(ropeC + pos * 32 + j0), s = *(const f32x4*)(ropeS + pos * 32 + j0);
                        f32x4 o0, o1;
                        o0[0] = v0[0] * cc[0] - v0[1] * s[0]; o0[1] = v0[0] * s[0] + v0[1] * cc[0]; o0[2] = v0[2] * cc[1] - v0[3] * s[1]; o0[3] = v0[2] * s[1] + v0[3] * cc[1];
                        o1[0] = v1[0] * cc[2] - v1[1] * s[2]; o1[1] = v1[0] * s[2] + v1[1] * cc[2]; o1[2] = v1[2] * cc[3] - v1[3] * s[3]; o1[3] = v1[2] * s[3] + v1[3] * cc[3];
                        v0 = o0; v1 = o1; }
                    *(u32x4*)(QC + (size_t)row * 768 + c) = pack8(v0, v1); } asm volatile("" ::: "memory"); }
    }
};
struct EpiUKV {
    static constexpr bool PERM = true;
    bf16_t* KC; bf16_t* VC; const float* ssqz;
    __device__ __forceinline__ void operator()(const Acc& acc, const pg8::Unit& u, int wr, int wc, int fr, int fq) const {
        const int row0 = u.pm * 256 + wr * 64 + fr, cw = wc * 32 + 8 * fq, h = u.pn;
#pragma unroll
        for (int ai = 0; ai < 2; ++ai)
#pragma unroll
            for (int m = 0; m < 4; ++m) { const int row = row0 + ai * 128 + m * 16; const float r = rinv_sum(ssqz + (size_t)row * 24 + 12, 2, 1.f / 256.f);
                *(u32x4*)(KC + (size_t)row * 768 + h * 192 + cw) = pack8(acc[ai][0][m][0] * r, acc[ai][0][m][1] * r);
                *(u32x4*)(VC + (size_t)row * 512 + h * 128 + cw) = pack8(acc[ai][1][m][0] * r, acc[ai][1][m][1] * r); asm volatile("" ::: "memory"); }
    }
};
struct EpiGateAcc {
    static constexpr bool PERM = false;
    const bf16_t* Gt; float* mg; bf16_t* MB;
    __device__ __forceinline__ void operator()(const Acc& acc, const pg8::Unit& u, int wr, int wc, int fr, int fq) const {
        const int nb = u.pn >> 2, pno = u.pn & 3;
        const int row0 = u.pm * 256 + wr * 64 + fr, col0 = pno * 256 + wc * 32 + 4 * fq;
#pragma unroll
        for (int ai = 0; ai < 2; ++ai)
#pragma unroll
            for (int m = 0; m < 4; ++m) { const int row = row0 + ai * 128 + m * 16;
#pragma unroll
                for (int bj = 0; bj < 2; ++bj)
#pragma unroll
                    for (int n = 0; n < 2; ++n) { const int col = col0 + bj * 128 + n * 16; const size_t off = (size_t)row * DM + col;
                        const u32x2 gw = *(const u32x2*)(Gt + (size_t)row * 3072 + nb * 1024 + col);
                        f32x4 v = acc[ai][bj][m][n]; v[0] *= bf16_lo(gw.x); v[1] *= bf16_hi(gw.x); v[2] *= bf16_lo(gw.y); v[3] *= bf16_hi(gw.y);
                        if (nb > 0) v += *(const f32x4*)(mg + off);
                        if (nb < 2) *(f32x4*)(mg + off) = v;
                        else { u32x2 w; w.x = cvt_pk_bf16(v[0], v[1]); w.y = cvt_pk_bf16(v[2], v[3]); *(u32x2*)(MB + off) = w; } } asm volatile("" ::: "memory"); }
    }
};

#ifdef A_SIMPLE
#define ATT_A_BODY att::attn_body_simple<64, 128, 1, ZC, ZC, ZC>
#else
#define ATT_A_BODY att::attn_body<64, 128, 1, 1, ZC, ZC, ZC>
#endif
namespace att {
#define SBAR() __builtin_amdgcn_sched_barrier(0)
__device__ __forceinline__ int crow(int r, int hi) { return (r & 3) + 8 * (r >> 2) + 4 * hi; }
template <int DQK> __device__ __forceinline__ int kswz(int row, int colB) { return row * (DQK * 2) + (colB ^ (((row >> 1) & 7) << 4)); }
template <int DV> __device__ __forceinline__ int v_st(int k, int c) { constexpr int NCB = DV / 32; const int kk = (k & ~0xC) | ((k & 4) << 1) | ((k & 8) >> 1); return ((kk >> 3) * NCB + (c >> 5)) * 512 + ((kk & 7) * 32 + (c & 31)) * 2; }
__device__ __forceinline__ int v_rd_base(int lane) { return ((lane & 3) << 3) | (((lane >> 2) & 3) << 6) | (((lane >> 4) & 1) << 5) | (((lane >> 5) & 1) << 8); }
template <int DV> constexpr int v_rd_off(int d0, int ks, int half) { return d0 * 512 + ks * (2 * (DV / 32) * 512) + half * ((DV / 32) * 512); }
template <int OFF> __device__ __forceinline__ s16x4 tr_read(int vb) { s16x4 r; asm volatile("ds_read_b64_tr_b16 %0, %1 offset:%2" : "=&v"(r) : "v"(vb), "i"(OFF) : "memory"); return r; }

__device__ __forceinline__ void partialSM(f32x16& p0, f32x16& p1, float& m_reg, float& mn, float& alpha, float C, float thr, float aoff = 0.f, bool nomax = false) {
    if (nomax) { mn = m_reg; alpha = 1.f; }
    else {
    float pmax = p0[0];
#pragma unroll
    for (int r = 1; r < 16; ++r) pmax = fmaxf(pmax, p0[r]);
#pragma unroll
    for (int r = 0; r < 16; ++r) pmax = fmaxf(pmax, p1[r]);
    pmax += aoff;
    { auto rr = __builtin_amdgcn_permlane32_swap(__float_as_uint(pmax), __float_as_uint(pmax), false, false); pmax = fmaxf(__uint_as_float(rr[0]), __uint_as_float(rr[1])); }
    if (__builtin_expect(__all(pmax - m_reg <= thr), 1)) { mn = m_reg; alpha = 1.f; }
    else { mn = fmaxf(m_reg, pmax); alpha = __builtin_amdgcn_exp2f((m_reg - mn) * C); m_reg = mn; }
    }
    const float mnC = mn < -1e29f ? 0.f : (aoff - mn) * C;
#pragma unroll
    for (int r = 0; r < 16; ++r) p0[r] = fmaf(p0[r], C, mnC);
#pragma unroll
    for (int r = 0; r < 16; ++r) p1[r] = fmaf(p1[r], C, mnC);
#pragma unroll
    for (int r = 0; r < 16; ++r) p0[r] = __builtin_amdgcn_exp2f(p0[r]);
}
__device__ __forceinline__ void finishSM(f32x16& p0, f32x16& p1, float alpha, float& l_reg, bf16x8& pa0, bf16x8& pa1, bf16x8& pa2, bf16x8& pa3) {
#pragma unroll
    for (int r = 0; r < 16; ++r) p1[r] = __builtin_amdgcn_exp2f(p1[r]);
    float ps = 0;
#pragma unroll
    for (int r = 0; r < 16; ++r) ps += p0[r];
#pragma unroll
    for (int r = 0; r < 16; ++r) ps += p1[r];
    { auto rr = __builtin_amdgcn_permlane32_swap(__float_as_uint(ps), __float_as_uint(ps), false, false); ps = __uint_as_float(rr[0]) + __uint_as_float(rr[1]); }
    l_reg = l_reg * alpha + ps;
#define PK4(P, BASE, OUT) do { unsigned a0 = cvt_pk_bf16(P[BASE + 0], P[BASE + 1]), a1 = cvt_pk_bf16(P[BASE + 2], P[BASE + 3]);   \
    unsigned b0 = cvt_pk_bf16(P[BASE + 4], P[BASE + 5]), b1 = cvt_pk_bf16(P[BASE + 6], P[BASE + 7]);                              \
    auto r0 = __builtin_amdgcn_permlane32_swap(a0, b0, false, false); auto r1 = __builtin_amdgcn_permlane32_swap(a1, b1, false, false); \
    u32x4 w = {r0[0], r1[0], r0[1], r1[1]}; OUT = *reinterpret_cast<bf16x8*>(&w); } while (0)
    PK4(p0, 0, pa0); PK4(p0, 8, pa1); PK4(p1, 0, pa2); PK4(p1, 8, pa3);
#undef PK4
}
template <int MODE> __device__ __forceinline__ float alibi_off(int rel, float dq, float sl) { return (MODE == 1 && (rel > 63 || rel < -31)) ? (rel > 63 ? -sl : sl) * dq : 0.f; }
template <int DQK, int MODE, int NQR = DQK / 16> __device__ __forceinline__ void qkt(f32x16& p0, f32x16& p1, LAS const char* Ks, const bf16x8* qr, int r32, int hi, float dq, float sl, LAS const char* qlds = nullptr, int rel = 0) {
    p0 = f32x16{}; p1 = f32x16{};
    if (NQR < DQK / 16) asm volatile("" : "+v"(qlds));
    const int x_ = ((r32 >> 1) & 7) << 4; int kb[4];
#pragma unroll
    for (int j = 0; j < 4; ++j) kb[j] = r32 * (DQK * 2) + ((j * 32 + hi * 16) ^ x_);
#pragma unroll
    for (int d0 = 0; d0 < DQK / 16; ++d0) {
        bf16x8 qf; if (d0 < NQR) qf = qr[d0 < NQR ? d0 : 0]; else qf = *(LAS const bf16x8*)(qlds + (d0 - NQR) * 1024);
        const bf16x8 b0 = *(LAS const bf16x8*)(Ks + kb[d0 & 3] + (d0 >> 2) * 128);
        const bf16x8 b1 = *(LAS const bf16x8*)(Ks + kb[d0 & 3] + (d0 >> 2) * 128 + 32 * (DQK * 2));
        p0 = __builtin_amdgcn_mfma_f32_32x32x16_bf16(b0, qf, p0, 0, 0, 0);
        p1 = __builtin_amdgcn_mfma_f32_32x32x16_bf16(b1, qf, p1, 0, 0, 0); }
    if (MODE == 1 && (rel > 63 || rel < -31)) {
        const float ss = rel > 63 ? sl : -sl;
#pragma unroll
        for (int r = 0; r < 16; ++r) { const float c = (float)((r & 3) + 8 * (r >> 2)); p0[r] = fmaf(ss, c, p0[r]); p1[r] = fmaf(ss, c + 32.f, p1[r]); }
    } else if (MODE != 0) {
#pragma unroll
        for (int r = 0; r < 16; ++r) { const float c = (float)((r & 3) + 8 * (r >> 2)); const float d0 = fabsf(dq - c), d1 = fabsf(dq - 32.f - c);
            if (MODE == 1) { p0[r] = fmaf(-sl, d0, p0[r]); p1[r] = fmaf(-sl, d1, p1[r]); }
            else { p0[r] = d0 > 128.f ? -1e30f : fmaf(-sl, d0, p0[r]); p1[r] = d1 > 128.f ? -1e30f : fmaf(-sl, d1, p1[r]); } }
    }
}
template <int D0, int DV> __device__ __forceinline__ void pv_one(f32x16& od, int vb, bf16x8 pa0, bf16x8 pa1, bf16x8 pa2, bf16x8 pa3) {
    const s16x4 l0 = tr_read<v_rd_off<DV>(D0, 0, 0)>(vb), h0 = tr_read<v_rd_off<DV>(D0, 0, 1)>(vb), l1 = tr_read<v_rd_off<DV>(D0, 1, 0)>(vb), h1 = tr_read<v_rd_off<DV>(D0, 1, 1)>(vb);
    const s16x4 l2 = tr_read<v_rd_off<DV>(D0, 2, 0)>(vb), h2 = tr_read<v_rd_off<DV>(D0, 2, 1)>(vb), l3 = tr_read<v_rd_off<DV>(D0, 3, 0)>(vb), h3 = tr_read<v_rd_off<DV>(D0, 3, 1)>(vb);
    asm volatile("s_waitcnt lgkmcnt(0)" ::: "memory"); SBAR();
#define PK(L, H) (bf16x8){L[0], L[1], L[2], L[3], H[0], H[1], H[2], H[3]}
    od = __builtin_amdgcn_mfma_f32_32x32x16_bf16(pa0, PK(l0, h0), od, 0, 0, 0);
    od = __builtin_amdgcn_mfma_f32_32x32x16_bf16(pa1, PK(l1, h1), od, 0, 0, 0);
    od = __builtin_amdgcn_mfma_f32_32x32x16_bf16(pa2, PK(l2, h2), od, 0, 0, 0);
    od = __builtin_amdgcn_mfma_f32_32x32x16_bf16(pa3, PK(l3, h3), od, 0, 0, 0);
#undef PK
}
template <int DV> __device__ __forceinline__ void pv_all(f32x16* o, int vb, bf16x8 pa0, bf16x8 pa1, bf16x8 pa2, bf16x8 pa3) {
    pv_one<0, DV>(o[0], vb, pa0, pa1, pa2, pa3); pv_one<1, DV>(o[1], vb, pa0, pa1, pa2, pa3);
    if constexpr (DV == 128) { pv_one<2, DV>(o[2], vb, pa0, pa1, pa2, pa3); pv_one<3, DV>(o[3], vb, pa0, pa1, pa2, pa3); }
}

template <int DQK, int DV, int MODE, int SD, int LDQ, int LDK, int LDV, int NQL = 0, class Epi>
__device__ __forceinline__ void attn_body(const bf16_t* __restrict__ Qb, const bf16_t* __restrict__ Kh, const bf16_t* __restrict__ Vh, int kstart, int NT, int qpos0,
                                          float scale, float slope, float sinkl2, LAS char* lds, const Epi& epi, int wave_, int safe_nomax = 0) {
    asm volatile("" : "+s"(Qb), "+s"(Kh), "+s"(Vh));
    constexpr int SHM_V = 64 * DV * 2, SHM_K = 64 * DQK * 2, NQ = DQK / 16, NO = DV / 32;
    constexpr int KCH = DQK / 8, NKC = 64 * KCH / 512, VCH = DV / 8, NVC = 64 * VCH / 512;
    int tid = wave_ * 64 + lane_id(); asm volatile("" : "+v"(tid));
    const int wid = tid >> 6, lane = tid & 63, r32 = lane & 31, hi = lane >> 5;
    LAS char* V_lds = lds; LAS char* K_lds = lds + 2 * SHM_V;
    LAS float* wsf = (LAS float*)(lds + 2 * SHM_V + 2 * SHM_K) + wid * 64; LAS float* li_l = wsf; LAS float* al_l = wsf + 32;
    const float C = scale * LOG2E, thr = 8.f / scale, sl = slope / scale;
    const float dq0 = (float)(qpos0 + wid * 32 + r32 - kstart - 4 * hi);
    constexpr int NQR = NQ - NQL;
    LAS char* qlds = lds + 2 * SHM_V + 2 * SHM_K + 2048 + wid * (NQL * 1024) + lane * 16;
    float m_reg = -1e30f, l_reg = 0; f32x16 o[NO]; bf16x8 qr[NQR > 0 ? NQR : 1];
#pragma unroll
    for (int d = 0; d < NO; ++d) o[d] = f32x16{};
    const GAS bf16_t* Qw = (const GAS bf16_t*)Qb + (size_t)(wid * 32 + r32) * LDQ + hi * 8;
#pragma unroll
    for (int d0 = 0; d0 < NQ; ++d0) { const bf16x8 qv = *(const GAS bf16x8*)(Qw + d0 * 16); if (d0 < NQR) qr[d0 < NQR ? d0 : 0] = qv; else *(LAS bf16x8*)(qlds + (d0 - NQR) * 1024) = qv; }
    int koff[NKC], kst[NKC], voff[NVC], vst[NVC];
#pragma unroll
    for (int i = 0; i < NKC; ++i) { const int c = tid + 512 * i, row = c / KCH, c8 = c % KCH; koff[i] = row * LDK + c8 * 8; kst[i] = kswz<DQK>(row, c8 * 16); }
#pragma unroll
    for (int i = 0; i < NVC; ++i) { const int c = tid + 512 * i, row = c / VCH, c8 = c % VCH; voff[i] = row * LDV + c8 * 8; vst[i] = v_st<DV>(row, c8 * 8); }
    const int vb0 = (int)(unsigned)(size_t)V_lds + v_rd_base(lane);
    struct { bf16x8 k[NKC]; bf16x8 v[NVC]; } sr_[SD];
    const GAS bf16_t* Kp = (const GAS bf16_t*)Kh + (size_t)kstart * LDK; const GAS bf16_t* Vp = (const GAS bf16_t*)Vh + (size_t)kstart * LDV;
#define SLOAD(i, k0) do { if constexpr (NQL > 0) { int t_ = tid; asm volatile("" : "+v"(t_)); \
      _Pragma("unroll") for (int _c = 0; _c < NVC; ++_c) { const int c_ = t_ + 512 * _c; sr_[i].v[_c] = *(const GAS bf16x8*)(Vp + (size_t)((k0) + c_ / VCH) * LDV + (c_ % VCH) * 8); } \
      _Pragma("unroll") for (int _c = 0; _c < NKC; ++_c) { const int c_ = t_ + 512 * _c; sr_[i].k[_c] = *(const GAS bf16x8*)(Kp + (size_t)((k0) + c_ / KCH) * LDK + (c_ % KCH) * 8); } } else { \
    _Pragma("unroll") for (int _c = 0; _c < NVC; ++_c) sr_[i].v[_c] = *(const GAS bf16x8*)(Vp + (size_t)(k0) * LDV + voff[_c]); \
    _Pragma("unroll") for (int _c = 0; _c < NKC; ++_c) sr_[i].k[_c] = *(const GAS bf16x8*)(Kp + (size_t)(k0) * LDK + koff[_c]); } } while (0)
#define SWRITE(b, i) do { if constexpr (NQL > 0) { int t_ = tid; asm volatile("" : "+v"(t_)); \
      _Pragma("unroll") for (int _c = 0; _c < NVC; ++_c) { const int c_ = t_ + 512 * _c; *(LAS bf16x8*)(V_lds + (b) * SHM_V + v_st<DV>(c_ / VCH, (c_ % VCH) * 8)) = sr_[i].v[_c]; } \
      _Pragma("unroll") for (int _c = 0; _c < NKC; ++_c) { const int c_ = t_ + 512 * _c; *(LAS bf16x8*)(K_lds + (b) * SHM_K + kswz<DQK>(c_ / KCH, (c_ % KCH) * 16)) = sr_[i].k[_c]; } } else { \
    _Pragma("unroll") for (int _c = 0; _c < NVC; ++_c) *(LAS bf16x8*)(V_lds + (b) * SHM_V + vst[_c]) = sr_[i].v[_c]; \
    _Pragma("unroll") for (int _c = 0; _c < NKC; ++_c) *(LAS bf16x8*)(K_lds + (b) * SHM_K + kst[_c]) = sr_[i].k[_c]; } } while (0)
#define RESC(a) do { if (__any((a) < 1.f)) { if (hi == 0) al_l[r32] = (a); asm volatile("s_waitcnt lgkmcnt(0)" ::: "memory"); \
    _Pragma("unroll") for (int d = 0; d < NO; ++d) _Pragma("unroll") for (int r = 0; r < 16; ++r) o[d][r] *= al_l[crow(r, hi)]; } } while (0)
    f32x16 pA0, pA1, pB0, pB1; float mnA, mnB, alA, alB; bf16x8 pa0, pa1, pa2, pa3;
    const int rel0 = qpos0 + __builtin_amdgcn_readfirstlane(wid) * 32 - kstart;
    constexpr int SE = 0, SO = SD - 1;
    __syncthreads();
    SLOAD(SE, 0); asm volatile("s_waitcnt vmcnt(0)" ::: "memory"); SWRITE(0, SE); __syncthreads();
    qkt<DQK, MODE, NQR>(pA0, pA1, K_lds, qr, r32, hi, dq0, sl, qlds, rel0); partialSM(pA0, pA1, m_reg, mnA, alA, C, thr, alibi_off<MODE>(rel0, dq0, sl), MODE == 1 && safe_nomax && rel0 < -31);
    SLOAD(SO, 64); if constexpr (SD == 2) { if (2 < NT) SLOAD(SE, 128); }
    SWRITE(1, SO); __syncthreads();
    for (int j = 1; j + 1 < NT; j += 2) {
        SBAR(); qkt<DQK, MODE, NQR>(pB0, pB1, K_lds + SHM_K, qr, r32, hi, dq0 - 64.f * (float)j, sl, qlds, rel0 - 64 * j);
        finishSM(pA0, pA1, alA, l_reg, pa0, pa1, pa2, pa3); SBAR();
        SLOAD(SO, (j + SD) * 64); SBAR();
        pv_all<DV>(o, vb0, pa0, pa1, pa2, pa3); partialSM(pB0, pB1, m_reg, mnB, alB, C, thr, alibi_off<MODE>(rel0 - 64 * j, dq0 - 64.f * (float)j, sl), MODE == 1 && safe_nomax && rel0 - 64 * j < -31);
        __syncthreads(); SWRITE(0, SE);
        RESC(alB); __syncthreads();
        SBAR(); qkt<DQK, MODE, NQR>(pA0, pA1, K_lds, qr, r32, hi, dq0 - 64.f * (float)(j + 1), sl, qlds, rel0 - 64 * (j + 1));
        finishSM(pB0, pB1, alB, l_reg, pa0, pa1, pa2, pa3); SBAR();
        if (SD == 1 || j + 3 < NT) SLOAD(SE, (j + 1 + SD) * 64); SBAR();
        pv_all<DV>(o, vb0 + SHM_V, pa0, pa1, pa2, pa3); partialSM(pA0, pA1, m_reg, mnA, alA, C, thr, alibi_off<MODE>(rel0 - 64 * (j + 1), dq0 - 64.f * (float)(j + 1), sl), MODE == 1 && safe_nomax && rel0 - 64 * (j + 1) < -31);
        __syncthreads(); SWRITE(1, SO);
        RESC(alA); __syncthreads();
    }
    SBAR(); qkt<DQK, MODE, NQR>(pB0, pB1, K_lds + SHM_K, qr, r32, hi, dq0 - 64.f * (float)(NT - 1), sl, qlds, rel0 - 64 * (NT - 1));
    finishSM(pA0, pA1, alA, l_reg, pa0, pa1, pa2, pa3); SBAR();
    pv_all<DV>(o, vb0, pa0, pa1, pa2, pa3); partialSM(pB0, pB1, m_reg, mnB, alB, C, thr, alibi_off<MODE>(rel0 - 64 * (NT - 1), dq0 - 64.f * (float)(NT - 1), sl), MODE == 1 && safe_nomax && rel0 - 64 * (NT - 1) < -31);
    __syncthreads(); RESC(alB);
    finishSM(pB0, pB1, alB, l_reg, pa0, pa1, pa2, pa3); SBAR();
    pv_all<DV>(o, vb0 + SHM_V, pa0, pa1, pa2, pa3);
    if (MODE == 2) l_reg += __builtin_amdgcn_exp2f(sinkl2 - m_reg * C);
    if (hi == 0) li_l[r32] = l_reg; asm volatile("s_waitcnt lgkmcnt(0)" ::: "memory");
    float rli[16];
#pragma unroll
    for (int r = 0; r < 16; ++r) rli[r] = __builtin_amdgcn_rcpf(li_l[crow(r, hi)]);
    epi(o, rli, wid, r32, hi);
#undef SLOAD
#undef SWRITE
#undef RESC
}

template <int DQK, int DV, int MODE, int LDQ, int LDK, int LDV, class Epi>
__device__ __forceinline__ void attn_body_simple(const bf16_t* __restrict__ Qb, const bf16_t* __restrict__ Kh, const bf16_t* __restrict__ Vh, int kstart, int NT, int qpos0,
                                                 float scale, float slope, float sinkl2, LAS char* lds, const Epi& epi, int wave_) {
    asm volatile("" : "+s"(Qb), "+s"(Kh), "+s"(Vh));
    constexpr int SHM_V = 64 * DV * 2, SHM_K = 64 * DQK * 2, NQ = DQK / 16, NO = DV / 32;
    constexpr int KCH = DQK / 8, NKC = 64 * KCH / 512, VCH = DV / 8, NVC = 64 * VCH / 512;
    int tid = wave_ * 64 + lane_id(); asm volatile("" : "+v"(tid));
    const int wid = tid >> 6, lane = tid & 63, r32 = lane & 31, hi = lane >> 5;
    LAS char* V_lds = lds; LAS char* K_lds = lds + 3 * SHM_V;
    LAS float* wsf = (LAS float*)(lds + 3 * SHM_V + 3 * SHM_K) + wid * 64; LAS float* li_l = wsf; LAS float* al_l = wsf + 32;
    const float C = scale * LOG2E, thr = 8.f / scale, sl = slope / scale;
    const float dq0 = (float)(qpos0 + wid * 32 + r32 - kstart - 4 * hi);
    float m_reg = -1e30f, l_reg = 0; f32x16 o[NO]; bf16x8 qr[NQ];
#pragma unroll
    for (int d = 0; d < NO; ++d) o[d] = f32x16{};
    const GAS bf16_t* Qw = (const GAS bf16_t*)Qb + (size_t)(wid * 32 + r32) * LDQ + hi * 8;
#pragma unroll
    for (int d0 = 0; d0 < NQ; ++d0) qr[d0] = *(const GAS bf16x8*)(Qw + d0 * 16);
    const int vb0 = (int)(unsigned)(size_t)V_lds + v_rd_base(lane);
    bf16x8 sk[NKC], sv[NVC];
    const GAS bf16_t* Kp = (const GAS bf16_t*)Kh + (size_t)kstart * LDK; const GAS bf16_t* Vp = (const GAS bf16_t*)Vh + (size_t)kstart * LDV;
#define S1LOAD(k0) do { _Pragma("unroll") for (int _c = 0; _c < NVC; ++_c) { const int c_ = tid + 512 * _c; sv[_c] = *(const GAS bf16x8*)(Vp + (size_t)((k0) + c_ / VCH) * LDV + (c_ % VCH) * 8); } \
    _Pragma("unroll") for (int _c = 0; _c < NKC; ++_c) { const int c_ = tid + 512 * _c; sk[_c] = *(const GAS bf16x8*)(Kp + (size_t)((k0) + c_ / KCH) * LDK + (c_ % KCH) * 8); } } while (0)
#define S1WRITE(b) do { _Pragma("unroll") for (int _c = 0; _c < NVC; ++_c) { const int c_ = tid + 512 * _c; *(LAS bf16x8*)(V_lds + (b) * SHM_V + v_st<DV>(c_ / VCH, (c_ % VCH) * 8)) = sv[_c]; } \
    _Pragma("unroll") for (int _c = 0; _c < NKC; ++_c) { const int c_ = tid + 512 * _c; *(LAS bf16x8*)(K_lds + (b) * SHM_K + kswz<DQK>(c_ / KCH, (c_ % KCH) * 16)) = sk[_c]; } } while (0)
    __syncthreads();
    S1LOAD(0); S1WRITE(0); S1LOAD(64); S1WRITE(1);
    if (2 < NT) S1LOAD(128);
    int slot = 0;
    for (int j = 0; j < NT; ++j) {
        __syncthreads();
        { const int wslot = slot == 0 ? 2 : slot - 1;
          if (j + 2 < NT) { S1WRITE(wslot); if (j + 3 < NT) S1LOAD((j + 3) * 64); } }
        f32x16 p0, p1; float mn, al; bf16x8 pa0, pa1, pa2, pa3;
        qkt<DQK, MODE>(p0, p1, K_lds + slot * SHM_K, qr, r32, hi, dq0 - 64.f * (float)j, sl);
        partialSM(p0, p1, m_reg, mn, al, C, thr);
        finishSM(p0, p1, al, l_reg, pa0, pa1, pa2, pa3);
        if (__any(al < 1.f)) { if (hi == 0) al_l[r32] = al; asm volatile("s_waitcnt lgkmcnt(0)" ::: "memory");
#pragma unroll
            for (int d = 0; d < NO; ++d)
#pragma unroll
                for (int r = 0; r < 16; ++r) o[d][r] *= al_l[crow(r, hi)]; }
        SBAR();
        pv_all<DV>(o, vb0 + slot * SHM_V, pa0, pa1, pa2, pa3);
        slot = slot == 2 ? 0 : slot + 1;
    }
#undef S1LOAD
#undef S1WRITE
    if (MODE == 2) l_reg += __builtin_amdgcn_exp2f(sinkl2 - m_reg * C);
    if (hi == 0) li_l[r32] = l_reg; asm volatile("s_waitcnt lgkmcnt(0)" ::: "memory");
    float rli[16];
#pragma unroll
    for (int r = 0; r < 16; ++r) rli[r] = __builtin_amdgcn_rcpf(li_l[crow(r, hi)]);
    epi(o, rli, wid, r32, hi);
}

template <int NO> struct EpiStoreBf16 {
    bf16_t* O; int ldo;
    __device__ __forceinline__ void operator()(const f32x16* o, const float* rli, int wid, int r32, int hi) const {
        bf16_t* Ob = O; asm volatile("" : "+s"(Ob));
#pragma unroll
        for (int r = 0; r < 16; ++r) { GAS bf16_t* p = (GAS bf16_t*)Ob + (size_t)(wid * 32 + crow(r, hi)) * ldo + r32;
#pragma unroll
            for (int d0 = 0; d0 < NO; ++d0) p[d0 * 32] = (bf16_t)(cvt_pk_bf16(o[d0][r] * rli[r], 0.f) & 0xffffu); }
    }
};
struct EpiDiff0 {
    float* scr;
    __device__ __forceinline__ void operator()(const f32x16* o, const float* rli, int wid, int r32, int hi) const {
        float* sb = scr; asm volatile("" : "+s"(sb));
        int t_ = wid * 64 + hi * 32 + r32; GAS f32x4* p = (GAS f32x4*)(sb + t_ * 64);
#pragma unroll
        for (int d0 = 0; d0 < 4; ++d0)
#pragma unroll
            for (int q = 0; q < 4; ++q) { f32x4 v;
#pragma unroll
                for (int i = 0; i < 4; ++i) v[i] = o[d0][4 * q + i] * rli[4 * q + i];
                p[d0 * 4 + q] = v; }
    }
};
struct EpiDiff1 {
    const float* scr; bf16_t* O; int ldo; const float* g; float lam, oscale;
    __device__ __forceinline__ void operator()(const f32x16* o, const float* rli, int wid, int r32, int hi) const {
        const float* sb = scr; bf16_t* Ob = O; asm volatile("" : "+s"(sb), "+s"(Ob));
        int t_ = wid * 64 + hi * 32 + r32; const GAS f32x4* p = (const GAS f32x4*)(sb + t_ * 64); float gv[4];
#pragma unroll
        for (int d0 = 0; d0 < 4; ++d0) gv[d0] = g[d0 * 32 + r32] * oscale;
#pragma unroll
        for (int q = 0; q < 4; ++q) { f32x4 t[4];
#pragma unroll
            for (int d0 = 0; d0 < 4; ++d0) t[d0] = p[d0 * 4 + q];
#pragma unroll
            for (int i = 0; i < 4; ++i) { const int r = 4 * q + i; float s = 0.f;
#pragma unroll
                for (int d0 = 0; d0 < 4; ++d0) { t[d0][i] -= lam * (o[d0][r] * rli[r]); s += t[d0][i] * t[d0][i]; }
                s += shfl_xor_f(s, 1); s += shfl_xor_f(s, 2); s += shfl_xor_f(s, 4); s += shfl_xor_f(s, 8); s += shfl_xor_f(s, 16);
                const float rn = fast_rsq(s * (1.f / 128.f) + EPS);
                GAS bf16_t* qp = (GAS bf16_t*)Ob + (size_t)(wid * 32 + crow(r, hi)) * ldo + r32;
#pragma unroll
                for (int d0 = 0; d0 < 4; ++d0) qp[d0 * 32] = (bf16_t)(cvt_pk_bf16(t[d0][i] * rn * gv[d0], 0.f) & 0xffffu); }
            asm volatile("" ::: "memory"); }
    }
};
}

__device__ __forceinline__ float wave_sum(float v) {
#pragma unroll
    for (int o = 1; o < 64; o <<= 1) v += shfl_xor_f(v, o);
    return v;
}
template <int MODE> __device__ __forceinline__ int src_col(int n) {
    if (MODE == 1) { const int t = n >> 8, j = n & 255; return j < 128 ? t * 128 + j : FF + t * 128 + (j - 128); }
    if (MODE == 2) { if (n < Z_CKR) return n; if (n < 3008) { const int e = n - Z_CKR; return Z_CKR + (e >> 1) + 32 * (e & 1); } return -1; }
    if (MODE == 3) { const int h = n / 192, e = n - h * 192; if (e < 128) return n; const int e2 = e - 128; return h * 192 + 128 + (e2 >> 1) + 32 * (e2 & 1); }
    return n;
}
template <int MODE> __device__ __forceinline__ void tr_item(const float* __restrict__ W, int K, int Nsrc, const float* __restrict__ gain, bf16_t* WT, int nblk, LAS float* scr, int item, int lane) {
    const int kb = item / nblk, nb = item - kb * nblk, k0 = 64 * kb, n0 = 32 * nb;
    const int sc0 = src_col<MODE>(n0), sc31 = src_col<MODE>(n0 + 31);
    if (sc0 >= 0 && sc31 == sc0 + 31 && (sc0 & 3) == 0) {
        const int row8 = lane >> 3, n4 = (lane & 7) * 4;
#pragma unroll
        for (int i = 0; i < 8; ++i) { const int kk = 8 * i + row8; f32x4 v = *(const f32x4*)(W + (size_t)(k0 + kk) * Nsrc + sc0 + n4);
            if (gain) v = v * gain[k0 + kk];
            LAS float* d = scr + kk * 33 + n4; d[0] = v[0]; d[1] = v[1]; d[2] = v[2]; d[3] = v[3]; }
    } else {
        const int sc = src_col<MODE>(n0 + (lane & 31));
#pragma unroll
        for (int i = 0; i < 32; ++i) { const int kk = 2 * i + (lane >> 5); float v = 0.f;
            if (sc >= 0) { v = W[(size_t)(k0 + kk) * Nsrc + sc]; if (gain) v *= gain[k0 + kk]; }
            scr[kk * 33 + (lane & 31)] = v; }
    }
    asm volatile("s_waitcnt lgkmcnt(0)" ::: "memory");
    const int c = lane & 7;
#pragma unroll
    for (int j = 0; j < 4; ++j) { const int n = (lane >> 3) + 8 * j; const LAS float* s = scr + (8 * c) * 33 + n;
        u32x4 o; o.x = cvt_pk_bf16(s[0 * 33], s[1 * 33]); o.y = cvt_pk_bf16(s[2 * 33], s[3 * 33]); o.z = cvt_pk_bf16(s[4 * 33], s[5 * 33]); o.w = cvt_pk_bf16(s[6 * 33], s[7 * 33]);
        *(u32x4*)(WT + (size_t)(n0 + n) * K + k0 + 8 * c) = o; }
    asm volatile("s_waitcnt lgkmcnt(0)" ::: "memory");
}

struct Args { const float* in[21]; float* out; unsigned char* ws; int ph_lo, ph_hi; };
enum { I_X = 0, I_F1N, I_F1W13, I_F1W2, I_MIXN, I_WIN, I_WGATE, I_BGATE, I_ALAM, I_ASUB, I_BSINK, I_CQN, I_CWUQ, I_CKVN, I_CWUKV, I_WBR, I_WOUT, I_F2N, I_F2W13, I_F2W2, I_FINN };

constexpr int LDS_BYTES = 155648;

struct TrDesc { const float* W; const float* gain; bf16_t* WT; int K, Nsrc, nblk, mode, r; };
__device__ __forceinline__ int src_col_rt(int mode, int n) { return mode == 1 ? src_col<1>(n) : mode == 2 ? src_col<2>(n) : mode == 3 ? src_col<3>(n) : n; }
__device__ __forceinline__ bool tr_decode(const Args& a, int l, unsigned char* ws, int it, TrDesc& d) {
    constexpr int I_W13 = (DM / 64) * (2 * FF / 32), I_W2 = (FF / 64) * (DM / 32), I_IN = (DM / 64) * (3072 / 32), I_GT = I_IN,
                  I_UQ = (384 / 64) * (768 / 32), I_UKV = (256 / 64) * (1024 / 32), I_BR = (512 / 64) * (1024 / 32), I_OUT = (DM / 64) * (DM / 32);
    constexpr int NITEMS = 2 * I_W13 + 2 * I_W2 + I_IN + I_GT + I_UQ + I_UKV + 3 * I_BR + I_OUT;
    if (it >= NITEMS) return false;
    int r = it;
#define TR_SET(W_, K_, NS_, G_, WT_, NB_, M_) do { d.W = (W_); d.K = (K_); d.Nsrc = (NS_); d.gain = (G_); d.WT = (WT_); d.nblk = (NB_); d.mode = (M_); d.r = r; return true; } while (0)
    if (r < I_W13) TR_SET(a.in[I_F1W13] + (size_t)l * DM * 2 * FF, DM, 2 * FF, a.in[I_F1N] + l * DM, (bf16_t*)(ws + WS_W13A), 2 * FF / 32, 1); r -= I_W13;
    if (r < I_W13) TR_SET(a.in[I_F2W13] + (size_t)l * DM * 2 * FF, DM, 2 * FF, a.in[I_F2N] + l * DM, (bf16_t*)(ws + WS_W13B), 2 * FF / 32, 1); r -= I_W13;
    if (r < I_W2) TR_SET(a.in[I_F1W2] + (size_t)l * FF * DM, FF, DM, nullptr, (bf16_t*)(ws + WS_W2A), DM / 32, 0); r -= I_W2;
    if (r < I_W2) TR_SET(a.in[I_F2W2] + (size_t)l * FF * DM, FF, DM, nullptr, (bf16_t*)(ws + WS_W2B), DM / 32, 0); r -= I_W2;
    if (r < I_IN) TR_SET(a.in[I_WIN] + (size_t)l * DM * 3008, DM, 3008, a.in[I_MIXN] + l * DM, (bf16_t*)(ws + WS_WIG), 3072 / 32, 2); r -= I_IN;
    if (r < I_GT) TR_SET(a.in[I_WGATE] + (size_t)l * DM * 3072, DM, 3072, a.in[I_MIXN] + l * DM, (bf16_t*)(ws + WS_WIG) + (size_t)3072 * DM, 3072 / 32, 0); r -= I_GT;
    if (r < I_UQ) TR_SET(a.in[I_CWUQ] + (size_t)l * 384 * 768, 384, 768, a.in[I_CQN] + l * 384, (bf16_t*)(ws + WS_WUQ), 768 / 32, 3); r -= I_UQ;
    if (r < I_UKV) TR_SET(a.in[I_CWUKV] + (size_t)l * 256 * 1024, 256, 1024, a.in[I_CKVN] + l * 256, (bf16_t*)(ws + WS_WUKV), 1024 / 32, 0); r -= I_UKV;
    if (r < 3 * I_BR) { const int n = r / I_BR; r -= n * I_BR; TR_SET(a.in[I_WBR] + ((size_t)l * 3 + n) * 512 * 1024, 512, 1024, nullptr, (bf16_t*)(ws + WS_WB) + (size_t)n * 1024 * 512, 1024 / 32, 0); } r -= 3 * I_BR;
    TR_SET(a.in[I_WOUT] + (size_t)l * DM * DM, DM, DM, nullptr, (bf16_t*)(ws + WS_WO), DM / 32, 0);
#undef TR_SET
}
__device__ __forceinline__ bool tr_load(const TrDesc& d, int lane, f32x4 (&v)[8]) {
    const int kb = d.r / d.nblk, nb = d.r - kb * d.nblk, k0 = 64 * kb, n0 = 32 * nb;
    const int sc0 = src_col_rt(d.mode, n0), sc31 = src_col_rt(d.mode, n0 + 31);
    const bool vec = sc0 >= 0 && sc31 == sc0 + 31 && (sc0 & 3) == 0;
    if (vec) { const int row8 = lane >> 3, n4 = (lane & 7) * 4;
#pragma unroll
        for (int i = 0; i < 8; ++i) { const int kk = 8 * i + row8; v[i] = *(const f32x4*)(d.W + (size_t)(k0 + kk) * d.Nsrc + sc0 + n4); } }
    return vec;
}
__device__ __forceinline__ void tr_finish(const TrDesc& d, bool vec, int lane, const f32x4 (&v)[8], LAS float* scr) {
    const int kb = d.r / d.nblk, nb = d.r - kb * d.nblk, k0 = 64 * kb, n0 = 32 * nb;
    if (vec) { const int row8 = lane >> 3, n4 = (lane & 7) * 4;
#pragma unroll
        for (int i = 0; i < 8; ++i) { const int kk = 8 * i + row8; const f32x4 x = d.gain ? v[i] * d.gain[k0 + kk] : v[i]; LAS float* p = scr + kk * 33 + n4; p[0] = x[0]; p[1] = x[1]; p[2] = x[2]; p[3] = x[3]; }
    } else { const int sc = src_col_rt(d.mode, n0 + (lane & 31));
#pragma unroll 8
        for (int i = 0; i < 32; ++i) { const int kk = 2 * i + (lane >> 5); float x = 0.f;
            if (sc >= 0) { x = d.W[(size_t)(k0 + kk) * d.Nsrc + sc]; if (d.gain) x *= d.gain[k0 + kk]; }
            scr[kk * 33 + (lane & 31)] = x; } }
    asm volatile("s_waitcnt lgkmcnt(0)" ::: "memory");
    const int c = lane & 7;
#pragma unroll
    for (int j = 0; j < 4; ++j) { const int n = (lane >> 3) + 8 * j; const LAS float* s = scr + (8 * c) * 33 + n;
        u32x4 o; o.x = cvt_pk_bf16(s[0 * 33], s[1 * 33]); o.y = cvt_pk_bf16(s[2 * 33], s[3 * 33]); o.z = cvt_pk_bf16(s[4 * 33], s[5 * 33]); o.w = cvt_pk_bf16(s[6 * 33], s[7 * 33]);
        *(u32x4*)(d.WT + (size_t)(n0 + n) * d.K + k0 + 8 * c) = o; }
    asm volatile("s_waitcnt lgkmcnt(0)" ::: "memory");
}
__device__ __forceinline__ void convert_layer(const Args& a, int l, LAS unsigned char* lds, int gw, int NGW, int wave, int mask = 0) {
    constexpr int I_W13 = (DM / 64) * (2 * FF / 32), I_W2 = (FF / 64) * (DM / 32), I_IN = (DM / 64) * (3072 / 32),
                  I_UQ = (384 / 64) * (768 / 32), I_UKV = (256 / 64) * (1024 / 32), I_BR = (512 / 64) * (1024 / 32), I_OUT = (DM / 64) * (DM / 32);
    constexpr int NITEMS = 2 * I_W13 + 2 * I_W2 + 2 * I_IN + I_UQ + I_UKV + 3 * I_BR + I_OUT, OFF_W2B = 2 * I_W13 + I_W2;
    int lane = lane_id(); asm volatile("" : "+v"(lane));
    LAS float* scr0 = (LAS float*)(lds + wave * 17408); LAS float* scr1 = scr0 + 64 * 33 + 32;
    unsigned char* ws = a.ws; asm volatile("" : "+s"(ws));
    const int limit = mask == 0 ? NITEMS : mask == 1 ? NITEMS - I_W2 : I_W2;
#define CV_MAP(i_) (mask == 0 ? (i_) : mask == 1 ? ((i_) >= OFF_W2B ? (i_) + I_W2 : (i_)) : OFF_W2B + (i_))
    for (int it = gw; it < limit; it += 2 * NGW) {
        TrDesc d0, d1; f32x4 v0[8], v1[8];
        if (!tr_decode(a, l, ws, CV_MAP(it), d0)) break;
        const bool has1 = (it + NGW < limit) && tr_decode(a, l, ws, CV_MAP(it + NGW), d1);
        const bool vec0 = tr_load(d0, lane, v0);
        bool vec1 = false; if (has1) vec1 = tr_load(d1, lane, v1);
        tr_finish(d0, vec0, lane, v0, scr0);
        if (has1) tr_finish(d1, vec1, lane, v1, scr1);
    }
#undef CV_MAP
}

#define XB_TMO      128
#define XB_XCNT(j)  (256  + 64 * (j))
#define XB_XSUB(j)  (1280 + 64 * (j))
#define XB_XGEN(j)  (2304 + 64 * (j))
#define XB_TOP      3328
#define XB_TOPGEN   3392
#define XCD_BAR_WORDS 3456
#define XB_SPIN_CAP (1u << 18)

__device__ __forceinline__ unsigned xb_ld(unsigned* p)              { return __hip_atomic_load(p, __ATOMIC_RELAXED, __HIP_MEMORY_SCOPE_AGENT); }
__device__ __forceinline__ unsigned xb_add(unsigned* p, unsigned v) { return __hip_atomic_fetch_add(p, v, __ATOMIC_RELAXED, __HIP_MEMORY_SCOPE_AGENT); }
__device__ __forceinline__ unsigned xb_xcc_id() { return (unsigned)__builtin_amdgcn_s_getreg((3 << 11) | 20) & 0xFu; }
#define XB_SPIN(cond, bar) do { unsigned _sp = 0; while (cond) { __builtin_amdgcn_s_sleep(1); \
    if ((++_sp & 255u) == 0u) { if (xb_ld(&(bar)[XB_TMO])) break; if (_sp > XB_SPIN_CAP) { atomicAdd(&(bar)[XB_TMO], 1u); break; } } } } while (0)

struct XcdBarrier {
    unsigned* bar; unsigned x;
    volatile LAS unsigned* st;
};

__device__ __forceinline__ XcdBarrier xcd_barrier_post(unsigned* bar, volatile LAS unsigned* st) {
    XcdBarrier b; b.bar = bar; b.x = xb_xcc_id(); b.st = st;
    if (threadIdx.x == 0) (void)xb_add(&bar[XB_XCNT(b.x)], 1u);
    return b;
}
__device__ __forceinline__ void xcd_barrier_complete(unsigned* bar, unsigned x, unsigned& nloc, unsigned& nx) {
    const unsigned G = gridDim.x * gridDim.y * gridDim.z;
    unsigned sum, cnt, mine, sp = 0u;
    for (;;) {
        sum = 0u; cnt = 0u; mine = 0u;
#pragma unroll
        for (unsigned j = 0; j < 16; ++j) { const unsigned c = xb_ld(&bar[XB_XCNT(j)]); sum += c; cnt += (c > 0u) ? 1u : 0u; mine = (j == x) ? c : mine; }
        if (sum == G) break;
        __builtin_amdgcn_s_sleep(1);
        if ((++sp & 255u) == 0u) { if (xb_ld(&bar[XB_TMO])) break; if (sp > XB_SPIN_CAP) { atomicAdd(&bar[XB_TMO], 1u); break; } }
    }
    nloc = mine > 0u ? mine : 1u; nx = cnt > 0u ? cnt : 1u;
}

__device__ __forceinline__ void xcd_barrier(const XcdBarrier& b0_) {
    XcdBarrier b; b.bar = b0_.bar; b.st = b0_.st; b.x = xb_xcc_id(); { unsigned* bb = b.bar; asm volatile("" : "+s"(bb)); b.bar = bb; }
    asm volatile("s_waitcnt vmcnt(0)" ::: "memory");
    __syncthreads();
    if (threadIdx.x == 0) {
        unsigned* bar = b.bar;
        __builtin_amdgcn_s_waitcnt(0);
        unsigned nloc = b.st[0], nx = b.st[1];
        if (nloc == 0u) { xcd_barrier_complete(bar, b.x, nloc, nx); b.st[0] = nloc; b.st[1] = nx; }
        const unsigned old = xb_add(&bar[XB_XSUB(b.x)], 1u);
        const unsigned gen = old / nloc;
        if (old + 1u == (gen + 1u) * nloc) {
            __builtin_amdgcn_fence(__ATOMIC_RELEASE, "agent");
            asm volatile("s_waitcnt vmcnt(0)" ::: "memory");
            const unsigned og = xb_add(&bar[XB_TOP], 1u);
            const unsigned tg = og / nx;
            if (og + 1u == (tg + 1u) * nx) xb_add(&bar[XB_TOPGEN], 1u);
            else XB_SPIN(xb_ld(&bar[XB_TOPGEN]) == tg, bar);
            __builtin_amdgcn_fence(__ATOMIC_ACQUIRE, "agent");
            xb_add(&bar[XB_XGEN(b.x)], 1u);
            asm volatile("s_waitcnt vmcnt(0)" ::: "memory");
        } else {
            XB_SPIN(xb_ld(&bar[XB_XGEN(b.x)]) == gen, bar);
            __builtin_amdgcn_fence(__ATOMIC_ACQUIRE, "agent");
            asm volatile("s_waitcnt vmcnt(0)" ::: "memory");
        }
    }
    __syncthreads();
}


__global__ void __launch_bounds__(512) fwd_megakernel(Args a) {
    extern __shared__ __attribute__((aligned(16))) unsigned char lds_raw[];
    LAS unsigned char* lds = (LAS unsigned char*)lds_raw;
    cg::grid_group grid = cg::this_grid();
#define GSYNC() xcd_barrier(xbar)
    const int wave = __builtin_amdgcn_readfirstlane(threadIdx.x >> 6);
    const int G = gridDim.x, bx = blockIdx.x;
    volatile LAS unsigned* xst = (volatile LAS unsigned*)(lds + LDS_BYTES - 64);
    if (threadIdx.x < 2) xst[threadIdx.x] = 0u;
    __syncthreads();
    grid.sync();
    XcdBarrier xbar = xcd_barrier_post((unsigned*)(a.ws + WS_BAR), xst);
    const int vcu = (G % 8 == 0) ? (bx % 8) * (G / 8) + bx / 8 : bx;
    const int gw = vcu * 8 + wave, NGW = G * 8;
    unsigned char* ws = a.ws;
    float* X = a.out;
    bf16_t* XB = (bf16_t*)(ws + WS_XB); float* SSQ = (float*)(ws + WS_SSQ); float* SSQZ = (float*)(ws + WS_SSQZ);
    float* ROPEC = (float*)(ws + WS_ROPE); float* ROPES = ROPEC + SEQ * 32;
    bf16_t* Z = (bf16_t*)(ws + WS_R0); bf16_t* H = (bf16_t*)(ws + WS_R0); float* MG = (float*)(ws + WS_R0); bf16_t* MB = (bf16_t*)(ws + WS_R0 + 64 * MiB);
    bf16_t* GT = (bf16_t*)(ws + WS_G); bf16_t* QC = (bf16_t*)(ws + WS_QC); bf16_t* KC = (bf16_t*)(ws + WS_KC); bf16_t* VC = (bf16_t*)(ws + WS_VC);
    bf16_t* O3 = (bf16_t*)(ws + WS_O3); float* SCR = (float*)(ws + WS_SCR) + (size_t)bx * (512 * 64);

    {
        const float* xin = a.in[I_X]; const int lane = lane_id();
        for (int m = gw; m < M_TOK; m += NGW) {
            const f32x4* xr = (const f32x4*)(xin + (size_t)m * DM) + lane; f32x4* xo = (f32x4*)(X + (size_t)m * DM) + lane; u32x2* bo = (u32x2*)(XB + (size_t)m * DM) + lane;
            float s = 0.f;
#pragma unroll
            for (int j = 0; j < 4; ++j) { const f32x4 v = xr[64 * j]; xo[64 * j] = v; s += dot4(v); u32x2 w; w.x = cvt_pk_bf16(v[0], v[1]); w.y = cvt_pk_bf16(v[2], v[3]); bo[64 * j] = w; }
            s = wave_sum(s);
            if (lane < 16) SSQ[(size_t)m * 16 + lane] = lane == 0 ? s : 0.f;
        }
        for (int i = gw * 64 + lane; i < SEQ * 32; i += NGW * 64) {
            const int pos = i >> 5, j = i & 31;
            const float inv_freq = (float)exp2(-(double)(2 * j) / 64.0 * 13.287712379549449);
            const float ang = (float)pos * inv_freq;
            const double rev = (double)ang * 0.15915494309189535; const float f = (float)(rev - floor(rev));
            ROPEC[i] = __builtin_amdgcn_cosf(f); ROPES[i] = __builtin_amdgcn_sinf(f);
        }
#ifndef NO_CONV
        convert_layer(a, 0, lds, gw, NGW, wave);
#endif
    }
    GSYNC();

    for (int l = 0; l < DEPTH; ++l) {
        for (int half = 0; half < 2; ++half) {
#ifndef NO_FFNUP
            { pg8::Gemm g{XB, (const bf16_t*)(ws + (half ? WS_W13B : WS_W13A)), M_TOK, 2 * FF, DM, DM, 31, 0}; pg8::StaticOrder S; S.init(M_TOK, 2 * FF, G, bx);
              EpiSwiGLU E{H, SSQ}; pg8::gemm_phase(lds, g, S, E, wave); }
#endif
            GSYNC();
#ifndef NO_FFNDN
            { pg8::Gemm g{H, (const bf16_t*)(ws + (half ? WS_W2B : WS_W2A)), M_TOK, DM, FF, FF, 31, 0}; pg8::StaticOrder S; S.init(M_TOK, DM, G, bx);
              EpiResid E{X, XB, SSQ, 0.5f}; pg8::gemm_phase(lds, g, S, E, wave); }
#endif
            if (half == 1) { if (l + 1 < DEPTH) convert_layer(a, l + 1, lds, gw, NGW, wave, 1); }
            else if (l > 0) convert_layer(a, l, lds, gw, NGW, wave, 2);
            GSYNC();
            if (half == 1) break;
#ifndef NO_INPROJ
            { pg8::Gemm g{XB, (const bf16_t*)(ws + WS_WIG), M_TOK, 6144, DM, DM, 31, 0}; pg8::StaticOrder S; S.init(M_TOK, 6144, G, bx);
              EpiInProj E{Z, GT, KC, SSQ, SSQZ, a.in[I_BGATE] + l * 3072, ROPEC, ROPES}; pg8::gemm_phase(lds, g, S, E, wave); }
#endif
            GSYNC();
#ifndef NO_UQ
            { pg8::Gemm g{Z + Z_CQ, (const bf16_t*)(ws + WS_WUQ), M_TOK, 768, 384, ZC, 31, 0}; pg8::StaticOrder S; S.init(M_TOK, 768, G, bx);
              EpiUQ E{QC, SSQZ, ROPEC, ROPES}; pg8::gemm_phase(lds, g, S, E, wave); }
#endif
#ifndef NO_UKV
            { pg8::Gemm g{Z + Z_CKV, (const bf16_t*)(ws + WS_WUKV), M_TOK, 1024, 256, ZC, 31, 0}; pg8::StaticOrder S; S.init(M_TOK, 1024, G, G - 1 - bx);
              EpiUKV E{KC, VC, SSQZ}; pg8::gemm_phase(lds, g, S, E, wave); }
#endif
            { unsigned* NRM = (unsigned*)(ws + WS_BAR + 32768) + l * 32; const int lane = lane_id(); float mx0 = 0.f, mx1 = 0.f;
              for (int m = gw; m < M_TOK; m += NGW) { const u32x4* zp = (const u32x4*)(Z + (size_t)m * ZC + lane * 16); const u32x4 w0 = zp[0], w1 = zp[1]; float sq = 0.f;
#pragma unroll
                  for (int i = 0; i < 4; ++i) { const float a0 = bf16_lo(w0[i]), a1 = bf16_hi(w0[i]), b0 = bf16_lo(w1[i]), b1 = bf16_hi(w1[i]); sq += (a0 * a0 + a1 * a1) + (b0 * b0 + b1 * b1); }
                  sq += shfl_xor_f(sq, 1); sq += shfl_xor_f(sq, 2);
                  if (m < SEQ) mx0 = fmaxf(mx0, sq); else mx1 = fmaxf(mx1, sq); }
              if ((lane & 3) == 0) { __hip_atomic_fetch_max(NRM + (lane >> 2), __float_as_uint(mx0), __ATOMIC_RELAXED, __HIP_MEMORY_SCOPE_AGENT);
                                     __hip_atomic_fetch_max(NRM + 16 + (lane >> 2), __float_as_uint(mx1), __ATOMIC_RELAXED, __HIP_MEMORY_SCOPE_AGENT); } }
            GSYNC();
            {
                LAS char* al = (LAS char*)lds;
                const int nslot = (G == 256) ? 6 : (1024 + G - 1) / G;
                for (int k_ = 0; k_ < nslot; ++k_) {
                    int L;
                    if (G == 256) {
                        if (vcu < 128) L = k_ < 2 ? 2 * vcu + k_ : k_ < 4 ? 512 + 2 * vcu + (k_ - 2) : (k_ == 4 && (vcu & 1)) ? 512 + 256 + (vcu >> 1) : -1;
                        else { const int u = (vcu - 128) & 63, hi_ = vcu >= 192, hh = k_ == 0 ? (hi_ ? 2 : 3) : (hi_ ? 1 : 0);
                               L = k_ < 2 ? 256 + (((u >> 5) * 4 + hh) << 5) + (u & 31) : hi_ ? (k_ < 4 ? 512 + 384 + 2 * u + (k_ - 2) : -1) : (k_ == 2 ? 512 + 320 + u : -1); }
                    } else { L = vcu + k_ * G; if (L >= 1024) L = -1; }
                    if (L < 0) continue;
                    if (L < 256) {
#ifndef NO_C
                        const int bh = L >> 5, qb = L & 31, b = bh >> 2, h = bh & 3; const size_t r0 = (size_t)b * SEQ + qb * 256;
                        att::EpiStoreBf16<4> E{O3 + r0 * 1536 + 1024 + h * 128, 1536};
                        att::attn_body_simple<192, 128, 0, 768, 768, 512>(QC + r0 * 768 + h * 192, KC + (size_t)b * SEQ * 768 + h * 192, VC + (size_t)b * SEQ * 512 + h * 128,
                                                                     0, SEQ / 64, qb * 256, 0.07216878364870322f, 0.f, 0.f, al, E, wave);
#endif
                    } else if (L < 512) {
#ifndef NO_A
                        const int u = L - 256, bh = u >> 5, qb = u & 31, b = bh >> 2, h = bh & 3; const size_t r0 = (size_t)b * SEQ + qb * 256;
                        int li = l; asm volatile("" : "+s"(li));
                        const float lam_init = __uint_as_float(li == 0 ? 0x3e4ccccdu : li == 1 ? 0x3eb60549u : li == 2 ? 0x3ef1014cu : 0x3f0e59d5u);
                        const float* lp = a.in[I_ALAM] + l * 256; const int lane = lane_id();
                        const float s01 = wave_sum(lp[lane] * lp[64 + lane]), s23 = wave_sum(lp[128 + lane] * lp[192 + lane]);
                        const float lam = uni(expf(s01) - expf(s23) + lam_init);
                        const float slope = uni(exp2f(-2.f * (float)(h + 1)));
                        const bf16_t* zb = Z + (size_t)b * SEQ * ZC;
                        int ks0, nt0, ks1, nt1, sf0 = 0, sf1 = 0;
                        { const unsigned* NRM = (const unsigned*)(ws + WS_BAR + 32768) + l * 32 + b * 16;
#pragma unroll
                          for (int mp = 0; mp < 2; ++mp) {
                              const float q2 = __uint_as_float(__hip_atomic_load(NRM + h * 2 + mp, __ATOMIC_RELAXED, __HIP_MEMORY_SCOPE_AGENT)), k2 = __uint_as_float(__hip_atomic_load(NRM + 8 + h * 2 + mp, __ATOMIC_RELAXED, __HIP_MEMORY_SCOPE_AGENT));
                              const float dmax = uni((2.f * 0.125f * sqrtf(q2 * k2) * 1.01f + 32.f) / slope);
                              const float lo_f = (float)(qb * 256) - dmax, hi_f = (float)(qb * 256 + 256) + dmax;
                              const int lo_i = lo_f <= 0.f ? 0 : ((int)lo_f >> 7) << 7; const int hi_i = hi_f >= (float)SEQ ? SEQ : ((((int)hi_f + 127) >> 7) << 7);
                              const int hi_c = hi_i > SEQ ? SEQ : hi_i;
                              const int sf = (2.f * 0.125f * sqrtf(q2 * k2) * 1.01f + 8.f) < 70.f;
                              if (mp == 0) { ks0 = lo_i; nt0 = (hi_c - lo_i) >> 6; sf0 = sf; } else { ks1 = lo_i; nt1 = (hi_c - lo_i) >> 6; sf1 = sf; } } }
                        { att::EpiDiff0 E{SCR};
                          ATT_A_BODY(Z + r0 * ZC + Z_AQ + h * 128, zb + Z_AK + h * 128, zb + Z_AV + h * 128, ks0, nt0, qb * 256, 0.125f, slope, 0.f, al, E, wave, sf0); }
                        { att::EpiDiff1 E{SCR, O3 + r0 * 1536 + h * 128, 1536, a.in[I_ASUB] + l * 128, lam, 1.f - lam_init};
                          ATT_A_BODY(Z + r0 * ZC + Z_AQ + h * 128 + 64, zb + Z_AK + h * 128 + 64, zb + Z_AV + h * 128, ks1, nt1, qb * 256, 0.125f, slope, 0.f, al, E, wave, sf1); }
#endif
                    } else {
#ifndef NO_B
                        const int u = L - 512, bh = u >> 5, qb = u & 31, b = bh >> 3, hq = bh & 7; const size_t r0 = (size_t)b * SEQ + qb * 256;
                        const int ks = qb * 256 - 128 < 0 ? 0 : qb * 256 - 128, ke = qb * 256 + 384 > SEQ ? SEQ : qb * 256 + 384;
                        const float slope = uni(exp2f(-(float)(hq + 1))); const float sink = uni(a.in[I_BSINK][l * 8 + hq]);
                        const bf16_t* zb = Z + (size_t)b * SEQ * ZC;
                        att::EpiStoreBf16<2> E{O3 + r0 * 1536 + 512 + hq * 64, 1536};
                        att::attn_body<64, 64, 2, 2, ZC, ZC, ZC>(Z + r0 * ZC + Z_BQ + hq * 64, zb + Z_BK + (hq >> 2) * 64, zb + Z_BV + (hq >> 2) * 64, ks, (ke - ks) / 64, qb * 256, 0.125f, slope, sink * LOG2E, al, E, wave);
#endif
                    }
                }
                __syncthreads();
            }
            GSYNC();
#ifndef NO_BR
            { pg8::Gemm g{O3, (const bf16_t*)(ws + WS_WB), M_TOK, 3072, 512, 1536, 2, 1024}; pg8::BranchOrder S; S.init(G, bx);
              EpiGateAcc E{GT, MG, MB}; pg8::gemm_phase(lds, g, S, E, wave); }
#endif
            GSYNC();
#ifndef NO_WOUT
            { pg8::Gemm g{MB, (const bf16_t*)(ws + WS_WO), M_TOK, DM, DM, DM, 31, 0}; pg8::StaticOrder S; S.init(M_TOK, DM, G, bx);
              EpiResid E{X, XB, SSQ, 1.0f}; pg8::gemm_phase(lds, g, S, E, wave); }
#endif
            GSYNC();
        }
    }
    {
        const float* fg = a.in[I_FINN]; const int lane = lane_id();
        for (int m = gw; m < M_TOK; m += NGW) {
            const float r = rinv_sum(SSQ + (size_t)m * 16, 4, 1.f / DM);
            f32x4* xo = (f32x4*)(X + (size_t)m * DM) + lane; const f32x4* gp = (const f32x4*)fg + lane;
#pragma unroll
            for (int j = 0; j < 4; ++j) { f32x4 v = xo[64 * j]; v = v * r * gp[64 * j]; xo[64 * j] = v; }
        }
    }
}

extern "C" void kernel_launch(void* const* d_in, const int* in_sizes, int n_in, void* d_out, int out_size, void* d_ws, size_t ws_size, hipStream_t stream) {
    static int grid = 0;
    if (grid == 0) {
        if (n_in != 21 || in_sizes[0] != M_TOK * DM || out_size != M_TOK * DM || ws_size < WS_END) {
            fprintf(stderr, "kernel_launch: shape/workspace mismatch (n_in %d, in0 %d, out %d, ws %zu, need %zu)\n", n_in, n_in > 0 ? in_sizes[0] : -1, out_size, ws_size, (size_t)WS_END); grid = -1; return; }
        int dev = 0, cus = 0, per_cu = 0;
        hipGetDevice(&dev); hipDeviceGetAttribute(&cus, hipDeviceAttributeMultiprocessorCount, dev);
        if (hipFuncSetAttribute((const void*)fwd_megakernel, hipFuncAttributeMaxDynamicSharedMemorySize, LDS_BYTES) != hipSuccess) { fprintf(stderr, "kernel_launch: hipFuncSetAttribute failed\n"); grid = -1; return; }
        if (hipOccupancyMaxActiveBlocksPerMultiprocessor(&per_cu, (const void*)fwd_megakernel, 512, LDS_BYTES) != hipSuccess || per_cu < 1) { fprintf(stderr, "kernel_launch: occupancy query failed (%d)\n", per_cu); per_cu = 1; }
        (void)hipGetLastError();
        grid = cus;
    }
    if (grid < 0) return;
    if (hipMemsetAsync((char*)d_ws + WS_BAR, 0, BAR_BYTES, stream) != hipSuccess) { fprintf(stderr, "kernel_launch: memset failed\n"); return; }
    Args a{};
    for (int i = 0; i < 21; ++i) a.in[i] = (const float*)d_in[i];
    a.out = (float*)d_out; a.ws = (unsigned char*)d_ws; a.ph_lo = 0; a.ph_hi = 0;
    void* args[] = {&a};
    hipError_t e = hipLaunchCooperativeKernel((const void*)fwd_megakernel, dim3(grid), dim3(512), args, LDS_BYTES, stream);
    if (e != hipSuccess) fprintf(stderr, "cooperative launch failed: %s (grid %d)\n", hipGetErrorString(e), grid);
}
```

```cpp
#include <hip/hip_runtime.h>
#include <hip/hip_cooperative_groups.h>
#include <cstdio>
#include <cstdint>
namespace cg = cooperative_groups;

#define LAS __attribute__((address_space(3)))
#define GAS __attribute__((address_space(1)))
typedef unsigned short bf16_t;
typedef short bf16x8 __attribute__((ext_vector_type(8)));
typedef short s16x4 __attribute__((ext_vector_type(4)));
typedef float f32x4 __attribute__((ext_vector_type(4)));
typedef float f32x16 __attribute__((ext_vector_type(16)));
typedef unsigned u32x4 __attribute__((ext_vector_type(4)));
typedef unsigned u32x2 __attribute__((ext_vector_type(2)));

constexpr int M_TOK = 16384, SEQ = 8192, DM = 1024, FF = 2816, DEPTH = 4;
constexpr int ZC = 3072;
constexpr int Z_AQ = 0, Z_AK = 512, Z_AV = 1024, Z_BQ = 1536, Z_BK = 2048, Z_BV = 2176, Z_CQ = 2304, Z_CKV = 2688, Z_CKR = 2944;
constexpr float EPS = 1e-6f;
constexpr float LOG2E = 1.4426950408889634f;

constexpr size_t MiB = 1u << 20;
constexpr size_t WS_W13A = 0, WS_W2A = 11 * MiB, WS_W13B = 33 * MiB / 2, WS_W2B = 55 * MiB / 2, WS_WIG = 33 * MiB, WS_WUQ = 45 * MiB,
                 WS_WUKV = 46 * MiB, WS_WB = 47 * MiB, WS_WO = 50 * MiB;
constexpr size_t WS_BAR = 54 * MiB, BAR_BYTES = 65536;
constexpr size_t WS_XB = 56 * MiB, WS_SSQ = 88 * MiB, WS_SSQZ = 89 * MiB, WS_ROPE = 91 * MiB;
constexpr size_t WS_R0 = 96 * MiB;
constexpr size_t WS_G = 192 * MiB, WS_QC = 288 * MiB, WS_KC = 312 * MiB, WS_VC = 336 * MiB, WS_O3 = 352 * MiB, WS_SCR = 400 * MiB, WS_END = 432 * MiB;

typedef float f32x2_t __attribute__((ext_vector_type(2)));
typedef __bf16 bf16x2_t __attribute__((ext_vector_type(2)));
__device__ __forceinline__ unsigned cvt_pk_bf16(float lo, float hi) { f32x2_t v = {lo, hi}; bf16x2_t b = __builtin_convertvector(v, bf16x2_t); return __builtin_bit_cast(unsigned, b); }
__device__ __forceinline__ int lane_id() { int r; asm volatile("v_mbcnt_lo_u32_b32 %0, -1, 0\n\tv_mbcnt_hi_u32_b32 %0, -1, %0" : "=v"(r)); return r; }
__device__ __forceinline__ float uni(float x) { return __int_as_float(__builtin_amdgcn_readfirstlane(__float_as_int(x))); }
__device__ __forceinline__ float shfl_xor_f(float v, int m) { return __int_as_float(__builtin_amdgcn_ds_bpermute((lane_id() ^ m) << 2, __float_as_int(v))); }
__device__ __forceinline__ float bf16_lo(unsigned w) { return __uint_as_float(w << 16); }
__device__ __forceinline__ float bf16_hi(unsigned w) { return __uint_as_float(w & 0xffff0000u); }
__device__ __forceinline__ float fast_rsq(float x) { return __builtin_amdgcn_rsqf(x); }
__device__ __forceinline__ float sum4(f32x4 a) { return (a.x + a.y) + (a.z + a.w); }
__device__ __forceinline__ float dot4(f32x4 a) { return (a.x * a.x + a.y * a.y) + (a.z * a.z + a.w * a.w); }

namespace pg8 {
constexpr int BM = 256, BK = 64, HALF = 128, HTB = HALF * BK * 2, STAGE_BYTES = 8 * HTB, NXCD = 8, WGM = 8;
__host__ __device__ __forceinline__ int lds_byte(int r, int c) { const int st = (r >> 4) * 2 + (c >> 5), rr = r & 15, cc = c & 31, ob = rr * 64 + cc * 2; return st * 1024 + (ob ^ (((ob >> 9) & 1) << 5)); }
__host__ __device__ __forceinline__ void stage_rc(int b, int& R, int& C) { const int st = b / 1024, sb = b % 1024, swz = sb ^ (((sb >> 9) & 1) << 5); R = (st >> 1) * 16 + swz / 64; C = (st & 1) * 32 + (swz % 64) / 2; }
__host__ __device__ __forceinline__ int perm32(int rho) { const int n = rho >> 4, i = rho & 15; return 8 * (i >> 2) + 4 * n + (i & 3); }

struct Unit { int pm, pn; };
struct Gemm { const bf16_t* A; const bf16_t* Bt; int M, N, K, lda, a_pn_shift, a_pn_stride; };

struct StaticOrder {
    int nM, nN, nwg, G, c;
    __device__ void init(int M, int N, int G_, int c_) { nM = M / BM; nN = N / BM; nwg = nM * nN; G = G_; c = c_; }
    __device__ bool next(int i, Unit& u) const {
        const long L = (long)i * G + c; if (L >= nwg) return false;
        int wgid = (int)L; { const int q = nwg / NXCD, r = nwg % NXCD, xcd = wgid % NXCD, off = wgid / NXCD; wgid = (xcd < r ? xcd * (q + 1) : r * (q + 1) + (xcd - r) * q) + off; }
        const int nig = WGM * nN, gid = wgid / nig, fm = gid * WGM, gsz = (nM - fm) < WGM ? (nM - fm) : WGM;
        u.pm = fm + ((wgid % nig) % gsz); u.pn = (wgid % nig) / gsz; return true;
    }
};
struct BranchOrder {
    StaticOrder so;
    __device__ void init(int G_, int c_) { so.init(M_TOK, DM, G_, c_); }
    __device__ bool next(int i, Unit& u) const { const int j = i / 3, n = i - 3 * j; Unit b; if (!so.next(j, b)) return false; u.pm = b.pm; u.pn = n * 4 + b.pn; return true; }
};

template <class Epi, class Sched>
__device__ __forceinline__ void gemm_phase(LAS unsigned char* lds, const Gemm g, const Sched& S, const Epi& E, int wave_) {
    int tid = wave_ * 64 + lane_id(); asm volatile("" : "+v"(tid));
    const int wid = __builtin_amdgcn_readfirstlane(tid >> 6), lane = tid & 63, wr = wid >> 2, wc = wid & 3, fr = lane & 15, fq = lane >> 4;
    const int K = g.K, nt = K / BK, lda = g.lda;
    const bf16_t* gA = g.A; const bf16_t* gB = g.Bt; asm volatile("" : "+s"(gA), "+s"(gB));
    unsigned voffA[2], voffB[2];
#pragma unroll
    for (int i = 0; i < 2; ++i) { int R, C; stage_rc(tid * 16 + i * 8192, R, C); const int Rb = Epi::PERM ? ((R & ~31) + perm32(R & 31)) : R;
        voffA[i] = (unsigned)(R * lda + C) * 2u; voffB[i] = (unsigned)(Rb * K + C) * 2u; }
    const size_t kstep = (size_t)(BK * 2);
    const size_t hstepA = (size_t)HALF * lda * 2, hstepB = (size_t)HALF * K * 2;
    const size_t tstepA = 2 * hstepA, tstepB = 2 * hstepB;
    const unsigned ldsw = (unsigned)wid * 1024u;
    const int aoff = lds_byte(wr * 64 + fr, fq * 8), boff = lds_byte(wc * 32 + fr, fq * 8);
#define PG8_SA(b, h) (((b) * 2 + (h)) * HTB)
#define PG8_SB(b, h) ((4 + (b) * 2 + (h)) * HTB)
#define PG8_STAGE(bufoff, gbase, voff) do { _Pragma("unroll") for (int _i = 0; _i < 2; ++_i) \
        __builtin_amdgcn_global_load_lds((const unsigned*)((const char*)(gbase) + (voff)[_i]), (LAS unsigned*)(lds + (bufoff) + ldsw + _i * 8192), 16, 0, 0); } while (0)
#define PG8_LDA(dst, b, h) do { _Pragma("unroll") for (int m = 0; m < 4; ++m) _Pragma("unroll") for (int k = 0; k < 2; ++k) dst[m][k] = *(const LAS bf16x8*)(lds + PG8_SA(b, h) + aoff + m * 2048 + k * 1024); } while (0)
#define PG8_LDB(dst, b, h) do { _Pragma("unroll") for (int n = 0; n < 2; ++n) _Pragma("unroll") for (int k = 0; k < 2; ++k) dst[n][k] = *(const LAS bf16x8*)(lds + PG8_SB(b, h) + boff + n * 2048 + k * 1024); } while (0)
#define PG8_MMA(ai, bj, At, Bt) do { __builtin_amdgcn_s_setprio(1); _Pragma("unroll") for (int m = 0; m < 4; ++m) _Pragma("unroll") for (int n = 0; n < 2; ++n) _Pragma("unroll") for (int k = 0; k < 2; ++k) \
        acc[ai][bj][m][n] = __builtin_amdgcn_mfma_f32_16x16x32_bf16(Bt[n][k], At[m][k], acc[ai][bj][m][n], 0, 0, 0); __builtin_amdgcn_s_setprio(0); } while (0)
#define PG8_WAIT_V(n) asm volatile("s_waitcnt vmcnt(" #n ")" ::: "memory")
#define PG8_WAIT_L(n) asm volatile("s_waitcnt lgkmcnt(" #n ")" ::: "memory")
#define PG8_BAR __builtin_amdgcn_s_barrier()
#define PG8_SCHED __builtin_amdgcn_sched_barrier(0)
#define PG8_APTR(u) ((const char*)gA + (size_t)(u).pm * tstepA + (size_t)((u).pn >> g.a_pn_shift) * (size_t)g.a_pn_stride)
    Unit cur, nxt; int ui = 0;
    if (!S.next(0, cur)) return;
    f32x4 acc[2][2][4][2];
#pragma unroll
    for (int a = 0; a < 2; ++a)
#pragma unroll
        for (int b = 0; b < 2; ++b)
#pragma unroll
            for (int m = 0; m < 4; ++m)
#pragma unroll
                for (int n = 0; n < 2; ++n) acc[a][b][m][n] = (f32x4){0.f, 0.f, 0.f, 0.f};
    bf16x8 At[4][2], B0[2][2], B1[2][2];
    const char* cA = PG8_APTR(cur); const char* cB = (const char*)gB + (size_t)cur.pn * tstepB;
    PG8_STAGE(PG8_SB(0, 0), cB, voffB); PG8_STAGE(PG8_SB(0, 1), cB + hstepB, voffB); PG8_STAGE(PG8_SA(0, 0), cA, voffA); PG8_STAGE(PG8_SA(0, 1), cA + hstepA, voffA);
    if (wr == 1) PG8_BAR;
    PG8_WAIT_V(2); PG8_BAR;
    PG8_STAGE(PG8_SB(1, 0), cB + kstep, voffB); PG8_STAGE(PG8_SA(1, 0), cA + kstep, voffA); PG8_STAGE(PG8_SB(1, 1), cB + hstepB + kstep, voffB);
    PG8_WAIT_V(6); PG8_BAR;
    for (;;) {
        const bool has_next = S.next(ui + 1, nxt);
        const char* nA = has_next ? PG8_APTR(nxt) : cA; const char* nB = has_next ? (const char*)gB + (size_t)nxt.pn * tstepB : cB;
        for (int t = 0; t < nt; t += 2) {
            const bool last = (t == nt - 2);
            const char* a1 = cA + (size_t)(t + 1) * kstep;
            const char* a2 = last ? nA : cA + (size_t)(t + 2) * kstep; const char* b2 = last ? nB : cB + (size_t)(t + 2) * kstep;
            const char* a3 = a2 + kstep; const char* b3 = b2 + kstep;
            PG8_LDB(B0, 0, 0); PG8_LDB(B1, 0, 1); PG8_SCHED; PG8_LDA(At, 0, 0); PG8_STAGE(PG8_SA(1, 1), a1 + hstepA, voffA);
            PG8_WAIT_V(8); PG8_WAIT_L(0); PG8_BAR; PG8_MMA(0, 0, At, B0); PG8_MMA(0, 1, At, B1); PG8_BAR; PG8_SCHED;
            PG8_LDA(At, 0, 1); PG8_STAGE(PG8_SB(0, 0), b2, voffB); PG8_STAGE(PG8_SB(0, 1), b2 + hstepB, voffB); PG8_STAGE(PG8_SA(0, 0), a2, voffA);
            PG8_WAIT_V(8); PG8_WAIT_L(0); PG8_BAR; PG8_MMA(1, 0, At, B0); PG8_MMA(1, 1, At, B1); PG8_BAR; PG8_SCHED;
            PG8_LDB(B0, 1, 0); PG8_LDB(B1, 1, 1); PG8_SCHED; PG8_LDA(At, 1, 0); PG8_STAGE(PG8_SA(0, 1), a2 + hstepA, voffA);
            PG8_WAIT_V(8); PG8_WAIT_L(0); PG8_BAR; PG8_MMA(0, 0, At, B0); PG8_MMA(0, 1, At, B1); PG8_BAR; PG8_SCHED;
            PG8_LDA(At, 1, 1); PG8_STAGE(PG8_SB(1, 0), b3, voffB); PG8_STAGE(PG8_SB(1, 1), b3 + hstepB, voffB); PG8_STAGE(PG8_SA(1, 0), a3, voffA);
            PG8_WAIT_V(8); PG8_WAIT_L(0); PG8_BAR; PG8_MMA(1, 0, At, B0); PG8_MMA(1, 1, At, B1); PG8_BAR; PG8_SCHED;
        }
        if (wr == 0) PG8_BAR;
        E(acc, cur, wr, wc, fr, fq);
        if (!has_next) break;
#pragma unroll
        for (int a = 0; a < 2; ++a)
#pragma unroll
            for (int b = 0; b < 2; ++b)
#pragma unroll
                for (int m = 0; m < 4; ++m)
#pragma unroll
                    for (int n = 0; n < 2; ++n) acc[a][b][m][n] = (f32x4){0.f, 0.f, 0.f, 0.f};
        cur = nxt; cA = nA; cB = nB; ++ui;
        if (wr == 1) PG8_BAR;
    }
    PG8_WAIT_V(0);
    PG8_BAR;
#undef PG8_SA
#undef PG8_SB
#undef PG8_STAGE
#undef PG8_LDA
#undef PG8_LDB
#undef PG8_MMA
#undef PG8_WAIT_V
#undef PG8_WAIT_L
#undef PG8_BAR
#undef PG8_SCHED
#undef PG8_APTR
}
}

typedef f32x4 Acc[2][2][4][2];
__device__ __forceinline__ float rinv_sum(const float* p, int n4, float invn) {
    float s = 0.f;
#pragma unroll
    for (int i = 0; i < 5; ++i) if (i < n4) s += sum4(*(const f32x4*)(p + 4 * i));
    return fast_rsq(s * invn + EPS);
}
__device__ __forceinline__ float silu_mul(float a, float g) { return a * __builtin_amdgcn_rcpf(1.f + __builtin_amdgcn_exp2f(-a * LOG2E)) * g; }
__device__ __forceinline__ float sigmoidf(float a) { return __builtin_amdgcn_rcpf(1.f + __builtin_amdgcn_exp2f(-a * LOG2E)); }
__device__ __forceinline__ u32x4 pack8(f32x4 v0, f32x4 v1) { u32x4 w; w.x = cvt_pk_bf16(v0[0], v0[1]); w.y = cvt_pk_bf16(v0[2], v0[3]); w.z = cvt_pk_bf16(v1[0], v1[1]); w.w = cvt_pk_bf16(v1[2], v1[3]); return w; }

struct EpiSwiGLU {
    static constexpr bool PERM = true;
    bf16_t* H; const float* ssq;
    __device__ __forceinline__ void operator()(const Acc& acc, const pg8::Unit& u, int wr, int wc, int fr, int fq) const {
        const int row0 = u.pm * 256 + wr * 64 + fr, col0 = u.pn * 128 + wc * 32 + 8 * fq;
#pragma unroll
        for (int ai = 0; ai < 2; ++ai)
#pragma unroll
            for (int m = 0; m < 4; ++m) { const int row = row0 + ai * 128 + m * 16; const float r = rinv_sum(ssq + (size_t)row * 16, 4, 1.f / DM);
                f32x4 h0, h1;
#pragma unroll
                for (int j = 0; j < 4; ++j) { h0[j] = silu_mul(acc[ai][0][m][0][j] * r, acc[ai][1][m][0][j] * r); h1[j] = silu_mul(acc[ai][0][m][1][j] * r, acc[ai][1][m][1][j] * r); }
                *(u32x4*)(H + (size_t)row * FF + col0) = pack8(h0, h1); asm volatile("" ::: "memory"); }
    }
};
struct EpiResid {
    static constexpr bool PERM = false;
    float* x; bf16_t* xb; float* ssq; float coef;
    __device__ __forceinline__ void operator()(const Acc& acc, const pg8::Unit& u, int wr, int wc, int fr, int fq) const {
        const int row0 = u.pm * 256 + wr * 64 + fr, col0 = u.pn * 256 + wc * 32 + 4 * fq;
#pragma unroll
        for (int ai = 0; ai < 2; ++ai) {
            f32x4 xv[4][2][2];
#pragma unroll
            for (int m = 0; m < 4; ++m)
#pragma unroll
                for (int bj = 0; bj < 2; ++bj)
#pragma unroll
                    for (int n = 0; n < 2; ++n) xv[m][bj][n] = *(const f32x4*)(x + (size_t)(row0 + ai * 128 + m * 16) * DM + col0 + bj * 128 + n * 16);
#pragma unroll
            for (int m = 0; m < 4; ++m) { const int row = row0 + ai * 128 + m * 16; float s = 0.f;
#pragma unroll
                for (int bj = 0; bj < 2; ++bj)
#pragma unroll
                    for (int n = 0; n < 2; ++n) { const size_t off = (size_t)row * DM + col0 + bj * 128 + n * 16;
                        const f32x4 v = xv[m][bj][n] + acc[ai][bj][m][n] * coef;
                        *(f32x4*)(x + off) = v; s += dot4(v);
                        u32x2 w; w.x = cvt_pk_bf16(v[0], v[1]); w.y = cvt_pk_bf16(v[2], v[3]); *(u32x2*)(xb + off) = w; }
                s += shfl_xor_f(s, 16); s += shfl_xor_f(s, 32);
                if (fq == 0) ssq[(size_t)row * 16 + u.pn * 4 + wc] = s; }
            asm volatile("" ::: "memory"); }
    }
};
struct EpiInProj {
    static constexpr bool PERM = true;
    bf16_t* Z; bf16_t* Gt; bf16_t* KC; const float* ssq; float* ssqz; const float* bgate; const float* ropeC; const float* ropeS;
    __device__ __forceinline__ void operator()(const Acc& acc, const pg8::Unit& u, int wr, int wc, int fr, int fq) const {
        const int row0 = u.pm * 256 + wr * 64 + fr, cw = wc * 32 + 8 * fq;
        if (u.pn < 12) {
#pragma unroll
            for (int ai = 0; ai < 2; ++ai)
#pragma unroll
                for (int m = 0; m < 4; ++m) { const int row = row0 + ai * 128 + m * 16; const float r = rinv_sum(ssq + (size_t)row * 16, 4, 1.f / DM);
#pragma unroll
                    for (int bj = 0; bj < 2; ++bj) { f32x4 v0 = acc[ai][bj][m][0] * r, v1 = acc[ai][bj][m][1] * r;
                        if (u.pn >= 9) { float s = dot4(v0) + dot4(v1); s += shfl_xor_f(s, 16); s += shfl_xor_f(s, 32);
                            if (fq == 0) ssqz[(size_t)row * 24 + (u.pn - 9) * 8 + bj * 4 + wc] = s; }
                        if (u.pn == 11 && bj == 1 && wc < 2) {
                            const int pos = row & (SEQ - 1), j0 = 16 * wc + 4 * fq;
                            const f32x4 c = *(const f32x4*)(ropeC + pos * 32 + j0), s = *(const f32x4*)(ropeS + pos * 32 + j0);
                            f32x4 o0, o1;
                            o0[0] = v0[0] * c[0] - v0[1] * s[0]; o0[1] = v0[0] * s[0] + v0[1] * c[0]; o0[2] = v0[2] * c[1] - v0[3] * s[1]; o0[3] = v0[2] * s[1] + v0[3] * c[1];
                            o1[0] = v1[0] * c[2] - v1[1] * s[2]; o1[1] = v1[0] * s[2] + v1[1] * c[2]; o1[2] = v1[2] * c[3] - v1[3] * s[3]; o1[3] = v1[2] * s[3] + v1[3] * c[3];
                            const u32x4 w = pack8(o0, o1);
#pragma unroll
                            for (int h = 0; h < 4; ++h) *(u32x4*)(KC + (size_t)row * 768 + h * 192 + 128 + cw) = w;
                        }
                        *(u32x4*)(Z + (size_t)row * ZC + u.pn * 256 + bj * 128 + cw) = pack8(v0, v1); } asm volatile("" ::: "memory"); }
        } else {
            const int gc0 = (u.pn - 12) * 256 + cw;
#pragma unroll
            for (int bj = 0; bj < 2; ++bj) { const f32x4 b0 = *(const f32x4*)(bgate + gc0 + bj * 128), b1 = *(const f32x4*)(bgate + gc0 + bj * 128 + 4);
#pragma unroll
                for (int ai = 0; ai < 2; ++ai)
#pragma unroll
                    for (int m = 0; m < 4; ++m) { const int row = row0 + ai * 128 + m * 16; const float r = rinv_sum(ssq + (size_t)row * 16, 4, 1.f / DM);
                        f32x4 v0 = acc[ai][bj][m][0] * r + b0, v1 = acc[ai][bj][m][1] * r + b1;
#pragma unroll
                        for (int j = 0; j < 4; ++j) { v0[j] = sigmoidf(v0[j]); v1[j] = sigmoidf(v1[j]); }
                        *(u32x4*)(Gt + (size_t)row * 3072 + gc0 + bj * 128) = pack8(v0, v1); asm volatile("" ::: "memory"); } }
        }
    }
};
struct EpiUQ {
    static constexpr bool PERM = true;
    bf16_t* QC; const float* ssqz; const float* ropeC; const float* ropeS;
    __device__ __forceinline__ void operator()(const Acc& acc, const pg8::Unit& u, int wr, int wc, int fr, int fq) const {
        const int row0 = u.pm * 256 + wr * 64 + fr;
#pragma unroll
        for (int ai = 0; ai < 2; ++ai)
#pragma unroll
            for (int m = 0; m < 4; ++m) { const int row = row0 + ai * 128 + m * 16; const float r = rinv_sum(ssqz + (size_t)row * 24, 3, 1.f / 384.f);
#pragma unroll
                for (int bj = 0; bj < 2; ++bj) { const int c = u.pn * 256 + bj * 128 + wc * 32 + 8 * fq; const int e = c % 192;
                    f32x4 v0 = acc[ai][bj][m][0] * r, v1 = acc[ai][bj][m][1] * r;
                    if (e >= 128) { const int pos = row & (SEQ - 1), j0 = (e - 128) >> 1;
                        const f32x4 cc = *(const f32x4*)(ropeC + pos * 32 + j0), s = *(const f32x4*)(ropeS + pos * 32 + j0);
                        f32x4 o0, o1;
                        o0[0] = v0[0] * cc[0] - v0[1] * s[0]; o0[1] = v0[0] * s[0] + v0[1] * cc[0]; o0[2] = v0[2] * cc[1] - v0[3] * s[1]; o0[3] = v0[2] * s[1] + v0[3] * cc[1];
                        o1[0] = v1[0] * cc[2] - v1[1] * s[2]; o1[1] = v1[0] * s[2] + v1[1] * cc[2]; o1[2] = v1[2] * cc[3] - v1[3] * s[3]; o1[3] = v1[2] * s[3] + v1[3] * cc[3];
                        v0 = o0; v1 = o1; }
                    *(u32x4*)(QC + (size_t)row * 768 + c) = pack8(v0, v1); } asm volatile("" ::: "memory"); }
    }
};
struct EpiUKV {
    static constexpr bool PERM = true;
    bf16_t* KC; bf16_t* VC; const float* ssqz;
    __device__ __forceinline__ void operator()(const Acc& acc, const pg8::Unit& u, int wr, int wc, int fr, int fq) const {
        const int row0 = u.pm * 256 + wr * 64 + fr, cw = wc * 32 + 8 * fq, h = u.pn;
#pragma unroll
        for (int ai = 0; ai < 2; ++ai)
#pragma unroll
            for (int m = 0; m < 4; ++m) { const int row = row0 + ai * 128 + m * 16; const float r = rinv_sum(ssqz + (size_t)row * 24 + 12, 2, 1.f / 256.f);
                *(u32x4*)(KC + (size_t)row * 768 + h * 192 + cw) = pack8(acc[ai][0][m][0] * r, acc[ai][0][m][1] * r);
                *(u32x4*)(VC + (size_t)row * 512 + h * 128 + cw) = pack8(acc[ai][1][m][0] * r, acc[ai][1][m][1] * r); asm volatile("" ::: "memory"); }
    }
};
struct EpiGateAcc {
    static constexpr bool PERM = false;
    const bf16_t* Gt; float* mg; bf16_t* MB;
    __device__ __forceinline__ void operator()(const Acc& acc, const pg8::Unit& u, int wr, int wc, int fr, int fq) const {
        const int nb = u.pn >> 2, pno = u.pn & 3;
        const int row0 = u.pm * 256 + wr * 64 + fr, col0 = pno * 256 + wc * 32 + 4 * fq;
#pragma unroll
        for (int ai = 0; ai < 2; ++ai)
#pragma unroll
            for (int m = 0; m < 4; ++m) { const int row = row0 + ai * 128 + m * 16;
#pragma unroll
                for (int bj = 0; bj < 2; ++bj)
#pragma unroll
                    for (int n = 0; n < 2; ++n) { const int col = col0 + bj * 128 + n * 16; const size_t off = (size_t)row * DM + col;
                        const u32x2 gw = *(const u32x2*)(Gt + (size_t)row * 3072 + nb * 1024 + col);
                        f32x4 v = acc[ai][bj][m][n]; v[0] *= bf16_lo(gw.x); v[1] *= bf16_hi(gw.x); v[2] *= bf16_lo(gw.y); v[3] *= bf16_hi(gw.y);
                        if (nb > 0) { const u32x2 pw = *(const u32x2*)((const bf16_t*)mg + off); v[0] += bf16_lo(pw.x); v[1] += bf16_hi(pw.x); v[2] += bf16_lo(pw.y); v[3] += bf16_hi(pw.y); }
                        if (nb < 2) { u32x2 w; w.x = cvt_pk_bf16(v[0], v[1]); w.y = cvt_pk_bf16(v[2], v[3]); *(u32x2*)((bf16_t*)mg + off) = w; }
                        else { u32x2 w; w.x = cvt_pk_bf16(v[0], v[1]); w.y = cvt_pk_bf16(v[2], v[3]); *(u32x2*)(MB + off) = w; } } asm volatile("" ::: "memory"); }
    }
};

#ifdef A_SIMPLE
#define ATT_A_BODY att::attn_body_simple<64, 128, 1, ZC, ZC, ZC>
#else
#define ATT_A_BODY att::attn_body<64, 128, 1, 1, ZC, ZC, ZC>
#endif
namespace att {
#define SBAR() __builtin_amdgcn_sched_barrier(0)
__device__ __forceinline__ int crow(int r, int hi) { return (r & 3) + 8 * (r >> 2) + 4 * hi; }
template <int DQK> __device__ __forceinline__ int kswz(int row, int colB) { return row * (DQK * 2) + (colB ^ (((row >> 1) & 7) << 4)); }
template <int DV> __device__ __forceinline__ int v_st(int k, int c) { constexpr int NCB = DV / 32; const int kk = (k & ~0xC) | ((k & 4) << 1) | ((k & 8) >> 1); return ((kk >> 3) * NCB + (c >> 5)) * 512 + ((kk & 7) * 32 + (c & 31)) * 2; }
__device__ __forceinline__ int v_rd_base(int lane) { return ((lane & 3) << 3) | (((lane >> 2) & 3) << 6) | (((lane >> 4) & 1) << 5) | (((lane >> 5) & 1) << 8); }
template <int DV> constexpr int v_rd_off(int d0, int ks, int half) { return d0 * 512 + ks * (2 * (DV / 32) * 512) + half * ((DV / 32) * 512); }
template <int OFF> __device__ __forceinline__ s16x4 tr_read(int vb) { s16x4 r; asm volatile("ds_read_b64_tr_b16 %0, %1 offset:%2" : "=&v"(r) : "v"(vb), "i"(OFF) : "memory"); return r; }

__device__ __forceinline__ void partialSM(f32x16& p0, f32x16& p1, float& m_reg, float& mn, float& alpha, float C, float thr, float aoff = 0.f, bool nomax = false) {
    if (nomax) { mn = m_reg; alpha = 1.f; }
    else {
    float pmax = p0[0];
#pragma unroll
    for (int r = 1; r < 16; ++r) pmax = fmaxf(pmax, p0[r]);
#pragma unroll
    for (int r = 0; r < 16; ++r) pmax = fmaxf(pmax, p1[r]);
    pmax += aoff;
    { auto rr = __builtin_amdgcn_permlane32_swap(__float_as_uint(pmax), __float_as_uint(pmax), false, false); pmax = fmaxf(__uint_as_float(rr[0]), __uint_as_float(rr[1])); }
    if (__builtin_expect(__all(pmax - m_reg <= thr), 1)) { mn = m_reg; alpha = 1.f; }
    else { mn = fmaxf(m_reg, pmax); alpha = __builtin_amdgcn_exp2f((m_reg - mn) * C); m_reg = mn; }
    }
    const float mnC = mn < -1e29f ? 0.f : (aoff - mn) * C;
#pragma unroll
    for (int r = 0; r < 16; ++r) p0[r] = fmaf(p0[r], C, mnC);
#pragma unroll
    for (int r = 0; r < 16; ++r) p1[r] = fmaf(p1[r], C, mnC);
#pragma unroll
    for (int r = 0; r < 16; ++r) p0[r] = __builtin_amdgcn_exp2f(p0[r]);
}
__device__ __forceinline__ void finishSM(f32x16& p0, f32x16& p1, float alpha, float& l_reg, bf16x8& pa0, bf16x8& pa1, bf16x8& pa2, bf16x8& pa3) {
#pragma unroll
    for (int r = 0; r < 16; ++r) p1[r] = __builtin_amdgcn_exp2f(p1[r]);
    float ps = 0;
#pragma unroll
    for (int r = 0; r < 16; ++r) ps += p0[r];
#pragma unroll
    for (int r = 0; r < 16; ++r) ps += p1[r];
    { auto rr = __builtin_amdgcn_permlane32_swap(__float_as_uint(ps), __float_as_uint(ps), false, false); ps = __uint_as_float(rr[0]) + __uint_as_float(rr[1]); }
    l_reg = l_reg * alpha + ps;
#define PK4(P, BASE, OUT) do { unsigned a0 = cvt_pk_bf16(P[BASE + 0], P[BASE + 1]), a1 = cvt_pk_bf16(P[BASE + 2], P[BASE + 3]);   \
    unsigned b0 = cvt_pk_bf16(P[BASE + 4], P[BASE + 5]), b1 = cvt_pk_bf16(P[BASE + 6], P[BASE + 7]);                              \
    auto r0 = __builtin_amdgcn_permlane32_swap(a0, b0, false, false); auto r1 = __builtin_amdgcn_permlane32_swap(a1, b1, false, false); \
    u32x4 w = {r0[0], r1[0], r0[1], r1[1]}; OUT = *reinterpret_cast<bf16x8*>(&w); } while (0)
    PK4(p0, 0, pa0); PK4(p0, 8, pa1); PK4(p1, 0, pa2); PK4(p1, 8, pa3);
#undef PK4
}
template <int MODE> __device__ __forceinline__ float alibi_off(int rel, float dq, float sl) { return (MODE == 1 && (rel > 63 || rel < -31)) ? (rel > 63 ? -sl : sl) * dq : 0.f; }
template <int DQK, int MODE, int NQR = DQK / 16> __device__ __forceinline__ void qkt(f32x16& p0, f32x16& p1, LAS const char* Ks, const bf16x8* qr, int r32, int hi, float dq, float sl, LAS const char* qlds = nullptr, int rel = 0) {
    p0 = f32x16{}; p1 = f32x16{};
    if (NQR < DQK / 16) asm volatile("" : "+v"(qlds));
    const int x_ = ((r32 >> 1) & 7) << 4; int kb[4];
#pragma unroll
    for (int j = 0; j < 4; ++j) kb[j] = r32 * (DQK * 2) + ((j * 32 + hi * 16) ^ x_);
#pragma unroll
    for (int d0 = 0; d0 < DQK / 16; ++d0) {
        bf16x8 qf; if (d0 < NQR) qf = qr[d0 < NQR ? d0 : 0]; else qf = *(LAS const bf16x8*)(qlds + (d0 - NQR) * 1024);
        const bf16x8 b0 = *(LAS const bf16x8*)(Ks + kb[d0 & 3] + (d0 >> 2) * 128);
        const bf16x8 b1 = *(LAS const bf16x8*)(Ks + kb[d0 & 3] + (d0 >> 2) * 128 + 32 * (DQK * 2));
        p0 = __builtin_amdgcn_mfma_f32_32x32x16_bf16(b0, qf, p0, 0, 0, 0);
        p1 = __builtin_amdgcn_mfma_f32_32x32x16_bf16(b1, qf, p1, 0, 0, 0); }
    if (MODE == 1 && (rel > 63 || rel < -31)) {
        const float ss = rel > 63 ? sl : -sl;
#pragma unroll
        for (int r = 0; r < 16; ++r) { const float c = (float)((r & 3) + 8 * (r >> 2)); p0[r] = fmaf(ss, c, p0[r]); p1[r] = fmaf(ss, c + 32.f, p1[r]); }
    } else if (MODE != 0) {
#pragma unroll
        for (int r = 0; r < 16; ++r) { const float c = (float)((r & 3) + 8 * (r >> 2)); const float d0 = fabsf(dq - c), d1 = fabsf(dq - 32.f - c);
            if (MODE == 1) { p0[r] = fmaf(-sl, d0, p0[r]); p1[r] = fmaf(-sl, d1, p1[r]); }
            else { p0[r] = d0 > 128.f ? -1e30f : fmaf(-sl, d0, p0[r]); p1[r] = d1 > 128.f ? -1e30f : fmaf(-sl, d1, p1[r]); } }
    }
}
template <int D0, int DV> __device__ __forceinline__ void pv_one(f32x16& od, int vb, bf16x8 pa0, bf16x8 pa1, bf16x8 pa2, bf16x8 pa3) {
    const s16x4 l0 = tr_read<v_rd_off<DV>(D0, 0, 0)>(vb), h0 = tr_read<v_rd_off<DV>(D0, 0, 1)>(vb), l1 = tr_read<v_rd_off<DV>(D0, 1, 0)>(vb), h1 = tr_read<v_rd_off<DV>(D0, 1, 1)>(vb);
    const s16x4 l2 = tr_read<v_rd_off<DV>(D0, 2, 0)>(vb), h2 = tr_read<v_rd_off<DV>(D0, 2, 1)>(vb), l3 = tr_read<v_rd_off<DV>(D0, 3, 0)>(vb), h3 = tr_read<v_rd_off<DV>(D0, 3, 1)>(vb);
    asm volatile("s_waitcnt lgkmcnt(0)" ::: "memory"); SBAR();
#define PK(L, H) (bf16x8){L[0], L[1], L[2], L[3], H[0], H[1], H[2], H[3]}
    od = __builtin_amdgcn_mfma_f32_32x32x16_bf16(pa0, PK(l0, h0), od, 0, 0, 0);
    od = __builtin_amdgcn_mfma_f32_32x32x16_bf16(pa1, PK(l1, h1), od, 0, 0, 0);
    od = __builtin_amdgcn_mfma_f32_32x32x16_bf16(pa2, PK(l2, h2), od, 0, 0, 0);
    od = __builtin_amdgcn_mfma_f32_32x32x16_bf16(pa3, PK(l3, h3), od, 0, 0, 0);
#undef PK
}
template <int DV> __device__ __forceinline__ void pv_all(f32x16* o, int vb, bf16x8 pa0, bf16x8 pa1, bf16x8 pa2, bf16x8 pa3) {
    pv_one<0, DV>(o[0], vb, pa0, pa1, pa2, pa3); pv_one<1, DV>(o[1], vb, pa0, pa1, pa2, pa3);
    if constexpr (DV == 128) { pv_one<2, DV>(o[2], vb, pa0, pa1, pa2, pa3); pv_one<3, DV>(o[3], vb, pa0, pa1, pa2, pa3); }
}

template <int DQK, int DV, int MODE, int SD, int LDQ, int LDK, int LDV, int NQL = 0, class Epi>
__device__ __forceinline__ void attn_body(const bf16_t* __restrict__ Qb, const bf16_t* __restrict__ Kh, const bf16_t* __restrict__ Vh, int kstart, int NT, int qpos0,
                                          float scale, float slope, float sinkl2, LAS char* lds, const Epi& epi, int wave_, int safe_nomax = 0) {
    asm volatile("" : "+s"(Qb), "+s"(Kh), "+s"(Vh));
    constexpr int SHM_V = 64 * DV * 2, SHM_K = 64 * DQK * 2, NQ = DQK / 16, NO = DV / 32;
    constexpr int KCH = DQK / 8, NKC = 64 * KCH / 512, VCH = DV / 8, NVC = 64 * VCH / 512;
    int tid = wave_ * 64 + lane_id(); asm volatile("" : "+v"(tid));
    const int wid = tid >> 6, lane = tid & 63, r32 = lane & 31, hi = lane >> 5;
    LAS char* V_lds = lds; LAS char* K_lds = lds + 2 * SHM_V;
    LAS float* wsf = (LAS float*)(lds + 2 * SHM_V + 2 * SHM_K) + wid * 64; LAS float* li_l = wsf; LAS float* al_l = wsf + 32;
    const float C = scale * LOG2E, thr = 8.f / scale, sl = slope / scale;
    const float dq0 = (float)(qpos0 + wid * 32 + r32 - kstart - 4 * hi);
    constexpr int NQR = NQ - NQL;
    LAS char* qlds = lds + 2 * SHM_V + 2 * SHM_K + 2048 + wid * (NQL * 1024) + lane * 16;
    float m_reg = -1e30f, l_reg = 0; f32x16 o[NO]; bf16x8 qr[NQR > 0 ? NQR : 1];
#pragma unroll
    for (int d = 0; d < NO; ++d) o[d] = f32x16{};
    const GAS bf16_t* Qw = (const GAS bf16_t*)Qb + (size_t)(wid * 32 + r32) * LDQ + hi * 8;
#pragma unroll
    for (int d0 = 0; d0 < NQ; ++d0) { const bf16x8 qv = *(const GAS bf16x8*)(Qw + d0 * 16); if (d0 < NQR) qr[d0 < NQR ? d0 : 0] = qv; else *(LAS bf16x8*)(qlds + (d0 - NQR) * 1024) = qv; }
    int koff[NKC], kst[NKC], voff[NVC], vst[NVC];
#pragma unroll
    for (int i = 0; i < NKC; ++i) { const int c = tid + 512 * i, row = c / KCH, c8 = c % KCH; koff[i] = row * LDK + c8 * 8; kst[i] = kswz<DQK>(row, c8 * 16); }
#pragma unroll
    for (int i = 0; i < NVC; ++i) { const int c = tid + 512 * i, row = c / VCH, c8 = c % VCH; voff[i] = row * LDV + c8 * 8; vst[i] = v_st<DV>(row, c8 * 8); }
    const int vb0 = (int)(unsigned)(size_t)V_lds + v_rd_base(lane);
    struct { bf16x8 k[NKC]; bf16x8 v[NVC]; } sr_[SD];
    const GAS bf16_t* Kp = (const GAS bf16_t*)Kh + (size_t)kstart * LDK; const GAS bf16_t* Vp = (const GAS bf16_t*)Vh + (size_t)kstart * LDV;
#define SLOAD(i, k0) do { if constexpr (NQL > 0) { int t_ = tid; asm volatile("" : "+v"(t_)); \
      _Pragma("unroll") for (int _c = 0; _c < NVC; ++_c) { const int c_ = t_ + 512 * _c; sr_[i].v[_c] = *(const GAS bf16x8*)(Vp + (size_t)((k0) + c_ / VCH) * LDV + (c_ % VCH) * 8); } \
      _Pragma("unroll") for (int _c = 0; _c < NKC; ++_c) { const int c_ = t_ + 512 * _c; sr_[i].k[_c] = *(const GAS bf16x8*)(Kp + (size_t)((k0) + c_ / KCH) * LDK + (c_ % KCH) * 8); } } else { \
    _Pragma("unroll") for (int _c = 0; _c < NVC; ++_c) sr_[i].v[_c] = *(const GAS bf16x8*)(Vp + (size_t)(k0) * LDV + voff[_c]); \
    _Pragma("unroll") for (int _c = 0; _c < NKC; ++_c) sr_[i].k[_c] = *(const GAS bf16x8*)(Kp + (size_t)(k0) * LDK + koff[_c]); } } while (0)
#define SWRITE(b, i) do { if constexpr (NQL > 0) { int t_ = tid; asm volatile("" : "+v"(t_)); \
      _Pragma("unroll") for (int _c = 0; _c < NVC; ++_c) { const int c_ = t_ + 512 * _c; *(LAS bf16x8*)(V_lds + (b) * SHM_V + v_st<DV>(c_ / VCH, (c_ % VCH) * 8)) = sr_[i].v[_c]; } \
      _Pragma("unroll") for (int _c = 0; _c < NKC; ++_c) { const int c_ = t_ + 512 * _c; *(LAS bf16x8*)(K_lds + (b) * SHM_K + kswz<DQK>(c_ / KCH, (c_ % KCH) * 16)) = sr_[i].k[_c]; } } else { \
    _Pragma("unroll") for (int _c = 0; _c < NVC; ++_c) *(LAS bf16x8*)(V_lds + (b) * SHM_V + vst[_c]) = sr_[i].v[_c]; \
    _Pragma("unroll") for (int _c = 0; _c < NKC; ++_c) *(LAS bf16x8*)(K_lds + (b) * SHM_K + kst[_c]) = sr_[i].k[_c]; } } while (0)
#define RESC(a) do { if (__any((a) < 1.f)) { if (hi == 0) al_l[r32] = (a); asm volatile("s_waitcnt lgkmcnt(0)" ::: "memory"); \
    _Pragma("unroll") for (int d = 0; d < NO; ++d) _Pragma("unroll") for (int r = 0; r < 16; ++r) o[d][r] *= al_l[crow(r, hi)]; } } while (0)
    f32x16 pA0, pA1, pB0, pB1; float mnA, mnB, alA, alB; bf16x8 pa0, pa1, pa2, pa3;
    const int rel0 = qpos0 + __builtin_amdgcn_readfirstlane(wid) * 32 - kstart;
    constexpr int SE = 0, SO = SD - 1;
    __syncthreads();
    SLOAD(SE, 0); asm volatile("s_waitcnt vmcnt(0)" ::: "memory"); SWRITE(0, SE); __syncthreads();
    qkt<DQK, MODE, NQR>(pA0, pA1, K_lds, qr, r32, hi, dq0, sl, qlds, rel0); partialSM(pA0, pA1, m_reg, mnA, alA, C, thr, alibi_off<MODE>(rel0, dq0, sl), MODE == 1 && safe_nomax && rel0 < -31);
    SLOAD(SO, 64); if constexpr (SD == 2) { if (2 < NT) SLOAD(SE, 128); }
    SWRITE(1, SO); __syncthreads();
    for (int j = 1; j + 1 < NT; j += 2) {
        SBAR(); qkt<DQK, MODE, NQR>(pB0, pB1, K_lds + SHM_K, qr, r32, hi, dq0 - 64.f * (float)j, sl, qlds, rel0 - 64 * j);
        finishSM(pA0, pA1, alA, l_reg, pa0, pa1, pa2, pa3); SBAR();
        SLOAD(SO, (j + SD) * 64); SBAR();
        pv_all<DV>(o, vb0, pa0, pa1, pa2, pa3); partialSM(pB0, pB1, m_reg, mnB, alB, C, thr, alibi_off<MODE>(rel0 - 64 * j, dq0 - 64.f * (float)j, sl), MODE == 1 && safe_nomax && rel0 - 64 * j < -31);
        __syncthreads(); SWRITE(0, SE);
        RESC(alB); __syncthreads();
        SBAR(); qkt<DQK, MODE, NQR>(pA0, pA1, K_lds, qr, r32, hi, dq0 - 64.f * (float)(j + 1), sl, qlds, rel0 - 64 * (j + 1));
        finishSM(pB0, pB1, alB, l_reg, pa0, pa1, pa2, pa3); SBAR();
        if (SD == 1 || j + 3 < NT) SLOAD(SE, (j + 1 + SD) * 64); SBAR();
        pv_all<DV>(o, vb0 + SHM_V, pa0, pa1, pa2, pa3); partialSM(pA0, pA1, m_reg, mnA, alA, C, thr, alibi_off<MODE>(rel0 - 64 * (j + 1), dq0 - 64.f * (float)(j + 1), sl), MODE == 1 && safe_nomax && rel0 - 64 * (j + 1) < -31);
        __syncthreads(); SWRITE(1, SO);
        RESC(alA); __syncthreads();
    }
    SBAR(); qkt<DQK, MODE, NQR>(pB0, pB1, K_lds + SHM_K, qr, r32, hi, dq0 - 64.f * (float)(NT - 1), sl, qlds, rel0 - 64 * (NT - 1));
    finishSM(pA0, pA1, alA, l_reg, pa0, pa1, pa2, pa3); SBAR();
    pv_all<DV>(o, vb0, pa0, pa1, pa2, pa3); partialSM(pB0, pB1, m_reg, mnB, alB, C, thr, alibi_off<MODE>(rel0 - 64 * (NT - 1), dq0 - 64.f * (float)(NT - 1), sl), MODE == 1 && safe_nomax && rel0 - 64 * (NT - 1) < -31);
    __syncthreads(); RESC(alB);
    finishSM(pB0, pB1, alB, l_reg, pa0, pa1, pa2, pa3); SBAR();
    pv_all<DV>(o, vb0 + SHM_V, pa0, pa1, pa2, pa3);
    if (MODE == 2) l_reg += __builtin_amdgcn_exp2f(sinkl2 - m_reg * C);
    if (hi == 0) li_l[r32] = l_reg; asm volatile("s_waitcnt lgkmcnt(0)" ::: "memory");
    float rli[16];
#pragma unroll
    for (int r = 0; r < 16; ++r) rli[r] = __builtin_amdgcn_rcpf(li_l[crow(r, hi)]);
    epi(o, rli, wid, r32, hi);
#undef SLOAD
#undef SWRITE
#undef RESC
}

template <int DQK, int DV, int MODE, int LDQ, int LDK, int LDV, class Epi>
__device__ __forceinline__ void attn_body_simple(const bf16_t* __restrict__ Qb, const bf16_t* __restrict__ Kh, const bf16_t* __restrict__ Vh, int kstart, int NT, int qpos0,
                                                 float scale, float slope, float sinkl2, LAS char* lds, const Epi& epi, int wave_) {
    asm volatile("" : "+s"(Qb), "+s"(Kh), "+s"(Vh));
    constexpr int SHM_V = 64 * DV * 2, SHM_K = 64 * DQK * 2, NQ = DQK / 16, NO = DV / 32;
    constexpr int KCH = DQK / 8, NKC = 64 * KCH / 512, VCH = DV / 8, NVC = 64 * VCH / 512;
    int tid = wave_ * 64 + lane_id(); asm volatile("" : "+v"(tid));
    const int wid = tid >> 6, lane = tid & 63, r32 = lane & 31, hi = lane >> 5;
    LAS char* V_lds = lds; LAS char* K_lds = lds + 3 * SHM_V;
    LAS float* wsf = (LAS float*)(lds + 3 * SHM_V + 3 * SHM_K) + wid * 64; LAS float* li_l = wsf; LAS float* al_l = wsf + 32;
    const float C = scale * LOG2E, thr = 8.f / scale, sl = slope / scale;
    const float dq0 = (float)(qpos0 + wid * 32 + r32 - kstart - 4 * hi);
    float m_reg = -1e30f, l_reg = 0; f32x16 o[NO]; bf16x8 qr[NQ];
#pragma unroll
    for (int d = 0; d < NO; ++d) o[d] = f32x16{};
    const GAS bf16_t* Qw = (const GAS bf16_t*)Qb + (size_t)(wid * 32 + r32) * LDQ + hi * 8;
#pragma unroll
    for (int d0 = 0; d0 < NQ; ++d0) qr[d0] = *(const GAS bf16x8*)(Qw + d0 * 16);
    const int vb0 = (int)(unsigned)(size_t)V_lds + v_rd_base(lane);
    bf16x8 sk[NKC], sv[NVC];
    const GAS bf16_t* Kp = (const GAS bf16_t*)Kh + (size_t)kstart * LDK; const GAS bf16_t* Vp = (const GAS bf16_t*)Vh + (size_t)kstart * LDV;
#define S1LOAD(k0) do { _Pragma("unroll") for (int _c = 0; _c < NVC; ++_c) { const int c_ = tid + 512 * _c; sv[_c] = *(const GAS bf16x8*)(Vp + (size_t)((k0) + c_ / VCH) * LDV + (c_ % VCH) * 8); } \
    _Pragma("unroll") for (int _c = 0; _c < NKC; ++_c) { const int c_ = tid + 512 * _c; sk[_c] = *(const GAS bf16x8*)(Kp + (size_t)((k0) + c_ / KCH) * LDK + (c_ % KCH) * 8); } } while (0)
#define S1WRITE(b) do { _Pragma("unroll") for (int _c = 0; _c < NVC; ++_c) { const int c_ = tid + 512 * _c; *(LAS bf16x8*)(V_lds + (b) * SHM_V + v_st<DV>(c_ / VCH, (c_ % VCH) * 8)) = sv[_c]; } \
    _Pragma("unroll") for (int _c = 0; _c < NKC; ++_c) { const int c_ = tid + 512 * _c; *(LAS bf16x8*)(K_lds + (b) * SHM_K + kswz<DQK>(c_ / KCH, (c_ % KCH) * 16)) = sk[_c]; } } while (0)
    __syncthreads();
    S1LOAD(0); S1WRITE(0); S1LOAD(64); S1WRITE(1);
    if (2 < NT) S1LOAD(128);
    int slot = 0;
    for (int j = 0; j < NT; ++j) {
        __syncthreads();
        { const int wslot = slot == 0 ? 2 : slot - 1;
          if (j + 2 < NT) { S1WRITE(wslot); if (j + 3 < NT) S1LOAD((j + 3) * 64); } }
        f32x16 p0, p1; float mn, al; bf16x8 pa0, pa1, pa2, pa3;
        qkt<DQK, MODE>(p0, p1, K_lds + slot * SHM_K, qr, r32, hi, dq0 - 64.f * (float)j, sl);
        partialSM(p0, p1, m_reg, mn, al, C, thr);
        finishSM(p0, p1, al, l_reg, pa0, pa1, pa2, pa3);
        if (__any(al < 1.f)) { if (hi == 0) al_l[r32] = al; asm volatile("s_waitcnt lgkmcnt(0)" ::: "memory");
#pragma unroll
            for (int d = 0; d < NO; ++d)
#pragma unroll
                for (int r = 0; r < 16; ++r) o[d][r] *= al_l[crow(r, hi)]; }
        SBAR();
        pv_all<DV>(o, vb0 + slot * SHM_V, pa0, pa1, pa2, pa3);
        slot = slot == 2 ? 0 : slot + 1;
    }
#undef S1LOAD
#undef S1WRITE
    if (MODE == 2) l_reg += __builtin_amdgcn_exp2f(sinkl2 - m_reg * C);
    if (hi == 0) li_l[r32] = l_reg; asm volatile("s_waitcnt lgkmcnt(0)" ::: "memory");
    float rli[16];
#pragma unroll
    for (int r = 0; r < 16; ++r) rli[r] = __builtin_amdgcn_rcpf(li_l[crow(r, hi)]);
    epi(o, rli, wid, r32, hi);
}

template <int NO> struct EpiStoreBf16 {
    bf16_t* O; int ldo;
    __device__ __forceinline__ void operator()(const f32x16* o, const float* rli, int wid, int r32, int hi) const {
        bf16_t* Ob = O; asm volatile("" : "+s"(Ob));
#pragma unroll
        for (int r = 0; r < 16; ++r) { GAS bf16_t* p = (GAS bf16_t*)Ob + (size_t)(wid * 32 + crow(r, hi)) * ldo + r32;
#pragma unroll
            for (int d0 = 0; d0 < NO; ++d0) p[d0 * 32] = (bf16_t)(cvt_pk_bf16(o[d0][r] * rli[r], 0.f) & 0xffffu); }
    }
};
struct EpiDiff0 {
    float* scr;
    __device__ __forceinline__ void operator()(const f32x16* o, const float* rli, int wid, int r32, int hi) const {
        float* sb = scr; asm volatile("" : "+s"(sb));
        int t_ = wid * 64 + hi * 32 + r32; GAS f32x4* p = (GAS f32x4*)(sb + t_ * 64);
#pragma unroll
        for (int d0 = 0; d0 < 4; ++d0)
#pragma unroll
            for (int q = 0; q < 4; ++q) { f32x4 v;
#pragma unroll
                for (int i = 0; i < 4; ++i) v[i] = o[d0][4 * q + i] * rli[4 * q + i];
                p[d0 * 4 + q] = v; }
    }
};
struct EpiDiff1 {
    const float* scr; bf16_t* O; int ldo; const float* g; float lam, oscale;
    __device__ __forceinline__ void operator()(const f32x16* o, const float* rli, int wid, int r32, int hi) const {
        const float* sb = scr; bf16_t* Ob = O; asm volatile("" : "+s"(sb), "+s"(Ob));
        int t_ = wid * 64 + hi * 32 + r32; const GAS f32x4* p = (const GAS f32x4*)(sb + t_ * 64); float gv[4];
#pragma unroll
        for (int d0 = 0; d0 < 4; ++d0) gv[d0] = g[d0 * 32 + r32] * oscale;
#pragma unroll
        for (int q = 0; q < 4; ++q) { f32x4 t[4];
#pragma unroll
            for (int d0 = 0; d0 < 4; ++d0) t[d0] = p[d0 * 4 + q];
#pragma unroll
            for (int i = 0; i < 4; ++i) { const int r = 4 * q + i; float s = 0.f;
#pragma unroll
                for (int d0 = 0; d0 < 4; ++d0) { t[d0][i] -= lam * (o[d0][r] * rli[r]); s += t[d0][i] * t[d0][i]; }
                s += shfl_xor_f(s, 1); s += shfl_xor_f(s, 2); s += shfl_xor_f(s, 4); s += shfl_xor_f(s, 8); s += shfl_xor_f(s, 16);
                const float rn = fast_rsq(s * (1.f / 128.f) + EPS);
                GAS bf16_t* qp = (GAS bf16_t*)Ob + (size_t)(wid * 32 + crow(r, hi)) * ldo + r32;
#pragma unroll
                for (int d0 = 0; d0 < 4; ++d0) qp[d0 * 32] = (bf16_t)(cvt_pk_bf16(t[d0][i] * rn * gv[d0], 0.f) & 0xffffu); }
            asm volatile("" ::: "memory"); }
    }
};
}

__device__ __forceinline__ float wave_sum(float v) {
#pragma unroll
    for (int o = 1; o < 64; o <<= 1) v += shfl_xor_f(v, o);
    return v;
}
template <int MODE> __device__ __forceinline__ int src_col(int n) {
    if (MODE == 1) { const int t = n >> 8, j = n & 255; return j < 128 ? t * 128 + j : FF + t * 128 + (j - 128); }
    if (MODE == 2) { if (n < Z_CKR) return n; if (n < 3008) { const int e = n - Z_CKR; return Z_CKR + (e >> 1) + 32 * (e & 1); } return -1; }
    if (MODE == 3) { const int h = n / 192, e = n - h * 192; if (e < 128) return n; const int e2 = e - 128; return h * 192 + 128 + (e2 >> 1) + 32 * (e2 & 1); }
    return n;
}
template <int MODE> __device__ __forceinline__ void tr_item(const float* __restrict__ W, int K, int Nsrc, const float* __restrict__ gain, bf16_t* WT, int nblk, LAS float* scr, int item, int lane) {
    const int kb = item / nblk, nb = item - kb * nblk, k0 = 64 * kb, n0 = 32 * nb;
    const int sc0 = src_col<MODE>(n0), sc31 = src_col<MODE>(n0 + 31);
    if (sc0 >= 0 && sc31 == sc0 + 31 && (sc0 & 3) == 0) {
        const int row8 = lane >> 3, n4 = (lane & 7) * 4;
#pragma unroll
        for (int i = 0; i < 8; ++i) { const int kk = 8 * i + row8; f32x4 v = *(const f32x4*)(W + (size_t)(k0 + kk) * Nsrc + sc0 + n4);
            if (gain) v = v * gain[k0 + kk];
            LAS float* d = scr + kk * 33 + n4; d[0] = v[0]; d[1] = v[1]; d[2] = v[2]; d[3] = v[3]; }
    } else {
        const int sc = src_col<MODE>(n0 + (lane & 31));
#pragma unroll
        for (int i = 0; i < 32; ++i) { const int kk = 2 * i + (lane >> 5); float v = 0.f;
            if (sc >= 0) { v = W[(size_t)(k0 + kk) * Nsrc + sc]; if (gain) v *= gain[k0 + kk]; }
            scr[kk * 33 + (lane & 31)] = v; }
    }
    asm volatile("s_waitcnt lgkmcnt(0)" ::: "memory");
    const int c = lane & 7;
#pragma unroll
    for (int j = 0; j < 4; ++j) { const int n = (lane >> 3) + 8 * j; const LAS float* s = scr + (8 * c) * 33 + n;
        u32x4 o; o.x = cvt_pk_bf16(s[0 * 33], s[1 * 33]); o.y = cvt_pk_bf16(s[2 * 33], s[3 * 33]); o.z = cvt_pk_bf16(s[4 * 33], s[5 * 33]); o.w = cvt_pk_bf16(s[6 * 33], s[7 * 33]);
        *(u32x4*)(WT + (size_t)(n0 + n) * K + k0 + 8 * c) = o; }
    asm volatile("s_waitcnt lgkmcnt(0)" ::: "memory");
}

struct Args { const float* in[21]; float* out; unsigned char* ws; int ph_lo, ph_hi; };
enum { I_X = 0, I_F1N, I_F1W13, I_F1W2, I_MIXN, I_WIN, I_WGATE, I_BGATE, I_ALAM, I_ASUB, I_BSINK, I_CQN, I_CWUQ, I_CKVN, I_CWUKV, I_WBR, I_WOUT, I_F2N, I_F2W13, I_F2W2, I_FINN };

constexpr int LDS_BYTES = 155648;

struct TrDesc { const float* W; const float* gain; bf16_t* WT; int K, Nsrc, nblk, mode, r; };
__device__ __forceinline__ int src_col_rt(int mode, int n) { return mode == 1 ? src_col<1>(n) : mode == 2 ? src_col<2>(n) : mode == 3 ? src_col<3>(n) : n; }
__device__ __forceinline__ bool tr_decode(const Args& a, int l, unsigned char* ws, int it, TrDesc& d) {
    constexpr int I_W13 = (DM / 64) * (2 * FF / 32), I_W2 = (FF / 64) * (DM / 32), I_IN = (DM / 64) * (3072 / 32), I_GT = I_IN,
                  I_UQ = (384 / 64) * (768 / 32), I_UKV = (256 / 64) * (1024 / 32), I_BR = (512 / 64) * (1024 / 32), I_OUT = (DM / 64) * (DM / 32);
    constexpr int NITEMS = 2 * I_W13 + 2 * I_W2 + I_IN + I_GT + I_UQ + I_UKV + 3 * I_BR + I_OUT;
    if (it >= NITEMS) return false;
    int r = it;
#define TR_SET(W_, K_, NS_, G_, WT_, NB_, M_) do { d.W = (W_); d.K = (K_); d.Nsrc = (NS_); d.gain = (G_); d.WT = (WT_); d.nblk = (NB_); d.mode = (M_); d.r = r; return true; } while (0)
    if (r < I_W13) TR_SET(a.in[I_F1W13] + (size_t)l * DM * 2 * FF, DM, 2 * FF, a.in[I_F1N] + l * DM, (bf16_t*)(ws + WS_W13A), 2 * FF / 32, 1); r -= I_W13;
    if (r < I_W13) TR_SET(a.in[I_F2W13] + (size_t)l * DM * 2 * FF, DM, 2 * FF, a.in[I_F2N] + l * DM, (bf16_t*)(ws + WS_W13B), 2 * FF / 32, 1); r -= I_W13;
    if (r < I_W2) TR_SET(a.in[I_F1W2] + (size_t)l * FF * DM, FF, DM, nullptr, (bf16_t*)(ws + WS_W2A), DM / 32, 0); r -= I_W2;
    if (r < I_W2) TR_SET(a.in[I_F2W2] + (size_t)l * FF * DM, FF, DM, nullptr, (bf16_t*)(ws + WS_W2B), DM / 32, 0); r -= I_W2;
    if (r < I_IN) TR_SET(a.in[I_WIN] + (size_t)l * DM * 3008, DM, 3008, a.in[I_MIXN] + l * DM, (bf16_t*)(ws + WS_WIG), 3072 / 32, 2); r -= I_IN;
    if (r < I_GT) TR_SET(a.in[I_WGATE] + (size_t)l * DM * 3072, DM, 3072, a.in[I_MIXN] + l * DM, (bf16_t*)(ws + WS_WIG) + (size_t)3072 * DM, 3072 / 32, 0); r -= I_GT;
    if (r < I_UQ) TR_SET(a.in[I_CWUQ] + (size_t)l * 384 * 768, 384, 768, a.in[I_CQN] + l * 384, (bf16_t*)(ws + WS_WUQ), 768 / 32, 3); r -= I_UQ;
    if (r < I_UKV) TR_SET(a.in[I_CWUKV] + (size_t)l * 256 * 1024, 256, 1024, a.in[I_CKVN] + l * 256, (bf16_t*)(ws + WS_WUKV), 1024 / 32, 0); r -= I_UKV;
    if (r < 3 * I_BR) { const int n = r / I_BR; r -= n * I_BR; TR_SET(a.in[I_WBR] + ((size_t)l * 3 + n) * 512 * 1024, 512, 1024, nullptr, (bf16_t*)(ws + WS_WB) + (size_t)n * 1024 * 512, 1024 / 32, 0); } r -= 3 * I_BR;
    TR_SET(a.in[I_WOUT] + (size_t)l * DM * DM, DM, DM, nullptr, (bf16_t*)(ws + WS_WO), DM / 32, 0);
#undef TR_SET
}
__device__ __forceinline__ bool tr_load(const TrDesc& d, int lane, f32x4 (&v)[8]) {
    const int kb = d.r / d.nblk, nb = d.r - kb * d.nblk, k0 = 64 * kb, n0 = 32 * nb;
    const int sc0 = src_col_rt(d.mode, n0), sc31 = src_col_rt(d.mode, n0 + 31);
    const bool vec = sc0 >= 0 && sc31 == sc0 + 31 && (sc0 & 3) == 0;
    if (vec) { const int row8 = lane >> 3, n4 = (lane & 7) * 4;
#pragma unroll
        for (int i = 0; i < 8; ++i) { const int kk = 8 * i + row8; v[i] = *(const f32x4*)(d.W + (size_t)(k0 + kk) * d.Nsrc + sc0 + n4); } }
    return vec;
}
__device__ __forceinline__ void tr_finish(const TrDesc& d, bool vec, int lane, const f32x4 (&v)[8], LAS float* scr) {
    const int kb = d.r / d.nblk, nb = d.r - kb * d.nblk, k0 = 64 * kb, n0 = 32 * nb;
    if (vec) { const int row8 = lane >> 3, n4 = (lane & 7) * 4;
#pragma unroll
        for (int i = 0; i < 8; ++i) { const int kk = 8 * i + row8; const f32x4 x = d.gain ? v[i] * d.gain[k0 + kk] : v[i]; LAS float* p = scr + kk * 33 + n4; p[0] = x[0]; p[1] = x[1]; p[2] = x[2]; p[3] = x[3]; }
    } else { const int sc = src_col_rt(d.mode, n0 + (lane & 31));
#pragma unroll 8
        for (int i = 0; i < 32; ++i) { const int kk = 2 * i + (lane >> 5); float x = 0.f;
            if (sc >= 0) { x = d.W[(size_t)(k0 + kk) * d.Nsrc + sc]; if (d.gain) x *= d.gain[k0 + kk]; }
            scr[kk * 33 + (lane & 31)] = x; } }
    asm volatile("s_waitcnt lgkmcnt(0)" ::: "memory");
    const int c = lane & 7;
#pragma unroll
    for (int j = 0; j < 4; ++j) { const int n = (lane >> 3) + 8 * j; const LAS float* s = scr + (8 * c) * 33 + n;
        u32x4 o; o.x = cvt_pk_bf16(s[0 * 33], s[1 * 33]); o.y = cvt_pk_bf16(s[2 * 33], s[3 * 33]); o.z = cvt_pk_bf16(s[4 * 33], s[5 * 33]); o.w = cvt_pk_bf16(s[6 * 33], s[7 * 33]);
        *(u32x4*)(d.WT + (size_t)(n0 + n) * d.K + k0 + 8 * c) = o; }
    asm volatile("s_waitcnt lgkmcnt(0)" ::: "memory");
}
__device__ __forceinline__ void convert_layer(const Args& a, int l, LAS unsigned char* lds, int gw, int NGW, int wave, int mask = 0) {
    constexpr int I_W13 = (DM / 64) * (2 * FF / 32), I_W2 = (FF / 64) * (DM / 32), I_IN = (DM / 64) * (3072 / 32),
                  I_UQ = (384 / 64) * (768 / 32), I_UKV = (256 / 64) * (1024 / 32), I_BR = (512 / 64) * (1024 / 32), I_OUT = (DM / 64) * (DM / 32);
    constexpr int NITEMS = 2 * I_W13 + 2 * I_W2 + 2 * I_IN + I_UQ + I_UKV + 3 * I_BR + I_OUT, OFF_W2B = 2 * I_W13 + I_W2;
    int lane = lane_id(); asm volatile("" : "+v"(lane));
    LAS float* scr0 = (LAS float*)(lds + wave * 17408); LAS float* scr1 = scr0 + 64 * 33 + 32;
    unsigned char* ws = a.ws; asm volatile("" : "+s"(ws));
    const int limit = mask == 0 ? NITEMS : mask == 1 ? NITEMS - I_W2 : I_W2;
#define CV_MAP(i_) (mask == 0 ? (i_) : mask == 1 ? ((i_) >= OFF_W2B ? (i_) + I_W2 : (i_)) : OFF_W2B + (i_))
    for (int it = gw; it < limit; it += 2 * NGW) {
        TrDesc d0, d1; f32x4 v0[8], v1[8];
        if (!tr_decode(a, l, ws, CV_MAP(it), d0)) break;
        const bool has1 = (it + NGW < limit) && tr_decode(a, l, ws, CV_MAP(it + NGW), d1);
        const bool vec0 = tr_load(d0, lane, v0);
        bool vec1 = false; if (has1) vec1 = tr_load(d1, lane, v1);
        tr_finish(d0, vec0, lane, v0, scr0);
        if (has1) tr_finish(d1, vec1, lane, v1, scr1);
    }
#undef CV_MAP
}

#define XB_TMO      128
#define XB_XCNT(j)  (256  + 64 * (j))
#define XB_XSUB(j)  (1280 + 64 * (j))
#define XB_XGEN(j)  (2304 + 64 * (j))
#define XB_TOP      3328
#define XB_TOPGEN   3392
#define XCD_BAR_WORDS 3456
#define XB_SPIN_CAP (1u << 18)

__device__ __forceinline__ unsigned xb_ld(unsigned* p)              { return __hip_atomic_load(p, __ATOMIC_RELAXED, __HIP_MEMORY_SCOPE_AGENT); }
__device__ __forceinline__ unsigned xb_add(unsigned* p, unsigned v) { return __hip_atomic_fetch_add(p, v, __ATOMIC_RELAXED, __HIP_MEMORY_SCOPE_AGENT); }
__device__ __forceinline__ unsigned xb_xcc_id() { return (unsigned)__builtin_amdgcn_s_getreg((3 << 11) | 20) & 0xFu; }
#define XB_SPIN(cond, bar) do { unsigned _sp = 0; while (cond) { __builtin_amdgcn_s_sleep(1); \
    if ((++_sp & 255u) == 0u) { if (xb_ld(&(bar)[XB_TMO])) break; if (_sp > XB_SPIN_CAP) { atomicAdd(&(bar)[XB_TMO], 1u); break; } } } } while (0)

struct XcdBarrier {
    unsigned* bar; unsigned x;
    volatile LAS unsigned* st;
};

__device__ __forceinline__ XcdBarrier xcd_barrier_post(unsigned* bar, volatile LAS unsigned* st) {
    XcdBarrier b; b.bar = bar; b.x = xb_xcc_id(); b.st = st;
    if (threadIdx.x == 0) (void)xb_add(&bar[XB_XCNT(b.x)], 1u);
    return b;
}
__device__ __forceinline__ void xcd_barrier_complete(unsigned* bar, unsigned x, unsigned& nloc, unsigned& nx) {
    const unsigned G = gridDim.x * gridDim.y * gridDim.z;
    unsigned sum, cnt, mine, sp = 0u;
    for (;;) {
        sum = 0u; cnt = 0u; mine = 0u;
#pragma unroll
        for (unsigned j = 0; j < 16; ++j) { const unsigned c = xb_ld(&bar[XB_XCNT(j)]); sum += c; cnt += (c > 0u) ? 1u : 0u; mine = (j == x) ? c : mine; }
        if (sum == G) break;
        __builtin_amdgcn_s_sleep(1);
        if ((++sp & 255u) == 0u) { if (xb_ld(&bar[XB_TMO])) break; if (sp > XB_SPIN_CAP) { atomicAdd(&bar[XB_TMO], 1u); break; } }
    }
    nloc = mine > 0u ? mine : 1u; nx = cnt > 0u ? cnt : 1u;
}

__device__ __forceinline__ void xcd_barrier(const XcdBarrier& b0_) {
    XcdBarrier b; b.bar = b0_.bar; b.st = b0_.st; b.x = xb_xcc_id(); { unsigned* bb = b.bar; asm volatile("" : "+s"(bb)); b.bar = bb; }
    asm volatile("s_waitcnt vmcnt(0)" ::: "memory");
    __syncthreads();
    if (threadIdx.x == 0) {
        unsigned* bar = b.bar;
        __builtin_amdgcn_s_waitcnt(0);
        unsigned nloc = b.st[0], nx = b.st[1];
        if (nloc == 0u) { xcd_barrier_complete(bar, b.x, nloc, nx); b.st[0] = nloc; b.st[1] = nx; }
        const unsigned old = xb_add(&bar[XB_XSUB(b.x)], 1u);
        const unsigned gen = old / nloc;
        if (old + 1u == (gen + 1u) * nloc) {
            __builtin_amdgcn_fence(__ATOMIC_RELEASE, "agent");
            asm volatile("s_waitcnt vmcnt(0)" ::: "memory");
            const unsigned og = xb_add(&bar[XB_TOP], 1u);
            const unsigned tg = og / nx;
            if (og + 1u == (tg + 1u) * nx) xb_add(&bar[XB_TOPGEN], 1u);
            else XB_SPIN(xb_ld(&bar[XB_TOPGEN]) == tg, bar);
            __builtin_amdgcn_fence(__ATOMIC_ACQUIRE, "agent");
            xb_add(&bar[XB_XGEN(b.x)], 1u);
            asm volatile("s_waitcnt vmcnt(0)" ::: "memory");
        } else {
            XB_SPIN(xb_ld(&bar[XB_XGEN(b.x)]) == gen, bar);
            __builtin_amdgcn_fence(__ATOMIC_ACQUIRE, "agent");
            asm volatile("s_waitcnt vmcnt(0)" ::: "memory");
        }
    }
    __syncthreads();
}


__global__ void __launch_bounds__(512) fwd_megakernel(Args a) {
    extern __shared__ __attribute__((aligned(16))) unsigned char lds_raw[];
    LAS unsigned char* lds = (LAS unsigned char*)lds_raw;
    cg::grid_group grid = cg::this_grid();
#define GSYNC() xcd_barrier(xbar)
    const int wave = __builtin_amdgcn_readfirstlane(threadIdx.x >> 6);
    const int G = gridDim.x, bx = blockIdx.x;
    volatile LAS unsigned* xst = (volatile LAS unsigned*)(lds + LDS_BYTES - 64);
    if (threadIdx.x < 2) xst[threadIdx.x] = 0u;
    __syncthreads();
    grid.sync();
    XcdBarrier xbar = xcd_barrier_post((unsigned*)(a.ws + WS_BAR), xst);
    const int vcu = (G % 8 == 0) ? (bx % 8) * (G / 8) + bx / 8 : bx;
    const int gw = vcu * 8 + wave, NGW = G * 8;
    unsigned char* ws = a.ws;
    float* X = a.out;
    bf16_t* XB = (bf16_t*)(ws + WS_XB); float* SSQ = (float*)(ws + WS_SSQ); float* SSQZ = (float*)(ws + WS_SSQZ);
    float* ROPEC = (float*)(ws + WS_ROPE); float* ROPES = ROPEC + SEQ * 32;
    bf16_t* Z = (bf16_t*)(ws + WS_R0); bf16_t* H = (bf16_t*)(ws + WS_R0); float* MG = (float*)(ws + WS_R0); bf16_t* MB = (bf16_t*)(ws + WS_R0 + 64 * MiB);
    bf16_t* GT = (bf16_t*)(ws + WS_G); bf16_t* QC = (bf16_t*)(ws + WS_QC); bf16_t* KC = (bf16_t*)(ws + WS_KC); bf16_t* VC = (bf16_t*)(ws + WS_VC);
    bf16_t* O3 = (bf16_t*)(ws + WS_O3); float* SCR = (float*)(ws + WS_SCR) + (size_t)bx * (512 * 64);

    {
        const float* xin = a.in[I_X]; const int lane = lane_id();
        for (int m = gw; m < M_TOK; m += NGW) {
            const f32x4* xr = (const f32x4*)(xin + (size_t)m * DM) + lane; f32x4* xo = (f32x4*)(X + (size_t)m * DM) + lane; u32x2* bo = (u32x2*)(XB + (size_t)m * DM) + lane;
            float s = 0.f;
#pragma unroll
            for (int j = 0; j < 4; ++j) { const f32x4 v = xr[64 * j]; xo[64 * j] = v; s += dot4(v); u32x2 w; w.x = cvt_pk_bf16(v[0], v[1]); w.y = cvt_pk_bf16(v[2], v[3]); bo[64 * j] = w; }
            s = wave_sum(s);
            if (lane < 16) SSQ[(size_t)m * 16 + lane] = lane == 0 ? s : 0.f;
        }
        for (int i = gw * 64 + lane; i < SEQ * 32; i += NGW * 64) {
            const int pos = i >> 5, j = i & 31;
            const float inv_freq = (float)exp2(-(double)(2 * j) / 64.0 * 13.287712379549449);
            const float ang = (float)pos * inv_freq;
            const double rev = (double)ang * 0.15915494309189535; const float f = (float)(rev - floor(rev));
            ROPEC[i] = __builtin_amdgcn_cosf(f); ROPES[i] = __builtin_amdgcn_sinf(f);
        }
#ifndef NO_CONV
        convert_layer(a, 0, lds, gw, NGW, wave);
#endif
    }
    GSYNC();

    for (int l = 0; l < DEPTH; ++l) {
        for (int half = 0; half < 2; ++half) {
#ifndef NO_FFNUP
            { pg8::Gemm g{XB, (const bf16_t*)(ws + (half ? WS_W13B : WS_W13A)), M_TOK, 2 * FF, DM, DM, 31, 0}; pg8::StaticOrder S; S.init(M_TOK, 2 * FF, G, bx);
              EpiSwiGLU E{H, SSQ}; pg8::gemm_phase(lds, g, S, E, wave); }
#endif
            GSYNC();
#ifndef NO_FFNDN
            { pg8::Gemm g{H, (const bf16_t*)(ws + (half ? WS_W2B : WS_W2A)), M_TOK, DM, FF, FF, 31, 0}; pg8::StaticOrder S; S.init(M_TOK, DM, G, bx);
              EpiResid E{X, XB, SSQ, 0.5f}; pg8::gemm_phase(lds, g, S, E, wave); }
#endif
            if (half == 1) { if (l + 1 < DEPTH) convert_layer(a, l + 1, lds, gw, NGW, wave, 1); }
            else if (l > 0) convert_layer(a, l, lds, gw, NGW, wave, 2);
            GSYNC();
            if (half == 1) break;
#ifndef NO_INPROJ
            { pg8::Gemm g{XB, (const bf16_t*)(ws + WS_WIG), M_TOK, 6144, DM, DM, 31, 0}; pg8::StaticOrder S; S.init(M_TOK, 6144, G, bx);
              EpiInProj E{Z, GT, KC, SSQ, SSQZ, a.in[I_BGATE] + l * 3072, ROPEC, ROPES}; pg8::gemm_phase(lds, g, S, E, wave); }
#endif
            GSYNC();
#ifndef NO_UQ
            { pg8::Gemm g{Z + Z_CQ, (const bf16_t*)(ws + WS_WUQ), M_TOK, 768, 384, ZC, 31, 0}; pg8::StaticOrder S; S.init(M_TOK, 768, G, bx);
              EpiUQ E{QC, SSQZ, ROPEC, ROPES}; pg8::gemm_phase(lds, g, S, E, wave); }
#endif
#ifndef NO_UKV
            { pg8::Gemm g{Z + Z_CKV, (const bf16_t*)(ws + WS_WUKV), M_TOK, 1024, 256, ZC, 31, 0}; pg8::StaticOrder S; S.init(M_TOK, 1024, G, G - 1 - bx);
              EpiUKV E{KC, VC, SSQZ}; pg8::gemm_phase(lds, g, S, E, wave); }
#endif
            { unsigned* NRM = (unsigned*)(ws + WS_BAR + 32768) + l * 32; const int lane = lane_id(); float mx0 = 0.f, mx1 = 0.f;
              for (int m = gw; m < M_TOK; m += NGW) { const u32x4* zp = (const u32x4*)(Z + (size_t)m * ZC + lane * 16); const u32x4 w0 = zp[0], w1 = zp[1]; float sq = 0.f;
#pragma unroll
                  for (int i = 0; i < 4; ++i) { const float a0 = bf16_lo(w0[i]), a1 = bf16_hi(w0[i]), b0 = bf16_lo(w1[i]), b1 = bf16_hi(w1[i]); sq += (a0 * a0 + a1 * a1) + (b0 * b0 + b1 * b1); }
                  sq += shfl_xor_f(sq, 1); sq += shfl_xor_f(sq, 2);
                  if (m < SEQ) mx0 = fmaxf(mx0, sq); else mx1 = fmaxf(mx1, sq); }
              if ((lane & 3) == 0) { __hip_atomic_fetch_max(NRM + (lane >> 2), __float_as_uint(mx0), __ATOMIC_RELAXED, __HIP_MEMORY_SCOPE_AGENT);
                                     __hip_atomic_fetch_max(NRM + 16 + (lane >> 2), __float_as_uint(mx1), __ATOMIC_RELAXED, __HIP_MEMORY_SCOPE_AGENT); } }
            GSYNC();
            {
                LAS char* al = (LAS char*)lds;
                const int nslot = (G == 256) ? 6 : (1024 + G - 1) / G;
                for (int k_ = 0; k_ < nslot; ++k_) {
                    int L;
                    if (G == 256) {
                        if (vcu < 128) L = k_ < 2 ? 2 * vcu + k_ : k_ < 4 ? 512 + 2 * vcu + (k_ - 2) : (k_ == 4 && (vcu & 1)) ? 512 + 256 + (vcu >> 1) : -1;
                        else { const int u = (vcu - 128) & 63, hi_ = vcu >= 192, hh = k_ == 0 ? (hi_ ? 2 : 3) : (hi_ ? 1 : 0);
                               L = k_ < 2 ? 256 + (((u >> 5) * 4 + hh) << 5) + (u & 31) : hi_ ? (k_ < 4 ? 512 + 384 + 2 * u + (k_ - 2) : -1) : (k_ == 2 ? 512 + 320 + u : -1); }
                    } else { L = vcu + k_ * G; if (L >= 1024) L = -1; }
                    if (L < 0) continue;
                    if (L < 256) {
#ifndef NO_C
                        const int bh = L >> 5, qb = L & 31, b = bh >> 2, h = bh & 3; const size_t r0 = (size_t)b * SEQ + qb * 256;
                        att::EpiStoreBf16<4> E{O3 + r0 * 1536 + 1024 + h * 128, 1536};
                        att::attn_body_simple<192, 128, 0, 768, 768, 512>(QC + r0 * 768 + h * 192, KC + (size_t)b * SEQ * 768 + h * 192, VC + (size_t)b * SEQ * 512 + h * 128,
                                                                     0, SEQ / 64, qb * 256, 0.07216878364870322f, 0.f, 0.f, al, E, wave);
#endif
                    } else if (L < 512) {
#ifndef NO_A
                        const int u = L - 256, bh = u >> 5, qb = u & 31, b = bh >> 2, h = bh & 3; const size_t r0 = (size_t)b * SEQ + qb * 256;
                        int li = l; asm volatile("" : "+s"(li));
                        const float lam_init = __uint_as_float(li == 0 ? 0x3e4ccccdu : li == 1 ? 0x3eb60549u : li == 2 ? 0x3ef1014cu : 0x3f0e59d5u);
                        const float* lp = a.in[I_ALAM] + l * 256; const int lane = lane_id();
                        const float s01 = wave_sum(lp[lane] * lp[64 + lane]), s23 = wave_sum(lp[128 + lane] * lp[192 + lane]);
                        const float lam = uni(expf(s01) - expf(s23) + lam_init);
                        const float slope = uni(exp2f(-2.f * (float)(h + 1)));
                        const bf16_t* zb = Z + (size_t)b * SEQ * ZC;
                        int ks0, nt0, ks1, nt1, sf0 = 0, sf1 = 0;
                        { const unsigned* NRM = (const unsigned*)(ws + WS_BAR + 32768) + l * 32 + b * 16;
#pragma unroll
                          for (int mp = 0; mp < 2; ++mp) {
                              const float q2 = __uint_as_float(__hip_atomic_load(NRM + h * 2 + mp, __ATOMIC_RELAXED, __HIP_MEMORY_SCOPE_AGENT)), k2 = __uint_as_float(__hip_atomic_load(NRM + 8 + h * 2 + mp, __ATOMIC_RELAXED, __HIP_MEMORY_SCOPE_AGENT));
                              const float dmax = uni((2.f * 0.125f * sqrtf(q2 * k2) * 1.01f + 32.f) / slope);
                              const float lo_f = (float)(qb * 256) - dmax, hi_f = (float)(qb * 256 + 256) + dmax;
                              const int lo_i = lo_f <= 0.f ? 0 : ((int)lo_f >> 7) << 7; const int hi_i = hi_f >= (float)SEQ ? SEQ : ((((int)hi_f + 127) >> 7) << 7);
                              const int hi_c = hi_i > SEQ ? SEQ : hi_i;
                              const int sf = (2.f * 0.125f * sqrtf(q2 * k2) * 1.01f + 8.f) < 70.f;
                              if (mp == 0) { ks0 = lo_i; nt0 = (hi_c - lo_i) >> 6; sf0 = sf; } else { ks1 = lo_i; nt1 = (hi_c - lo_i) >> 6; sf1 = sf; } } }
                        { att::EpiDiff0 E{SCR};
                          ATT_A_BODY(Z + r0 * ZC + Z_AQ + h * 128, zb + Z_AK + h * 128, zb + Z_AV + h * 128, ks0, nt0, qb * 256, 0.125f, slope, 0.f, al, E, wave, sf0); }
                        { att::EpiDiff1 E{SCR, O3 + r0 * 1536 + h * 128, 1536, a.in[I_ASUB] + l * 128, lam, 1.f - lam_init};
                          ATT_A_BODY(Z + r0 * ZC + Z_AQ + h * 128 + 64, zb + Z_AK + h * 128 + 64, zb + Z_AV + h * 128, ks1, nt1, qb * 256, 0.125f, slope, 0.f, al, E, wave, sf1); }
#endif
                    } else {
#ifndef NO_B
                        const int u = L - 512, bh = u >> 5, qb = u & 31, b = bh >> 3, hq = bh & 7; const size_t r0 = (size_t)b * SEQ + qb * 256;
                        const int ks = qb * 256 - 128 < 0 ? 0 : qb * 256 - 128, ke = qb * 256 + 384 > SEQ ? SEQ : qb * 256 + 384;
                        const float slope = uni(exp2f(-(float)(hq + 1))); const float sink = uni(a.in[I_BSINK][l * 8 + hq]);
                        const bf16_t* zb = Z + (size_t)b * SEQ * ZC;
                        att::EpiStoreBf16<2> E{O3 + r0 * 1536 + 512 + hq * 64, 1536};
                        att::attn_body<64, 64, 2, 2, ZC, ZC, ZC>(Z + r0 * ZC + Z_BQ + hq * 64, zb + Z_BK + (hq >> 2) * 64, zb + Z_BV + (hq >> 2) * 64, ks, (ke - ks) / 64, qb * 256, 0.125f, slope, sink * LOG2E, al, E, wave);
#endif
                    }
                }
                __syncthreads();
            }
            GSYNC();
#ifndef NO_BR
            { pg8::Gemm g{O3, (const bf16_t*)(ws + WS_WB), M_TOK, 3072, 512, 1536, 2, 1024}; pg8::BranchOrder S; S.init(G, bx);
              EpiGateAcc E{GT, MG, MB}; pg8::gemm_phase(lds, g, S, E, wave); }
#endif
            GSYNC();
#ifndef NO_WOUT
            { pg8::Gemm g{MB, (const bf16_t*)(ws + WS_WO), M_TOK, DM, DM, DM, 31, 0}; pg8::StaticOrder S; S.init(M_TOK, DM, G, bx);
              EpiResid E{X, XB, SSQ, 1.0f}; pg8::gemm_phase(lds, g, S, E, wave); }
#endif
            GSYNC();
        }
    }
    {
        const float* fg = a.in[I_FINN]; const int lane = lane_id();
        for (int m = gw; m < M_TOK; m += NGW) {
            const float r = rinv_sum(SSQ + (size_t)m * 16, 4, 1.f / DM);
            f32x4* xo = (f32x4*)(X + (size_t)m * DM) + lane; const f32x4* gp = (const f32x4*)fg + lane;
#pragma unroll
            for (int j = 0; j < 4; ++j) { f32x4 v = xo[64 * j]; v = v * r * gp[64 * j]; xo[64 * j] = v; }
        }
    }
}

extern "C" void kernel_launch(void* const* d_in, const int* in_sizes, int n_in, void* d_out, int out_size, void* d_ws, size_t ws_size, hipStream_t stream) {
    static int grid = 0;
    if (grid == 0) {
        if (n_in != 21 || in_sizes[0] != M_TOK * DM || out_size != M_TOK * DM || ws_size < WS_END) {
            fprintf(stderr, "kernel_launch: shape/workspace mismatch (n_in %d, in0 %d, out %d, ws %zu, need %zu)\n", n_in, n_in > 0 ? in_sizes[0] : -1, out_size, ws_size, (size_t)WS_END); grid = -1; return; }
        int dev = 0, cus = 0, per_cu = 0;
        hipGetDevice(&dev); hipDeviceGetAttribute(&cus, hipDeviceAttributeMultiprocessorCount, dev);
        if (hipFuncSetAttribute((const void*)fwd_megakernel, hipFuncAttributeMaxDynamicSharedMemorySize, LDS_BYTES) != hipSuccess) { fprintf(stderr, "kernel_launch: hipFuncSetAttribute failed\n"); grid = -1; return; }
        if (hipOccupancyMaxActiveBlocksPerMultiprocessor(&per_cu, (const void*)fwd_megakernel, 512, LDS_BYTES) != hipSuccess || per_cu < 1) { fprintf(stderr, "kernel_launch: occupancy query failed (%d)\n", per_cu); per_cu = 1; }
        (void)hipGetLastError();
        grid = cus;
    }
    if (grid < 0) return;
    if (hipMemsetAsync((char*)d_ws + WS_BAR, 0, BAR_BYTES, stream) != hipSuccess) { fprintf(stderr, "kernel_launch: memset failed\n"); return; }
    Args a{};
    for (int i = 0; i < 21; ++i) a.in[i] = (const float*)d_in[i];
    a.out = (float*)d_out; a.ws = (unsigned char*)d_ws; a.ph_lo = 0; a.ph_hi = 0;
    void* args[] = {&a};
    hipError_t e = hipLaunchCooperativeKernel((const void*)fwd_megakernel, dim3(grid), dim3(512), args, LDS_BYTES, stream);
    if (e != hipSuccess) fprintf(stderr, "cooperative launch failed: %s (grid %d)\n", hipGetErrorString(e), grid);
}
```

```cpp
#include <hip/hip_runtime.h>
#include <hip/hip_cooperative_groups.h>
#include <cstdio>
#include <cstdint>
namespace cg = cooperative_groups;

#define LAS __attribute__((address_space(3)))
#define GAS __attribute__((address_space(1)))
typedef unsigned short bf16_t;
typedef short bf16x8 __attribute__((ext_vector_type(8)));
typedef short s16x4 __attribute__((ext_vector_type(4)));
typedef float f32x4 __attribute__((ext_vector_type(4)));
typedef float f32x16 __attribute__((ext_vector_type(16)));
typedef unsigned u32x4 __attribute__((ext_vector_type(4)));
typedef unsigned u32x2 __attribute__((ext_vector_type(2)));

constexpr int M_TOK = 16384, SEQ = 8192, DM = 1024, FF = 2816, DEPTH = 4;
constexpr int ZC = 3072;
constexpr int Z_AQ = 0, Z_AK = 512, Z_AV = 1024, Z_BQ = 1536, Z_BK = 2048, Z_BV = 2176, Z_CQ = 2304, Z_CKV = 2688, Z_CKR = 2944;
constexpr float EPS = 1e-6f;
constexpr float LOG2E = 1.4426950408889634f;

constexpr size_t MiB = 1u << 20;
constexpr size_t WS_W13A = 0, WS_W2A = 11 * MiB, WS_W13B = 33 * MiB / 2, WS_W2B = 55 * MiB / 2, WS_WIG = 33 * MiB, WS_WUQ = 45 * MiB,
                 WS_WUKV = 46 * MiB, WS_WB = 47 * MiB, WS_WO = 50 * MiB;
constexpr size_t WS_BAR = 54 * MiB, BAR_BYTES = 65536;
constexpr size_t WS_XB = 56 * MiB, WS_SSQ = 88 * MiB, WS_SSQZ = 89 * MiB, WS_ROPE = 91 * MiB;
constexpr size_t WS_R0 = 96 * MiB;
constexpr size_t WS_G = 192 * MiB, WS_QC = 288 * MiB, WS_KC = 312 * MiB, WS_VC = 336 * MiB, WS_O3 = 352 * MiB, WS_SCR = 400 * MiB, WS_END = 432 * MiB;

typedef float f32x2_t __attribute__((ext_vector_type(2)));
typedef __bf16 bf16x2_t __attribute__((ext_vector_type(2)));
__device__ __forceinline__ unsigned cvt_pk_bf16(float lo, float hi) { f32x2_t v = {lo, hi}; bf16x2_t b = __builtin_convertvector(v, bf16x2_t); return __builtin_bit_cast(unsigned, b); }
__device__ __forceinline__ int lane_id() { int r; asm volatile("v_mbcnt_lo_u32_b32 %0, -1, 0\n\tv_mbcnt_hi_u32_b32 %0, -1, %0" : "=v"(r)); return r; }
__device__ __forceinline__ float uni(float x) { return __int_as_float(__builtin_amdgcn_readfirstlane(__float_as_int(x))); }
__device__ __forceinline__ float shfl_xor_f(float v, int m) { return __int_as_float(__builtin_amdgcn_ds_bpermute((lane_id() ^ m) << 2, __float_as_int(v))); }
__device__ __forceinline__ float bf16_lo(unsigned w) { return __uint_as_float(w << 16); }
__device__ __forceinline__ float bf16_hi(unsigned w) { return __uint_as_float(w & 0xffff0000u); }
__device__ __forceinline__ float fast_rsq(float x) { return __builtin_amdgcn_rsqf(x); }
__device__ __forceinline__ float sum4(f32x4 a) { return (a.x + a.y) + (a.z + a.w); }
__device__ __forceinline__ float dot4(f32x4 a) { return (a.x * a.x + a.y * a.y) + (a.z * a.z + a.w * a.w); }

namespace pg8 {
constexpr int BM = 256, BK = 64, HALF = 128, HTB = HALF * BK * 2, STAGE_BYTES = 8 * HTB, NXCD = 8, WGM = 8;
__host__ __device__ __forceinline__ int lds_byte(int r, int c) { const int st = (r >> 4) * 2 + (c >> 5), rr = r & 15, cc = c & 31, ob = rr * 64 + cc * 2; return st * 1024 + (ob ^ (((ob >> 9) & 1) << 5)); }
__host__ __device__ __forceinline__ void stage_rc(int b, int& R, int& C) { const int st = b / 1024, sb = b % 1024, swz = sb ^ (((sb >> 9) & 1) << 5); R = (st >> 1) * 16 + swz / 64; C = (st & 1) * 32 + (swz % 64) / 2; }
__host__ __device__ __forceinline__ int perm32(int rho) { const int n = rho >> 4, i = rho & 15; return 8 * (i >> 2) + 4 * n + (i & 3); }

struct Unit { int pm, pn; };
struct Gemm { const bf16_t* A; const bf16_t* Bt; int M, N, K, lda, a_pn_shift, a_pn_stride; };

struct StaticOrder {
    int nM, nN, nwg, G, c;
    __device__ void init(int M, int N, int G_, int c_) { nM = M / BM; nN = N / BM; nwg = nM * nN; G = G_; c = c_; }
    __device__ bool next(int i, Unit& u) const {
        const long L = (long)i * G + c; if (L >= nwg) return false;
        int wgid = (int)L; { const int q = nwg / NXCD, r = nwg % NXCD, xcd = wgid % NXCD, off = wgid / NXCD; wgid = (xcd < r ? xcd * (q + 1) : r * (q + 1) + (xcd - r) * q) + off; }
        const int nig = WGM * nN, gid = wgid / nig, fm = gid * WGM, gsz = (nM - fm) < WGM ? (nM - fm) : WGM;
        u.pm = fm + ((wgid % nig) % gsz); u.pn = (wgid % nig) / gsz; return true;
    }
};
struct BranchOrder {
    StaticOrder so;
    __device__ void init(int G_, int c_) { so.init(M_TOK, DM, G_, c_); }
    __device__ bool next(int i, Unit& u) const { const int j = i / 3, n = i - 3 * j; Unit b; if (!so.next(j, b)) return false; u.pm = b.pm; u.pn = n * 4 + b.pn; return true; }
};

template <class Epi, class Sched>
__device__ __forceinline__ void gemm_phase(LAS unsigned char* lds, const Gemm g, const Sched& S, const Epi& E, int wave_) {
    int tid = wave_ * 64 + lane_id(); asm volatile("" : "+v"(tid));
    const int wid = __builtin_amdgcn_readfirstlane(tid >> 6), lane = tid & 63, wr = wid >> 2, wc = wid & 3, fr = lane & 15, fq = lane >> 4;
    const int K = g.K, nt = K / BK, lda = g.lda;
    const bf16_t* gA = g.A; const bf16_t* gB = g.Bt; asm volatile("" : "+s"(gA), "+s"(gB));
    unsigned voffA[2], voffB[2];
#pragma unroll
    for (int i = 0; i < 2; ++i) { int R, C; stage_rc(tid * 16 + i * 8192, R, C); const int Rb = Epi::PERM ? ((R & ~31) + perm32(R & 31)) : R;
        voffA[i] = (unsigned)(R * lda + C) * 2u; voffB[i] = (unsigned)(Rb * K + C) * 2u; }
    const size_t kstep = (size_t)(BK * 2);
    const size_t hstepA = (size_t)HALF * lda * 2, hstepB = (size_t)HALF * K * 2;
    const size_t tstepA = 2 * hstepA, tstepB = 2 * hstepB;
    const unsigned ldsw = (unsigned)wid * 1024u;
    const int aoff = lds_byte(wr * 64 + fr, fq * 8), boff = lds_byte(wc * 32 + fr, fq * 8);
#define PG8_SA(b, h) (((b) * 2 + (h)) * HTB)
#define PG8_SB(b, h) ((4 + (b) * 2 + (h)) * HTB)
#define PG8_STAGE(bufoff, gbase, voff) do { _Pragma("unroll") for (int _i = 0; _i < 2; ++_i) \
        __builtin_amdgcn_global_load_lds((const unsigned*)((const char*)(gbase) + (voff)[_i]), (LAS unsigned*)(lds + (bufoff) + ldsw + _i * 8192), 16, 0, 0); } while (0)
#define PG8_LDA(dst, b, h) do { _Pragma("unroll") for (int m = 0; m < 4; ++m) _Pragma("unroll") for (int k = 0; k < 2; ++k) dst[m][k] = *(const LAS bf16x8*)(lds + PG8_SA(b, h) + aoff + m * 2048 + k * 1024); } while (0)
#define PG8_LDB(dst, b, h) do { _Pragma("unroll") for (int n = 0; n < 2; ++n) _Pragma("unroll") for (int k = 0; k < 2; ++k) dst[n][k] = *(const LAS bf16x8*)(lds + PG8_SB(b, h) + boff + n * 2048 + k * 1024); } while (0)
#define PG8_MMA(ai, bj, At, Bt) do { __builtin_amdgcn_s_setprio(1); _Pragma("unroll") for (int m = 0; m < 4; ++m) _Pragma("unroll") for (int n = 0; n < 2; ++n) _Pragma("unroll") for (int k = 0; k < 2; ++k) \
        acc[ai][bj][m][n] = __builtin_amdgcn_mfma_f32_16x16x32_bf16(Bt[n][k], At[m][k], acc[ai][bj][m][n], 0, 0, 0); __builtin_amdgcn_s_setprio(0); } while (0)
#define PG8_WAIT_V(n) asm volatile("s_waitcnt vmcnt(" #n ")" ::: "memory")
#define PG8_WAIT_L(n) asm volatile("s_waitcnt lgkmcnt(" #n ")" ::: "memory")
#define PG8_BAR __builtin_amdgcn_s_barrier()
#define PG8_SCHED __builtin_amdgcn_sched_barrier(0)
#define PG8_APTR(u) ((const char*)gA + (size_t)(u).pm * tstepA + (size_t)((u).pn >> g.a_pn_shift) * (size_t)g.a_pn_stride)
    Unit cur, nxt; int ui = 0;
    if (!S.next(0, cur)) return;
    f32x4 acc[2][2][4][2];
#pragma unroll
    for (int a = 0; a < 2; ++a)
#pragma unroll
        for (int b = 0; b < 2; ++b)
#pragma unroll
            for (int m = 0; m < 4; ++m)
#pragma unroll
                for (int n = 0; n < 2; ++n) acc[a][b][m][n] = (f32x4){0.f, 0.f, 0.f, 0.f};
    bf16x8 At[4][2], B0[2][2], B1[2][2];
    const char* cA = PG8_APTR(cur); const char* cB = (const char*)gB + (size_t)cur.pn * tstepB;
    PG8_STAGE(PG8_SB(0, 0), cB, voffB); PG8_STAGE(PG8_SB(0, 1), cB + hstepB, voffB); PG8_STAGE(PG8_SA(0, 0), cA, voffA); PG8_STAGE(PG8_SA(0, 1), cA + hstepA, voffA);
    if (wr == 1) PG8_BAR;
    PG8_WAIT_V(2); PG8_BAR;
    PG8_STAGE(PG8_SB(1, 0), cB + kstep, voffB); PG8_STAGE(PG8_SA(1, 0), cA + kstep, voffA); PG8_STAGE(PG8_SB(1, 1), cB + hstepB + kstep, voffB);
    PG8_WAIT_V(6); PG8_BAR;
    for (;;) {
        const bool has_next = S.next(ui + 1, nxt);
        const char* nA = has_next ? PG8_APTR(nxt) : cA; const char* nB = has_next ? (const char*)gB + (size_t)nxt.pn * tstepB : cB;
        for (int t = 0; t < nt; t += 2) {
            const bool last = (t == nt - 2);
            const char* a1 = cA + (size_t)(t + 1) * kstep;
            const char* a2 = last ? nA : cA + (size_t)(t + 2) * kstep; const char* b2 = last ? nB : cB + (size_t)(t + 2) * kstep;
            const char* a3 = a2 + kstep; const char* b3 = b2 + kstep;
            PG8_LDB(B0, 0, 0); PG8_LDB(B1, 0, 1); PG8_SCHED; PG8_LDA(At, 0, 0); PG8_STAGE(PG8_SA(1, 1), a1 + hstepA, voffA);
            PG8_WAIT_V(8); PG8_WAIT_L(0); PG8_BAR; PG8_MMA(0, 0, At, B0); PG8_MMA(0, 1, At, B1); PG8_BAR; PG8_SCHED;
            PG8_LDA(At, 0, 1); PG8_STAGE(PG8_SB(0, 0), b2, voffB); PG8_STAGE(PG8_SB(0, 1), b2 + hstepB, voffB); PG8_STAGE(PG8_SA(0, 0), a2, voffA);
            PG8_WAIT_V(8); PG8_WAIT_L(0); PG8_BAR; PG8_MMA(1, 0, At, B0); PG8_MMA(1, 1, At, B1); PG8_BAR; PG8_SCHED;
            PG8_LDB(B0, 1, 0); PG8_LDB(B1, 1, 1); PG8_SCHED; PG8_LDA(At, 1, 0); PG8_STAGE(PG8_SA(0, 1), a2 + hstepA, voffA);
            PG8_WAIT_V(8); PG8_WAIT_L(0); PG8_BAR; PG8_MMA(0, 0, At, B0); PG8_MMA(0, 1, At, B1); PG8_BAR; PG8_SCHED;
            PG8_LDA(At, 1, 1); PG8_STAGE(PG8_SB(1, 0), b3, voffB); PG8_STAGE(PG8_SB(1, 1), b3 + hstepB, voffB); PG8_STAGE(PG8_SA(1, 0), a3, voffA);
            PG8_WAIT_V(8); PG8_WAIT_L(0); PG8_BAR; PG8_MMA(1, 0, At, B0); PG8_MMA(1, 1, At, B1); PG8_BAR; PG8_SCHED;
        }
        if (wr == 0) PG8_BAR;
        E(acc, cur, wr, wc, fr, fq);
        if (!has_next) break;
#pragma unroll
        for (int a = 0; a < 2; ++a)
#pragma unroll
            for (int b = 0; b < 2; ++b)
#pragma unroll
                for (int m = 0; m < 4; ++m)
#pragma unroll
                    for (int n = 0; n < 2; ++n) acc[a][b][m][n] = (f32x4){0.f, 0.f, 0.f, 0.f};
        cur = nxt; cA = nA; cB = nB; ++ui;
        if (wr == 1) PG8_BAR;
    }
    PG8_WAIT_V(0);
    PG8_BAR;
#undef PG8_SA
#undef PG8_SB
#undef PG8_STAGE
#undef PG8_LDA
#undef PG8_LDB
#undef PG8_MMA
#undef PG8_WAIT_V
#undef PG8_WAIT_L
#undef PG8_BAR
#undef PG8_SCHED
#undef PG8_APTR
}
}

typedef f32x4 Acc[2][2][4][2];
__device__ __forceinline__ float rinv_sum(const float* p, int n4, float invn) {
    float s = 0.f;
#pragma unroll
    for (int i = 0; i < 5; ++i) if (i < n4) s += sum4(*(const f32x4*)(p + 4 * i));
    return fast_rsq(s * invn + EPS);
}
__device__ __forceinline__ float silu_mul(float a, float g) { return a * __builtin_amdgcn_rcpf(1.f + __builtin_amdgcn_exp2f(-a * LOG2E)) * g; }
__device__ __forceinline__ float sigmoidf(float a) { return __builtin_amdgcn_rcpf(1.f + __builtin_amdgcn_exp2f(-a * LOG2E)); }
__device__ __forceinline__ u32x4 pack8(f32x4 v0, f32x4 v1) { u32x4 w; w.x = cvt_pk_bf16(v0[0], v0[1]); w.y = cvt_pk_bf16(v0[2], v0[3]); w.z = cvt_pk_bf16(v1[0], v1[1]); w.w = cvt_pk_bf16(v1[2], v1[3]); return w; }

struct EpiSwiGLU {
    static constexpr bool PERM = true;
    bf16_t* H; const float* ssq;
    __device__ __forceinline__ void operator()(const Acc& acc, const pg8::Unit& u, int wr, int wc, int fr, int fq) const {
        const int row0 = u.pm * 256 + wr * 64 + fr, col0 = u.pn * 128 + wc * 32 + 8 * fq;
#pragma unroll
        for (int ai = 0; ai < 2; ++ai)
#pragma unroll
            for (int m = 0; m < 4; ++m) { const int row = row0 + ai * 128 + m * 16; const float r = rinv_sum(ssq + (size_t)row * 16, 4, 1.f / DM);
                f32x4 h0, h1;
#pragma unroll
                for (int j = 0; j < 4; ++j) { h0[j] = silu_mul(acc[ai][0][m][0][j] * r, acc[ai][1][m][0][j] * r); h1[j] = silu_mul(acc[ai][0][m][1][j] * r, acc[ai][1][m][1][j] * r); }
                *(u32x4*)(H + (size_t)row * FF + col0) = pack8(h0, h1); asm volatile("" ::: "memory"); }
    }
};
struct EpiResid {
    static constexpr bool PERM = false;
    const float* xin; float* x; bf16_t* xb; float* ssq; float coef;
    __device__ __forceinline__ void operator()(const Acc& acc, const pg8::Unit& u, int wr, int wc, int fr, int fq) const {
        const int row0 = u.pm * 256 + wr * 64 + fr, col0 = u.pn * 256 + wc * 32 + 4 * fq;
#pragma unroll
        for (int ai = 0; ai < 2; ++ai) {
            f32x4 xv[4][2][2];
#pragma unroll
            for (int m = 0; m < 4; ++m)
#pragma unroll
                for (int bj = 0; bj < 2; ++bj)
#pragma unroll
                    for (int n = 0; n < 2; ++n) xv[m][bj][n] = *(const f32x4*)(xin + (size_t)(row0 + ai * 128 + m * 16) * DM + col0 + bj * 128 + n * 16);
#pragma unroll
            for (int m = 0; m < 4; ++m) { const int row = row0 + ai * 128 + m * 16; float s = 0.f;
#pragma unroll
                for (int bj = 0; bj < 2; ++bj)
#pragma unroll
                    for (int n = 0; n < 2; ++n) { const size_t off = (size_t)row * DM + col0 + bj * 128 + n * 16;
                        const f32x4 v = xv[m][bj][n] + acc[ai][bj][m][n] * coef;
                        *(f32x4*)(x + off) = v; s += dot4(v);
                        u32x2 w; w.x = cvt_pk_bf16(v[0], v[1]); w.y = cvt_pk_bf16(v[2], v[3]); *(u32x2*)(xb + off) = w; }
                s += shfl_xor_f(s, 16); s += shfl_xor_f(s, 32);
                if (fq == 0) ssq[(size_t)row * 16 + u.pn * 4 + wc] = s; }
            asm volatile("" ::: "memory"); }
    }
};
struct EpiInProj {
    static constexpr bool PERM = true;
    bf16_t* Z; bf16_t* Gt; bf16_t* KC; const float* ssq; float* ssqz; const float* bgate; const float* ropeC; const float* ropeS;
    __device__ __forceinline__ void operator()(const Acc& acc, const pg8::Unit& u, int wr, int wc, int fr, int fq) const {
        const int row0 = u.pm * 256 + wr * 64 + fr, cw = wc * 32 + 8 * fq;
        if (u.pn < 12) {
#pragma unroll
            for (int ai = 0; ai < 2; ++ai)
#pragma unroll
                for (int m = 0; m < 4; ++m) { const int row = row0 + ai * 128 + m * 16; const float r = rinv_sum(ssq + (size_t)row * 16, 4, 1.f / DM);
#pragma unroll
                    for (int bj = 0; bj < 2; ++bj) { f32x4 v0 = acc[ai][bj][m][0] * r, v1 = acc[ai][bj][m][1] * r;
                        if (u.pn >= 9) { float s = dot4(v0) + dot4(v1); s += shfl_xor_f(s, 16); s += shfl_xor_f(s, 32);
                            if (fq == 0) ssqz[(size_t)row * 24 + (u.pn - 9) * 8 + bj * 4 + wc] = s; }
                        if (u.pn == 11 && bj == 1 && wc < 2) {
                            const int pos = row & (SEQ - 1), j0 = 16 * wc + 4 * fq;
                            const f32x4 c = *(const f32x4*)(ropeC + pos * 32 + j0), s = *(const f32x4*)(ropeS + pos * 32 + j0);
                            f32x4 o0, o1;
                            o0[0] = v0[0] * c[0] - v0[1] * s[0]; o0[1] = v0[0] * s[0] + v0[1] * c[0]; o0[2] = v0[2] * c[1] - v0[3] * s[1]; o0[3] = v0[2] * s[1] + v0[3] * c[1];
                            o1[0] = v1[0] * c[2] - v1[1] * s[2]; o1[1] = v1[0] * s[2] + v1[1] * c[2]; o1[2] = v1[2] * c[3] - v1[3] * s[3]; o1[3] = v1[2] * s[3] + v1[3] * c[3];
                            const u32x4 w = pack8(o0, o1);
#pragma unroll
                            for (int h = 0; h < 4; ++h) *(u32x4*)(KC + (size_t)row * 768 + h * 192 + 128 + cw) = w;
                        }
                        *(u32x4*)(Z + (size_t)row * ZC + u.pn * 256 + bj * 128 + cw) = pack8(v0, v1); } asm volatile("" ::: "memory"); }
        } else {
            const int gc0 = (u.pn - 12) * 256 + cw;
#pragma unroll
            for (int bj = 0; bj < 2; ++bj) { const f32x4 b0 = *(const f32x4*)(bgate + gc0 + bj * 128), b1 = *(const f32x4*)(bgate + gc0 + bj * 128 + 4);
#pragma unroll
                for (int ai = 0; ai < 2; ++ai)
#pragma unroll
                    for (int m = 0; m < 4; ++m) { const int row = row0 + ai * 128 + m * 16; const float r = rinv_sum(ssq + (size_t)row * 16, 4, 1.f / DM);
                        f32x4 v0 = acc[ai][bj][m][0] * r + b0, v1 = acc[ai][bj][m][1] * r + b1;
#pragma unroll
                        for (int j = 0; j < 4; ++j) { v0[j] = sigmoidf(v0[j]); v1[j] = sigmoidf(v1[j]); }
                        *(u32x4*)(Gt + (size_t)row * 3072 + gc0 + bj * 128) = pack8(v0, v1); asm volatile("" ::: "memory"); } }
        }
    }
};
struct EpiUQ {
    static constexpr bool PERM = true;
    bf16_t* QC; const float* ssqz; const float* ropeC; const float* ropeS;
    __device__ __forceinline__ void operator()(const Acc& acc, const pg8::Unit& u, int wr, int wc, int fr, int fq) const {
        const int row0 = u.pm * 256 + wr * 64 + fr;
#pragma unroll
        for (int ai = 0; ai < 2; ++ai)
#pragma unroll
            for (int m = 0; m < 4; ++m) { const int row = row0 + ai * 128 + m * 16; const float r = rinv_sum(ssqz + (size_t)row * 24, 3, 1.f / 384.f);
#pragma unroll
                for (int bj = 0; bj < 2; ++bj) { const int c = u.pn * 256 + bj * 128 + wc * 32 + 8 * fq; const int e = c % 192;
                    f32x4 v0 = acc[ai][bj][m][0] * r, v1 = acc[ai][bj][m][1] * r;
                    if (e >= 128) { const int pos = row & (SEQ - 1), j0 = (e - 128) >> 1;
                        const f32x4 cc = *(const f32x4*)(ropeC + pos * 32 + j0), s = *(const f32x4*)(ropeS + pos * 32 + j0);
                        f32x4 o0, o1;
                        o0[0] = v0[0] * cc[0] - v0[1] * s[0]; o0[1] = v0[0] * s[0] + v0[1] * cc[0]; o0[2] = v0[2] * cc[1] - v0[3] * s[1]; o0[3] = v0[2] * s[1] + v0[3] * cc[1];
                        o1[0] = v1[0] * cc[2] - v1[1] * s[2]; o1[1] = v1[0] * s[2] + v1[1] * cc[2]; o1[2] = v1[2] * cc[3] - v1[3] * s[3]; o1[3] = v1[2] * s[3] + v1[3] * cc[3];
                        v0 = o0; v1 = o1; }
                    *(u32x4*)(QC + (size_t)row * 768 + c) = pack8(v0, v1); } asm volatile("" ::: "memory"); }
    }
};
struct EpiUKV {
    static constexpr bool PERM = true;
    bf16_t* KC; bf16_t* VC; const float* ssqz;
    __device__ __forceinline__ void operator()(const Acc& acc, const pg8::Unit& u, int wr, int wc, int fr, int fq) const {
        const int row0 = u.pm * 256 + wr * 64 + fr, cw = wc * 32 + 8 * fq, h = u.pn;
#pragma unroll
        for (int ai = 0; ai < 2; ++ai)
#pragma unroll
            for (int m = 0; m < 4; ++m) { const int row = row0 + ai * 128 + m * 16; const float r = rinv_sum(ssqz + (size_t)row * 24 + 12, 2, 1.f / 256.f);
                *(u32x4*)(KC + (size_t)row * 768 + h * 192 + cw) = pack8(acc[ai][0][m][0] * r, acc[ai][0][m][1] * r);
                *(u32x4*)(VC + (size_t)row * 512 + h * 128 + cw) = pack8(acc[ai][1][m][0] * r, acc[ai][1][m][1] * r); asm volatile("" ::: "memory"); }
    }
};
struct EpiGateAcc {
    static constexpr bool PERM = false;
    const bf16_t* Gt; float* mg; bf16_t* MB;
    __device__ __forceinline__ void operator()(const Acc& acc, const pg8::Unit& u, int wr, int wc, int fr, int fq) const {
        const int nb = u.pn >> 2, pno = u.pn & 3;
        const int row0 = u.pm * 256 + wr * 64 + fr, col0 = pno * 256 + wc * 32 + 4 * fq;
#pragma unroll
        for (int ai = 0; ai < 2; ++ai)
#pragma unroll
            for (int m = 0; m < 4; ++m) { const int row = row0 + ai * 128 + m * 16;
#pragma unroll
                for (int bj = 0; bj < 2; ++bj)
#pragma unroll
                    for (int n = 0; n < 2; ++n) { const int col = col0 + bj * 128 + n * 16; const size_t off = (size_t)row * DM + col;
                        const u32x2 gw = *(const u32x2*)(Gt + (size_t)row * 3072 + nb * 1024 + col);
                        f32x4 v = acc[ai][bj][m][n]; v[0] *= bf16_lo(gw.x); v[1] *= bf16_hi(gw.x); v[2] *= bf16_lo(gw.y); v[3] *= bf16_hi(gw.y);
                        if (nb > 0) { const u32x2 pw = *(const u32x2*)((const bf16_t*)mg + off); v[0] += bf16_lo(pw.x); v[1] += bf16_hi(pw.x); v[2] += bf16_lo(pw.y); v[3] += bf16_hi(pw.y); }
                        if (nb < 2) { u32x2 w; w.x = cvt_pk_bf16(v[0], v[1]); w.y = cvt_pk_bf16(v[2], v[3]); *(u32x2*)((bf16_t*)mg + off) = w; }
                        else { u32x2 w; w.x = cvt_pk_bf16(v[0], v[1]); w.y = cvt_pk_bf16(v[2], v[3]); *(u32x2*)(MB + off) = w; } } asm volatile("" ::: "memory"); }
    }
};

#ifdef A_SIMPLE
#define ATT_A_BODY att::attn_body_simple<64, 128, 1, ZC, ZC, ZC>
#else
#define ATT_A_BODY att::attn_body<64, 128, 1, 1, ZC, ZC, ZC>
#endif
namespace att {
#define SBAR() __builtin_amdgcn_sched_barrier(0)
__device__ __forceinline__ int crow(int r, int hi) { return (r & 3) + 8 * (r >> 2) + 4 * hi; }
template <int DQK> __device__ __forceinline__ int kswz(int row, int colB) { return row * (DQK * 2) + (colB ^ (((row >> 1) & 7) << 4)); }
template <int DV> __device__ __forceinline__ int v_st(int k, int c) { constexpr int NCB = DV / 32; const int kk = (k & ~0xC) | ((k & 4) << 1) | ((k & 8) >> 1); return ((kk >> 3) * NCB + (c >> 5)) * 512 + ((kk & 7) * 32 + (c & 31)) * 2; }
__device__ __forceinline__ int v_rd_base(int lane) { return ((lane & 3) << 3) | (((lane >> 2) & 3) << 6) | (((lane >> 4) & 1) << 5) | (((lane >> 5) & 1) << 8); }
template <int DV> constexpr int v_rd_off(int d0, int ks, int half) { return d0 * 512 + ks * (2 * (DV / 32) * 512) + half * ((DV / 32) * 512); }
template <int OFF> __device__ __forceinline__ s16x4 tr_read(int vb) { s16x4 r; asm volatile("ds_read_b64_tr_b16 %0, %1 offset:%2" : "=&v"(r) : "v"(vb), "i"(OFF) : "memory"); return r; }

__device__ __forceinline__ void partialSM(f32x16& p0, f32x16& p1, float& m_reg, float& mn, float& alpha, float C, float thr, float aoff = 0.f, bool nomax = false) {
    if (nomax) { mn = m_reg; alpha = 1.f; }
    else {
    float pmax = p0[0];
#pragma unroll
    for (int r = 1; r < 16; ++r) pmax = fmaxf(pmax, p0[r]);
#pragma unroll
    for (int r = 0; r < 16; ++r) pmax = fmaxf(pmax, p1[r]);
    pmax += aoff;
    { auto rr = __builtin_amdgcn_permlane32_swap(__float_as_uint(pmax), __float_as_uint(pmax), false, false); pmax = fmaxf(__uint_as_float(rr[0]), __uint_as_float(rr[1])); }
    if (__builtin_expect(__all(pmax - m_reg <= thr), 1)) { mn = m_reg; alpha = 1.f; }
    else { mn = fmaxf(m_reg, pmax); alpha = __builtin_amdgcn_exp2f((m_reg - mn) * C); m_reg = mn; }
    }
    const float mnC = mn < -1e29f ? 0.f : (aoff - mn) * C;
#pragma unroll
    for (int r = 0; r < 16; ++r) p0[r] = fmaf(p0[r], C, mnC);
#pragma unroll
    for (int r = 0; r < 16; ++r) p1[r] = fmaf(p1[r], C, mnC);
#pragma unroll
    for (int r = 0; r < 16; ++r) p0[r] = __builtin_amdgcn_exp2f(p0[r]);
}
__device__ __forceinline__ void finishSM(f32x16& p0, f32x16& p1, float alpha, float& l_reg, bf16x8& pa0, bf16x8& pa1, bf16x8& pa2, bf16x8& pa3) {
#pragma unroll
    for (int r = 0; r < 16; ++r) p1[r] = __builtin_amdgcn_exp2f(p1[r]);
    float ps = 0;
#pragma unroll
    for (int r = 0; r < 16; ++r) ps += p0[r];
#pragma unroll
    for (int r = 0; r < 16; ++r) ps += p1[r];
    { auto rr = __builtin_amdgcn_permlane32_swap(__float_as_uint(ps), __float_as_uint(ps), false, false); ps = __uint_as_float(rr[0]) + __uint_as_float(rr[1]); }
    l_reg = l_reg * alpha + ps;
#define PK4(P, BASE, OUT) do { unsigned a0 = cvt_pk_bf16(P[BASE + 0], P[BASE + 1]), a1 = cvt_pk_bf16(P[BASE + 2], P[BASE + 3]);   \
    unsigned b0 = cvt_pk_bf16(P[BASE + 4], P[BASE + 5]), b1 = cvt_pk_bf16(P[BASE + 6], P[BASE + 7]);                              \
    auto r0 = __builtin_amdgcn_permlane32_swap(a0, b0, false, false); auto r1 = __builtin_amdgcn_permlane32_swap(a1, b1, false, false); \
    u32x4 w = {r0[0], r1[0], r0[1], r1[1]}; OUT = *reinterpret_cast<bf16x8*>(&w); } while (0)
    PK4(p0, 0, pa0); PK4(p0, 8, pa1); PK4(p1, 0, pa2); PK4(p1, 8, pa3);
#undef PK4
}
template <int MODE> __device__ __forceinline__ float alibi_off(int rel, float dq, float sl) { return (MODE == 1 && (rel > 63 || rel < -31)) ? (rel > 63 ? -sl : sl) * dq : 0.f; }
template <int DQK, int MODE, int NQR = DQK / 16> __device__ __forceinline__ void qkt(f32x16& p0, f32x16& p1, LAS const char* Ks, const bf16x8* qr, int r32, int hi, float dq, float sl, LAS const char* qlds = nullptr, int rel = 0) {
    p0 = f32x16{}; p1 = f32x16{};
    if (NQR < DQK / 16) asm volatile("" : "+v"(qlds));
    const int x_ = ((r32 >> 1) & 7) << 4; int kb[4];
#pragma unroll
    for (int j = 0; j < 4; ++j) kb[j] = r32 * (DQK * 2) + ((j * 32 + hi * 16) ^ x_);
#pragma unroll
    for (int d0 = 0; d0 < DQK / 16; ++d0) {
        bf16x8 qf; if (d0 < NQR) qf = qr[d0 < NQR ? d0 : 0]; else qf = *(LAS const bf16x8*)(qlds + (d0 - NQR) * 1024);
        const bf16x8 b0 = *(LAS const bf16x8*)(Ks + kb[d0 & 3] + (d0 >> 2) * 128);
        const bf16x8 b1 = *(LAS const bf16x8*)(Ks + kb[d0 & 3] + (d0 >> 2) * 128 + 32 * (DQK * 2));
        p0 = __builtin_amdgcn_mfma_f32_32x32x16_bf16(b0, qf, p0, 0, 0, 0);
        p1 = __builtin_amdgcn_mfma_f32_32x32x16_bf16(b1, qf, p1, 0, 0, 0); }
    if (MODE == 1 && (rel > 63 || rel < -31)) {
        const float ss = rel > 63 ? sl : -sl;
#pragma unroll
        for (int r = 0; r < 16; ++r) { const float c = (float)((r & 3) + 8 * (r >> 2)); p0[r] = fmaf(ss, c, p0[r]); p1[r] = fmaf(ss, c + 32.f, p1[r]); }
    } else if (MODE != 0) {
#pragma unroll
        for (int r = 0; r < 16; ++r) { const float c = (float)((r & 3) + 8 * (r >> 2)); const float d0 = fabsf(dq - c), d1 = fabsf(dq - 32.f - c);
            if (MODE == 1) { p0[r] = fmaf(-sl, d0, p0[r]); p1[r] = fmaf(-sl, d1, p1[r]); }
            else { p0[r] = d0 > 128.f ? -1e30f : fmaf(-sl, d0, p0[r]); p1[r] = d1 > 128.f ? -1e30f : fmaf(-sl, d1, p1[r]); } }
    }
}
template <int D0, int DV> __device__ __forceinline__ void pv_one(f32x16& od, int vb, bf16x8 pa0, bf16x8 pa1, bf16x8 pa2, bf16x8 pa3) {
    const s16x4 l0 = tr_read<v_rd_off<DV>(D0, 0, 0)>(vb), h0 = tr_read<v_rd_off<DV>(D0, 0, 1)>(vb), l1 = tr_read<v_rd_off<DV>(D0, 1, 0)>(vb), h1 = tr_read<v_rd_off<DV>(D0, 1, 1)>(vb);
    const s16x4 l2 = tr_read<v_rd_off<DV>(D0, 2, 0)>(vb), h2 = tr_read<v_rd_off<DV>(D0, 2, 1)>(vb), l3 = tr_read<v_rd_off<DV>(D0, 3, 0)>(vb), h3 = tr_read<v_rd_off<DV>(D0, 3, 1)>(vb);
    asm volatile("s_waitcnt lgkmcnt(0)" ::: "memory"); SBAR();
#define PK(L, H) (bf16x8){L[0], L[1], L[2], L[3], H[0], H[1], H[2], H[3]}
    od = __builtin_amdgcn_mfma_f32_32x32x16_bf16(pa0, PK(l0, h0), od, 0, 0, 0);
    od = __builtin_amdgcn_mfma_f32_32x32x16_bf16(pa1, PK(l1, h1), od, 0, 0, 0);
    od = __builtin_amdgcn_mfma_f32_32x32x16_bf16(pa2, PK(l2, h2), od, 0, 0, 0);
    od = __builtin_amdgcn_mfma_f32_32x32x16_bf16(pa3, PK(l3, h3), od, 0, 0, 0);
#undef PK
}
template <int DV> __device__ __forceinline__ void pv_all(f32x16* o, int vb, bf16x8 pa0, bf16x8 pa1, bf16x8 pa2, bf16x8 pa3) {
    pv_one<0, DV>(o[0], vb, pa0, pa1, pa2, pa3); pv_one<1, DV>(o[1], vb, pa0, pa1, pa2, pa3);
    if constexpr (DV == 128) { pv_one<2, DV>(o[2], vb, pa0, pa1, pa2, pa3); pv_one<3, DV>(o[3], vb, pa0, pa1, pa2, pa3); }
}

template <int DQK, int DV, int MODE, int SD, int LDQ, int LDK, int LDV, int NQL = 0, class Epi>
__device__ __forceinline__ void attn_body(const bf16_t* __restrict__ Qb, const bf16_t* __restrict__ Kh, const bf16_t* __restrict__ Vh, int kstart, int NT, int qpos0,
                                          float scale, float slope, float sinkl2, LAS char* lds, const Epi& epi, int wave_, int safe_nomax = 0) {
    asm volatile("" : "+s"(Qb), "+s"(Kh), "+s"(Vh));
    constexpr int SHM_V = 64 * DV * 2, SHM_K = 64 * DQK * 2, NQ = DQK / 16, NO = DV / 32;
    constexpr int KCH = DQK / 8, NKC = 64 * KCH / 512, VCH = DV / 8, NVC = 64 * VCH / 512;
    int tid = wave_ * 64 + lane_id(); asm volatile("" : "+v"(tid));
    const int wid = tid >> 6, lane = tid & 63, r32 = lane & 31, hi = lane >> 5;
    LAS char* V_lds = lds; LAS char* K_lds = lds + 2 * SHM_V;
    LAS float* wsf = (LAS float*)(lds + 2 * SHM_V + 2 * SHM_K) + wid * 64; LAS float* li_l = wsf; LAS float* al_l = wsf + 32;
    const float C = scale * LOG2E, thr = 8.f / scale, sl = slope / scale;
    const float dq0 = (float)(qpos0 + wid * 32 + r32 - kstart - 4 * hi);
    constexpr int NQR = NQ - NQL;
    LAS char* qlds = lds + 2 * SHM_V + 2 * SHM_K + 2048 + wid * (NQL * 1024) + lane * 16;
    float m_reg = -1e30f, l_reg = 0; f32x16 o[NO]; bf16x8 qr[NQR > 0 ? NQR : 1];
#pragma unroll
    for (int d = 0; d < NO; ++d) o[d] = f32x16{};
    const GAS bf16_t* Qw = (const GAS bf16_t*)Qb + (size_t)(wid * 32 + r32) * LDQ + hi * 8;
#pragma unroll
    for (int d0 = 0; d0 < NQ; ++d0) { const bf16x8 qv = *(const GAS bf16x8*)(Qw + d0 * 16); if (d0 < NQR) qr[d0 < NQR ? d0 : 0] = qv; else *(LAS bf16x8*)(qlds + (d0 - NQR) * 1024) = qv; }
    int koff[NKC], kst[NKC], voff[NVC], vst[NVC];
#pragma unroll
    for (int i = 0; i < NKC; ++i) { const int c = tid + 512 * i, row = c / KCH, c8 = c % KCH; koff[i] = row * LDK + c8 * 8; kst[i] = kswz<DQK>(row, c8 * 16); }
#pragma unroll
    for (int i = 0; i < NVC; ++i) { const int c = tid + 512 * i, row = c / VCH, c8 = c % VCH; voff[i] = row * LDV + c8 * 8; vst[i] = v_st<DV>(row, c8 * 8); }
    const int vb0 = (int)(unsigned)(size_t)V_lds + v_rd_base(lane);
    struct { bf16x8 k[NKC]; bf16x8 v[NVC]; } sr_[SD];
    const GAS bf16_t* Kp = (const GAS bf16_t*)Kh + (size_t)kstart * LDK; const GAS bf16_t* Vp = (const GAS bf16_t*)Vh + (size_t)kstart * LDV;
#define SLOAD(i, k0) do { if constexpr (NQL > 0) { int t_ = tid; asm volatile("" : "+v"(t_)); \
      _Pragma("unroll") for (int _c = 0; _c < NVC; ++_c) { const int c_ = t_ + 512 * _c; sr_[i].v[_c] = *(const GAS bf16x8*)(Vp + (size_t)((k0) + c_ / VCH) * LDV + (c_ % VCH) * 8); } \
      _Pragma("unroll") for (int _c = 0; _c < NKC; ++_c) { const int c_ = t_ + 512 * _c; sr_[i].k[_c] = *(const GAS bf16x8*)(Kp + (size_t)((k0) + c_ / KCH) * LDK + (c_ % KCH) * 8); } } else { \
    _Pragma("unroll") for (int _c = 0; _c < NVC; ++_c) sr_[i].v[_c] = *(const GAS bf16x8*)(Vp + (size_t)(k0) * LDV + voff[_c]); \
    _Pragma("unroll") for (int _c = 0; _c < NKC; ++_c) sr_[i].k[_c] = *(const GAS bf16x8*)(Kp + (size_t)(k0) * LDK + koff[_c]); } } while (0)
#define SWRITE(b, i) do { if constexpr (NQL > 0) { int t_ = tid; asm volatile("" : "+v"(t_)); \
      _Pragma("unroll") for (int _c = 0; _c < NVC; ++_c) { const int c_ = t_ + 512 * _c; *(LAS bf16x8*)(V_lds + (b) * SHM_V + v_st<DV>(c_ / VCH, (c_ % VCH) * 8)) = sr_[i].v[_c]; } \
      _Pragma("unroll") for (int _c = 0; _c < NKC; ++_c) { const int c_ = t_ + 512 * _c; *(LAS bf16x8*)(K_lds + (b) * SHM_K + kswz<DQK>(c_ / KCH, (c_ % KCH) * 16)) = sr_[i].k[_c]; } } else { \
    _Pragma("unroll") for (int _c = 0; _c < NVC; ++_c) *(LAS bf16x8*)(V_lds + (b) * SHM_V + vst[_c]) = sr_[i].v[_c]; \
    _Pragma("unroll") for (int _c = 0; _c < NKC; ++_c) *(LAS bf16x8*)(K_lds + (b) * SHM_K + kst[_c]) = sr_[i].k[_c]; } } while (0)
#define RESC(a) do { if (__any((a) < 1.f)) { if (hi == 0) al_l[r32] = (a); asm volatile("s_waitcnt lgkmcnt(0)" ::: "memory"); \
    _Pragma("unroll") for (int d = 0; d < NO; ++d) _Pragma("unroll") for (int r = 0; r < 16; ++r) o[d][r] *= al_l[crow(r, hi)]; } } while (0)
    f32x16 pA0, pA1, pB0, pB1; float mnA, mnB, alA, alB; bf16x8 pa0, pa1, pa2, pa3;
    const int rel0 = qpos0 + __builtin_amdgcn_readfirstlane(wid) * 32 - kstart;
    constexpr int SE = 0, SO = SD - 1;
    __syncthreads();
    SLOAD(SE, 0); asm volatile("s_waitcnt vmcnt(0)" ::: "memory"); SWRITE(0, SE); __syncthreads();
    qkt<DQK, MODE, NQR>(pA0, pA1, K_lds, qr, r32, hi, dq0, sl, qlds, rel0); partialSM(pA0, pA1, m_reg, mnA, alA, C, thr, alibi_off<MODE>(rel0, dq0, sl), MODE == 1 && safe_nomax && rel0 < -31);
    SLOAD(SO, 64); if constexpr (SD == 2) { if (2 < NT) SLOAD(SE, 128); }
    SWRITE(1, SO); __syncthreads();
    for (int j = 1; j + 1 < NT; j += 2) {
        SBAR(); qkt<DQK, MODE, NQR>(pB0, pB1, K_lds + SHM_K, qr, r32, hi, dq0 - 64.f * (float)j, sl, qlds, rel0 - 64 * j);
        finishSM(pA0, pA1, alA, l_reg, pa0, pa1, pa2, pa3); SBAR();
        SLOAD(SO, (j + SD) * 64); SBAR();
        pv_all<DV>(o, vb0, pa0, pa1, pa2, pa3); partialSM(pB0, pB1, m_reg, mnB, alB, C, thr, alibi_off<MODE>(rel0 - 64 * j, dq0 - 64.f * (float)j, sl), MODE == 1 && safe_nomax && rel0 - 64 * j < -31);
        __syncthreads(); SWRITE(0, SE);
        RESC(alB); __syncthreads();
        SBAR(); qkt<DQK, MODE, NQR>(pA0, pA1, K_lds, qr, r32, hi, dq0 - 64.f * (float)(j + 1), sl, qlds, rel0 - 64 * (j + 1));
        finishSM(pB0, pB1, alB, l_reg, pa0, pa1, pa2, pa3); SBAR();
        if (SD == 1 || j + 3 < NT) SLOAD(SE, (j + 1 + SD) * 64); SBAR();
        pv_all<DV>(o, vb0 + SHM_V, pa0, pa1, pa2, pa3); partialSM(pA0, pA1, m_reg, mnA, alA, C, thr, alibi_off<MODE>(rel0 - 64 * (j + 1), dq0 - 64.f * (float)(j + 1), sl), MODE == 1 && safe_nomax && rel0 - 64 * (j + 1) < -31);
        __syncthreads(); SWRITE(1, SO);
        RESC(alA); __syncthreads();
    }
    SBAR(); qkt<DQK, MODE, NQR>(pB0, pB1, K_lds + SHM_K, qr, r32, hi, dq0 - 64.f * (float)(NT - 1), sl, qlds, rel0 - 64 * (NT - 1));
    finishSM(pA0, pA1, alA, l_reg, pa0, pa1, pa2, pa3); SBAR();
    pv_all<DV>(o, vb0, pa0, pa1, pa2, pa3); partialSM(pB0, pB1, m_reg, mnB, alB, C, thr, alibi_off<MODE>(rel0 - 64 * (NT - 1), dq0 - 64.f * (float)(NT - 1), sl), MODE == 1 && safe_nomax && rel0 - 64 * (NT - 1) < -31);
    __syncthreads(); RESC(alB);
    finishSM(pB0, pB1, alB, l_reg, pa0, pa1, pa2, pa3); SBAR();
    pv_all<DV>(o, vb0 + SHM_V, pa0, pa1, pa2, pa3);
    if (MODE == 2) l_reg += __builtin_amdgcn_exp2f(sinkl2 - m_reg * C);
    if (hi == 0) li_l[r32] = l_reg; asm volatile("s_waitcnt lgkmcnt(0)" ::: "memory");
    float rli[16];
#pragma unroll
    for (int r = 0; r < 16; ++r) rli[r] = __builtin_amdgcn_rcpf(li_l[crow(r, hi)]);
    epi(o, rli, wid, r32, hi);
#undef SLOAD
#undef SWRITE
#undef RESC
}

template <int DQK, int DV, int MODE, int LDQ, int LDK, int LDV, class Epi>
__device__ __forceinline__ void attn_body_simple(const bf16_t* __restrict__ Qb, const bf16_t* __restrict__ Kh, const bf16_t* __restrict__ Vh, int kstart, int NT, int qpos0,
                                                 float scale, float slope, float sinkl2, LAS char* lds, const Epi& epi, int wave_) {
    asm volatile("" : "+s"(Qb), "+s"(Kh), "+s"(Vh));
    constexpr int SHM_V = 64 * DV * 2, SHM_K = 64 * DQK * 2, NQ = DQK / 16, NO = DV / 32;
    constexpr int KCH = DQK / 8, NKC = 64 * KCH / 512, VCH = DV / 8, NVC = 64 * VCH / 512;
    int tid = wave_ * 64 + lane_id(); asm volatile("" : "+v"(tid));
    const int wid = tid >> 6, lane = tid & 63, r32 = lane & 31, hi = lane >> 5;
    LAS char* V_lds = lds; LAS char* K_lds = lds + 3 * SHM_V;
    LAS float* wsf = (LAS float*)(lds + 3 * SHM_V + 3 * SHM_K) + wid * 64; LAS float* li_l = wsf; LAS float* al_l = wsf + 32;
    const float C = scale * LOG2E, thr = 8.f / scale, sl = slope / scale;
    const float dq0 = (float)(qpos0 + wid * 32 + r32 - kstart - 4 * hi);
    float m_reg = -1e30f, l_reg = 0; f32x16 o[NO]; bf16x8 qr[NQ];
#pragma unroll
    for (int d = 0; d < NO; ++d) o[d] = f32x16{};
    const GAS bf16_t* Qw = (const GAS bf16_t*)Qb + (size_t)(wid * 32 + r32) * LDQ + hi * 8;
#pragma unroll
    for (int d0 = 0; d0 < NQ; ++d0) qr[d0] = *(const GAS bf16x8*)(Qw + d0 * 16);
    const int vb0 = (int)(unsigned)(size_t)V_lds + v_rd_base(lane);
    bf16x8 sk[NKC], sv[NVC];
    const GAS bf16_t* Kp = (const GAS bf16_t*)Kh + (size_t)kstart * LDK; const GAS bf16_t* Vp = (const GAS bf16_t*)Vh + (size_t)kstart * LDV;
#define S1LOAD(k0) do { _Pragma("unroll") for (int _c = 0; _c < NVC; ++_c) { const int c_ = tid + 512 * _c; sv[_c] = *(const GAS bf16x8*)(Vp + (size_t)((k0) + c_ / VCH) * LDV + (c_ % VCH) * 8); } \
    _Pragma("unroll") for (int _c = 0; _c < NKC; ++_c) { const int c_ = tid + 512 * _c; sk[_c] = *(const GAS bf16x8*)(Kp + (size_t)((k0) + c_ / KCH) * LDK + (c_ % KCH) * 8); } } while (0)
#define S1WRITE(b) do { _Pragma("unroll") for (int _c = 0; _c < NVC; ++_c) { const int c_ = tid + 512 * _c; *(LAS bf16x8*)(V_lds + (b) * SHM_V + v_st<DV>(c_ / VCH, (c_ % VCH) * 8)) = sv[_c]; } \
    _Pragma("unroll") for (int _c = 0; _c < NKC; ++_c) { const int c_ = tid + 512 * _c; *(LAS bf16x8*)(K_lds + (b) * SHM_K + kswz<DQK>(c_ / KCH, (c_ % KCH) * 16)) = sk[_c]; } } while (0)
    __syncthreads();
    S1LOAD(0); S1WRITE(0); S1LOAD(64); S1WRITE(1);
    if (2 < NT) S1LOAD(128);
    int slot = 0;
    for (int j = 0; j < NT; ++j) {
        __syncthreads();
        { const int wslot = slot == 0 ? 2 : slot - 1;
          if (j + 2 < NT) { S1WRITE(wslot); if (j + 3 < NT) S1LOAD((j + 3) * 64); } }
        f32x16 p0, p1; float mn, al; bf16x8 pa0, pa1, pa2, pa3;
        qkt<DQK, MODE>(p0, p1, K_lds + slot * SHM_K, qr, r32, hi, dq0 - 64.f * (float)j, sl);
        partialSM(p0, p1, m_reg, mn, al, C, thr);
        finishSM(p0, p1, al, l_reg, pa0, pa1, pa2, pa3);
        if (__any(al < 1.f)) { if (hi == 0) al_l[r32] = al; asm volatile("s_waitcnt lgkmcnt(0)" ::: "memory");
#pragma unroll
            for (int d = 0; d < NO; ++d)
#pragma unroll
                for (int r = 0; r < 16; ++r) o[d][r] *= al_l[crow(r, hi)]; }
        SBAR();
        pv_all<DV>(o, vb0 + slot * SHM_V, pa0, pa1, pa2, pa3);
        slot = slot == 2 ? 0 : slot + 1;
    }
#undef S1LOAD
#undef S1WRITE
    if (MODE == 2) l_reg += __builtin_amdgcn_exp2f(sinkl2 - m_reg * C);
    if (hi == 0) li_l[r32] = l_reg; asm volatile("s_waitcnt lgkmcnt(0)" ::: "memory");
    float rli[16];
#pragma unroll
    for (int r = 0; r < 16; ++r) rli[r] = __builtin_amdgcn_rcpf(li_l[crow(r, hi)]);
    epi(o, rli, wid, r32, hi);
}

template <int NO> struct EpiStoreBf16 {
    bf16_t* O; int ldo;
    __device__ __forceinline__ void operator()(const f32x16* o, const float* rli, int wid, int r32, int hi) const {
        bf16_t* Ob = O; asm volatile("" : "+s"(Ob));
#pragma unroll
        for (int r = 0; r < 16; ++r) { GAS bf16_t* p = (GAS bf16_t*)Ob + (size_t)(wid * 32 + crow(r, hi)) * ldo + r32;
#pragma unroll
            for (int d0 = 0; d0 < NO; ++d0) p[d0 * 32] = (bf16_t)(cvt_pk_bf16(o[d0][r] * rli[r], 0.f) & 0xffffu); }
    }
};
struct EpiDiff0 {
    float* scr;
    __device__ __forceinline__ void operator()(const f32x16* o, const float* rli, int wid, int r32, int hi) const {
        float* sb = scr; asm volatile("" : "+s"(sb));
        int t_ = wid * 64 + hi * 32 + r32; GAS f32x4* p = (GAS f32x4*)(sb + t_ * 64);
#pragma unroll
        for (int d0 = 0; d0 < 4; ++d0)
#pragma unroll
            for (int q = 0; q < 4; ++q) { f32x4 v;
#pragma unroll
                for (int i = 0; i < 4; ++i) v[i] = o[d0][4 * q + i] * rli[4 * q + i];
                p[d0 * 4 + q] = v; }
    }
};
struct EpiDiff1 {
    const float* scr; bf16_t* O; int ldo; const float* g; float lam, oscale;
    __device__ __forceinline__ void operator()(const f32x16* o, const float* rli, int wid, int r32, int hi) const {
        const float* sb = scr; bf16_t* Ob = O; asm volatile("" : "+s"(sb), "+s"(Ob));
        int t_ = wid * 64 + hi * 32 + r32; const GAS f32x4* p = (const GAS f32x4*)(sb + t_ * 64); float gv[4];
#pragma unroll
        for (int d0 = 0; d0 < 4; ++d0) gv[d0] = g[d0 * 32 + r32] * oscale;
#pragma unroll
        for (int q = 0; q < 4; ++q) { f32x4 t[4];
#pragma unroll
            for (int d0 = 0; d0 < 4; ++d0) t[d0] = p[d0 * 4 + q];
#pragma unroll
            for (int i = 0; i < 4; ++i) { const int r = 4 * q + i; float s = 0.f;
#pragma unroll
                for (int d0 = 0; d0 < 4; ++d0) { t[d0][i] -= lam * (o[d0][r] * rli[r]); s += t[d0][i] * t[d0][i]; }
                s += shfl_xor_f(s, 1); s += shfl_xor_f(s, 2); s += shfl_xor_f(s, 4); s += shfl_xor_f(s, 8); s += shfl_xor_f(s, 16);
                const float rn = fast_rsq(s * (1.f / 128.f) + EPS);
                GAS bf16_t* qp = (GAS bf16_t*)Ob + (size_t)(wid * 32 + crow(r, hi)) * ldo + r32;
#pragma unroll
                for (int d0 = 0; d0 < 4; ++d0) qp[d0 * 32] = (bf16_t)(cvt_pk_bf16(t[d0][i] * rn * gv[d0], 0.f) & 0xffffu); }
            asm volatile("" ::: "memory"); }
    }
};
}

__device__ __forceinline__ float wave_sum(float v) {
#pragma unroll
    for (int o = 1; o < 64; o <<= 1) v += shfl_xor_f(v, o);
    return v;
}
template <int MODE> __device__ __forceinline__ int src_col(int n) {
    if (MODE == 1) { const int t = n >> 8, j = n & 255; return j < 128 ? t * 128 + j : FF + t * 128 + (j - 128); }
    if (MODE == 2) { if (n < Z_CKR) return n; if (n < 3008) { const int e = n - Z_CKR; return Z_CKR + (e >> 1) + 32 * (e & 1); } return -1; }
    if (MODE == 3) { const int h = n / 192, e = n - h * 192; if (e < 128) return n; const int e2 = e - 128; return h * 192 + 128 + (e2 >> 1) + 32 * (e2 & 1); }
    return n;
}
template <int MODE> __device__ __forceinline__ void tr_item(const float* __restrict__ W, int K, int Nsrc, const float* __restrict__ gain, bf16_t* WT, int nblk, LAS float* scr, int item, int lane) {
    const int kb = item / nblk, nb = item - kb * nblk, k0 = 64 * kb, n0 = 32 * nb;
    const int sc0 = src_col<MODE>(n0), sc31 = src_col<MODE>(n0 + 31);
    if (sc0 >= 0 && sc31 == sc0 + 31 && (sc0 & 3) == 0) {
        const int row8 = lane >> 3, n4 = (lane & 7) * 4;
#pragma unroll
        for (int i = 0; i < 8; ++i) { const int kk = 8 * i + row8; f32x4 v = *(const f32x4*)(W + (size_t)(k0 + kk) * Nsrc + sc0 + n4);
            if (gain) v = v * gain[k0 + kk];
            LAS float* d = scr + kk * 33 + n4; d[0] = v[0]; d[1] = v[1]; d[2] = v[2]; d[3] = v[3]; }
    } else {
        const int sc = src_col<MODE>(n0 + (lane & 31));
#pragma unroll
        for (int i = 0; i < 32; ++i) { const int kk = 2 * i + (lane >> 5); float v = 0.f;
            if (sc >= 0) { v = W[(size_t)(k0 + kk) * Nsrc + sc]; if (gain) v *= gain[k0 + kk]; }
            scr[kk * 33 + (lane & 31)] = v; }
    }
    asm volatile("s_waitcnt lgkmcnt(0)" ::: "memory");
    const int c = lane & 7;
#pragma unroll
    for (int j = 0; j < 4; ++j) { const int n = (lane >> 3) + 8 * j; const LAS float* s = scr + (8 * c) * 33 + n;
        u32x4 o; o.x = cvt_pk_bf16(s[0 * 33], s[1 * 33]); o.y = cvt_pk_bf16(s[2 * 33], s[3 * 33]); o.z = cvt_pk_bf16(s[4 * 33], s[5 * 33]); o.w = cvt_pk_bf16(s[6 * 33], s[7 * 33]);
        *(u32x4*)(WT + (size_t)(n0 + n) * K + k0 + 8 * c) = o; }
    asm volatile("s_waitcnt lgkmcnt(0)" ::: "memory");
}

struct Args { const float* in[21]; float* out; unsigned char* ws; int ph_lo, ph_hi; };
enum { I_X = 0, I_F1N, I_F1W13, I_F1W2, I_MIXN, I_WIN, I_WGATE, I_BGATE, I_ALAM, I_ASUB, I_BSINK, I_CQN, I_CWUQ, I_CKVN, I_CWUKV, I_WBR, I_WOUT, I_F2N, I_F2W13, I_F2W2, I_FINN };

constexpr int LDS_BYTES = 155648;

struct TrDesc { const float* W; const float* gain; bf16_t* WT; int K, Nsrc, nblk, mode, r; };
__device__ __forceinline__ int src_col_rt(int mode, int n) { return mode == 1 ? src_col<1>(n) : mode == 2 ? src_col<2>(n) : mode == 3 ? src_col<3>(n) : n; }
__device__ __forceinline__ bool tr_decode(const Args& a, int l, unsigned char* ws, int it, TrDesc& d) {
    constexpr int I_W13 = (DM / 64) * (2 * FF / 32), I_W2 = (FF / 64) * (DM / 32), I_IN = (DM / 64) * (3072 / 32), I_GT = I_IN,
                  I_UQ = (384 / 64) * (768 / 32), I_UKV = (256 / 64) * (1024 / 32), I_BR = (512 / 64) * (1024 / 32), I_OUT = (DM / 64) * (DM / 32);
    constexpr int NITEMS = 2 * I_W13 + 2 * I_W2 + I_IN + I_GT + I_UQ + I_UKV + 3 * I_BR + I_OUT;
    if (it >= NITEMS) return false;
    int r = it;
#define TR_SET(W_, K_, NS_, G_, WT_, NB_, M_) do { d.W = (W_); d.K = (K_); d.Nsrc = (NS_); d.gain = (G_); d.WT = (WT_); d.nblk = (NB_); d.mode = (M_); d.r = r; return true; } while (0)
    if (r < I_W13) TR_SET(a.in[I_F1W13] + (size_t)l * DM * 2 * FF, DM, 2 * FF, a.in[I_F1N] + l * DM, (bf16_t*)(ws + WS_W13A), 2 * FF / 32, 1); r -= I_W13;
    if (r < I_W13) TR_SET(a.in[I_F2W13] + (size_t)l * DM * 2 * FF, DM, 2 * FF, a.in[I_F2N] + l * DM, (bf16_t*)(ws + WS_W13B), 2 * FF / 32, 1); r -= I_W13;
    if (r < I_W2) TR_SET(a.in[I_F1W2] + (size_t)l * FF * DM, FF, DM, nullptr, (bf16_t*)(ws + WS_W2A), DM / 32, 0); r -= I_W2;
    if (r < I_W2) TR_SET(a.in[I_F2W2] + (size_t)l * FF * DM, FF, DM, nullptr, (bf16_t*)(ws + WS_W2B), DM / 32, 0); r -= I_W2;
    if (r < I_IN) TR_SET(a.in[I_WIN] + (size_t)l * DM * 3008, DM, 3008, a.in[I_MIXN] + l * DM, (bf16_t*)(ws + WS_WIG), 3072 / 32, 2); r -= I_IN;
    if (r < I_GT) TR_SET(a.in[I_WGATE] + (size_t)l * DM * 3072, DM, 3072, a.in[I_MIXN] + l * DM, (bf16_t*)(ws + WS_WIG) + (size_t)3072 * DM, 3072 / 32, 0); r -= I_GT;
    if (r < I_UQ) TR_SET(a.in[I_CWUQ] + (size_t)l * 384 * 768, 384, 768, a.in[I_CQN] + l * 384, (bf16_t*)(ws + WS_WUQ), 768 / 32, 3); r -= I_UQ;
    if (r < I_UKV) TR_SET(a.in[I_CWUKV] + (size_t)l * 256 * 1024, 256, 1024, a.in[I_CKVN] + l * 256, (bf16_t*)(ws + WS_WUKV), 1024 / 32, 0); r -= I_UKV;
    if (r < 3 * I_BR) { const int n = r / I_BR; r -= n * I_BR; TR_SET(a.in[I_WBR] + ((size_t)l * 3 + n) * 512 * 1024, 512, 1024, nullptr, (bf16_t*)(ws + WS_WB) + (size_t)n * 1024 * 512, 1024 / 32, 0); } r -= 3 * I_BR;
    TR_SET(a.in[I_WOUT] + (size_t)l * DM * DM, DM, DM, nullptr, (bf16_t*)(ws + WS_WO), DM / 32, 0);
#undef TR_SET
}
__device__ __forceinline__ bool tr_load(const TrDesc& d, int lane, f32x4 (&v)[8]) {
    const int kb = d.r / d.nblk, nb = d.r - kb * d.nblk, k0 = 64 * kb, n0 = 32 * nb;
    const int sc0 = src_col_rt(d.mode, n0), sc31 = src_col_rt(d.mode, n0 + 31);
    const bool vec = sc0 >= 0 && sc31 == sc0 + 31 && (sc0 & 3) == 0;
    if (vec) { const int row8 = lane >> 3, n4 = (lane & 7) * 4;
#pragma unroll
        for (int i = 0; i < 8; ++i) { const int kk = 8 * i + row8; v[i] = *(const f32x4*)(d.W + (size_t)(k0 + kk) * d.Nsrc + sc0 + n4); } }
    return vec;
}
__device__ __forceinline__ void tr_finish(const TrDesc& d, bool vec, int lane, const f32x4 (&v)[8], LAS float* scr) {
    const int kb = d.r / d.nblk, nb = d.r - kb * d.nblk, k0 = 64 * kb, n0 = 32 * nb;
    if (vec) { const int row8 = lane >> 3, n4 = (lane & 7) * 4;
#pragma unroll
        for (int i = 0; i < 8; ++i) { const int kk = 8 * i + row8; const f32x4 x = d.gain ? v[i] * d.gain[k0 + kk] : v[i]; LAS float* p = scr + kk * 33 + n4; p[0] = x[0]; p[1] = x[1]; p[2] = x[2]; p[3] = x[3]; }
    } else { const int sc = src_col_rt(d.mode, n0 + (lane & 31));
#pragma unroll 8
        for (int i = 0; i < 32; ++i) { const int kk = 2 * i + (lane >> 5); float x = 0.f;
            if (sc >= 0) { x = d.W[(size_t)(k0 + kk) * d.Nsrc + sc]; if (d.gain) x *= d.gain[k0 + kk]; }
            scr[kk * 33 + (lane & 31)] = x; } }
    asm volatile("s_waitcnt lgkmcnt(0)" ::: "memory");
    const int c = lane & 7;
#pragma unroll
    for (int j = 0; j < 4; ++j) { const int n = (lane >> 3) + 8 * j; const LAS float* s = scr + (8 * c) * 33 + n;
        u32x4 o; o.x = cvt_pk_bf16(s[0 * 33], s[1 * 33]); o.y = cvt_pk_bf16(s[2 * 33], s[3 * 33]); o.z = cvt_pk_bf16(s[4 * 33], s[5 * 33]); o.w = cvt_pk_bf16(s[6 * 33], s[7 * 33]);
        *(u32x4*)(d.WT + (size_t)(n0 + n) * d.K + k0 + 8 * c) = o; }
    asm volatile("s_waitcnt lgkmcnt(0)" ::: "memory");
}
__device__ __forceinline__ void convert_layer(const Args& a, int l, LAS unsigned char* lds, int gw, int NGW, int wave, int mask = 0) {
    constexpr int I_W13 = (DM / 64) * (2 * FF / 32), I_W2 = (FF / 64) * (DM / 32), I_IN = (DM / 64) * (3072 / 32),
                  I_UQ = (384 / 64) * (768 / 32), I_UKV = (256 / 64) * (1024 / 32), I_BR = (512 / 64) * (1024 / 32), I_OUT = (DM / 64) * (DM / 32);
    constexpr int NITEMS = 2 * I_W13 + 2 * I_W2 + 2 * I_IN + I_UQ + I_UKV + 3 * I_BR + I_OUT, OFF_W2B = 2 * I_W13 + I_W2;
    int lane = lane_id(); asm volatile("" : "+v"(lane));
    LAS float* scr0 = (LAS float*)(lds + wave * 17408); LAS float* scr1 = scr0 + 64 * 33 + 32;
    unsigned char* ws = a.ws; asm volatile("" : "+s"(ws));
    const int limit = mask == 0 ? NITEMS : mask == 1 ? NITEMS - I_W2 : I_W2;
#define CV_MAP(i_) (mask == 0 ? (i_) : mask == 1 ? ((i_) >= OFF_W2B ? (i_) + I_W2 : (i_)) : OFF_W2B + (i_))
    for (int it = gw; it < limit; it += 2 * NGW) {
        TrDesc d0, d1; f32x4 v0[8], v1[8];
        if (!tr_decode(a, l, ws, CV_MAP(it), d0)) break;
        const bool has1 = (it + NGW < limit) && tr_decode(a, l, ws, CV_MAP(it + NGW), d1);
        const bool vec0 = tr_load(d0, lane, v0);
        bool vec1 = false; if (has1) vec1 = tr_load(d1, lane, v1);
        tr_finish(d0, vec0, lane, v0, scr0);
        if (has1) tr_finish(d1, vec1, lane, v1, scr1);
    }
#undef CV_MAP
}

#define XB_TMO      128
#define XB_XCNT(j)  (256  + 64 * (j))
#define XB_XSUB(j)  (1280 + 64 * (j))
#define XB_XGEN(j)  (2304 + 64 * (j))
#define XB_TOP      3328
#define XB_TOPGEN   3392
#define XCD_BAR_WORDS 3456
#define XB_SPIN_CAP (1u << 18)

__device__ __forceinline__ unsigned xb_ld(unsigned* p)              { return __hip_atomic_load(p, __ATOMIC_RELAXED, __HIP_MEMORY_SCOPE_AGENT); }
__device__ __forceinline__ unsigned xb_add(unsigned* p, unsigned v) { return __hip_atomic_fetch_add(p, v, __ATOMIC_RELAXED, __HIP_MEMORY_SCOPE_AGENT); }
__device__ __forceinline__ unsigned xb_xcc_id() { return (unsigned)__builtin_amdgcn_s_getreg((3 << 11) | 20) & 0xFu; }
#define XB_SPIN(cond, bar) do { unsigned _sp = 0; while (cond) { __builtin_amdgcn_s_sleep(1); \
    if ((++_sp & 255u) == 0u) { if (xb_ld(&(bar)[XB_TMO])) break; if (_sp > XB_SPIN_CAP) { atomicAdd(&(bar)[XB_TMO], 1u); break; } } } } while (0)

struct XcdBarrier {
    unsigned* bar; unsigned x;
    volatile LAS unsigned* st;
};

__device__ __forceinline__ XcdBarrier xcd_barrier_post(unsigned* bar, volatile LAS unsigned* st) {
    XcdBarrier b; b.bar = bar; b.x = xb_xcc_id(); b.st = st;
    if (threadIdx.x == 0) (void)xb_add(&bar[XB_XCNT(b.x)], 1u);
    return b;
}
__device__ __forceinline__ void xcd_barrier_complete(unsigned* bar, unsigned x, unsigned& nloc, unsigned& nx) {
    const unsigned G = gridDim.x * gridDim.y * gridDim.z;
    unsigned sum, cnt, mine, sp = 0u;
    for (;;) {
        sum = 0u; cnt = 0u; mine = 0u;
#pragma unroll
        for (unsigned j = 0; j < 16; ++j) { const unsigned c = xb_ld(&bar[XB_XCNT(j)]); sum += c; cnt += (c > 0u) ? 1u : 0u; mine = (j == x) ? c : mine; }
        if (sum == G) break;
        __builtin_amdgcn_s_sleep(1);
        if ((++sp & 255u) == 0u) { if (xb_ld(&bar[XB_TMO])) break; if (sp > XB_SPIN_CAP) { atomicAdd(&bar[XB_TMO], 1u); break; } }
    }
    nloc = mine > 0u ? mine : 1u; nx = cnt > 0u ? cnt : 1u;
}

__device__ __forceinline__ void xcd_barrier(const XcdBarrier& b0_) {
    XcdBarrier b; b.bar = b0_.bar; b.st = b0_.st; b.x = xb_xcc_id(); { unsigned* bb = b.bar; asm volatile("" : "+s"(bb)); b.bar = bb; }
    asm volatile("s_waitcnt vmcnt(0)" ::: "memory");
    __syncthreads();
    if (threadIdx.x == 0) {
        unsigned* bar = b.bar;
        __builtin_amdgcn_s_waitcnt(0);
        unsigned nloc = b.st[0], nx = b.st[1];
        if (nloc == 0u) { xcd_barrier_complete(bar, b.x, nloc, nx); b.st[0] = nloc; b.st[1] = nx; }
        const unsigned old = xb_add(&bar[XB_XSUB(b.x)], 1u);
        const unsigned gen = old / nloc;
        if (old + 1u == (gen + 1u) * nloc) {
            __builtin_amdgcn_fence(__ATOMIC_RELEASE, "agent");
            asm volatile("s_waitcnt vmcnt(0)" ::: "memory");
            const unsigned og = xb_add(&bar[XB_TOP], 1u);
            const unsigned tg = og / nx;
            if (og + 1u == (tg + 1u) * nx) xb_add(&bar[XB_TOPGEN], 1u);
            else XB_SPIN(xb_ld(&bar[XB_TOPGEN]) == tg, bar);
            __builtin_amdgcn_fence(__ATOMIC_ACQUIRE, "agent");
            xb_add(&bar[XB_XGEN(b.x)], 1u);
            asm volatile("s_waitcnt vmcnt(0)" ::: "memory");
        } else {
            XB_SPIN(xb_ld(&bar[XB_XGEN(b.x)]) == gen, bar);
            __builtin_amdgcn_fence(__ATOMIC_ACQUIRE, "agent");
            asm volatile("s_waitcnt vmcnt(0)" ::: "memory");
        }
    }
    __syncthreads();
}


__global__ void __launch_bounds__(512) fwd_megakernel(Args a) {
    extern __shared__ __attribute__((aligned(16))) unsigned char lds_raw[];
    LAS unsigned char* lds = (LAS unsigned char*)lds_raw;
    cg::grid_group grid = cg::this_grid();
#define GSYNC() xcd_barrier(xbar)
    const int wave = __builtin_amdgcn_readfirstlane(threadIdx.x >> 6);
    const int G = gridDim.x, bx = blockIdx.x;
    volatile LAS unsigned* xst = (volatile LAS unsigned*)(lds + LDS_BYTES - 64);
    if (threadIdx.x < 2) xst[threadIdx.x] = 0u;
    __syncthreads();
    grid.sync();
    XcdBarrier xbar = xcd_barrier_post((unsigned*)(a.ws + WS_BAR), xst);
    const int vcu = (G % 8 == 0) ? (bx % 8) * (G / 8) + bx / 8 : bx;
    const int gw = vcu * 8 + wave, NGW = G * 8;
    unsigned char* ws = a.ws;
    float* X = a.out;
    bf16_t* XB = (bf16_t*)(ws + WS_XB); float* SSQ = (float*)(ws + WS_SSQ); float* SSQZ = (float*)(ws + WS_SSQZ);
    float* ROPEC = (float*)(ws + WS_ROPE); float* ROPES = ROPEC + SEQ * 32;
    bf16_t* Z = (bf16_t*)(ws + WS_R0); bf16_t* H = (bf16_t*)(ws + WS_R0); float* MG = (float*)(ws + WS_R0); bf16_t* MB = (bf16_t*)(ws + WS_R0 + 64 * MiB);
    bf16_t* GT = (bf16_t*)(ws + WS_G); bf16_t* QC = (bf16_t*)(ws + WS_QC); bf16_t* KC = (bf16_t*)(ws + WS_KC); bf16_t* VC = (bf16_t*)(ws + WS_VC);
    bf16_t* O3 = (bf16_t*)(ws + WS_O3); float* SCR = (float*)(ws + WS_SCR) + (size_t)bx * (512 * 64);

    {
        const float* xin = a.in[I_X]; const int lane = lane_id();
        for (int m = gw; m < M_TOK; m += NGW) {
            const f32x4* xr = (const f32x4*)(xin + (size_t)m * DM) + lane; u32x2* bo = (u32x2*)(XB + (size_t)m * DM) + lane;
            float s = 0.f;
#pragma unroll
            for (int j = 0; j < 4; ++j) { const f32x4 v = xr[64 * j]; s += dot4(v); u32x2 w; w.x = cvt_pk_bf16(v[0], v[1]); w.y = cvt_pk_bf16(v[2], v[3]); bo[64 * j] = w; }
            s = wave_sum(s);
            if (lane < 16) SSQ[(size_t)m * 16 + lane] = lane == 0 ? s : 0.f;
        }
        for (int i = gw * 64 + lane; i < SEQ * 32; i += NGW * 64) {
            const int pos = i >> 5, j = i & 31;
            const float inv_freq = (float)exp2(-(double)(2 * j) / 64.0 * 13.287712379549449);
            const float ang = (float)pos * inv_freq;
            const double rev = (double)ang * 0.15915494309189535; const float f = (float)(rev - floor(rev));
            ROPEC[i] = __builtin_amdgcn_cosf(f); ROPES[i] = __builtin_amdgcn_sinf(f);
        }
#ifndef NO_CONV
        convert_layer(a, 0, lds, gw, NGW, wave);
#endif
    }
    GSYNC();

    for (int l = 0; l < DEPTH; ++l) {
        for (int half = 0; half < 2; ++half) {
#ifndef NO_FFNUP
            { pg8::Gemm g{XB, (const bf16_t*)(ws + (half ? WS_W13B : WS_W13A)), M_TOK, 2 * FF, DM, DM, 31, 0}; pg8::StaticOrder S; S.init(M_TOK, 2 * FF, G, bx);
              EpiSwiGLU E{H, SSQ}; pg8::gemm_phase(lds, g, S, E, wave); }
#endif
            GSYNC();
#ifndef NO_FFNDN
            { pg8::Gemm g{H, (const bf16_t*)(ws + (half ? WS_W2B : WS_W2A)), M_TOK, DM, FF, FF, 31, 0}; pg8::StaticOrder S; S.init(M_TOK, DM, G, bx);
              EpiResid E{(l == 0 && half == 0) ? a.in[I_X] : (const float*)X, X, XB, SSQ, 0.5f};   pg8::gemm_phase(lds, g, S, E, wave); }
#endif
            if (half == 1) { if (l + 1 < DEPTH) convert_layer(a, l + 1, lds, gw, NGW, wave, 1); }
            else if (l > 0) convert_layer(a, l, lds, gw, NGW, wave, 2);
            GSYNC();
            if (half == 1) break;
#ifndef NO_INPROJ
            { pg8::Gemm g{XB, (const bf16_t*)(ws + WS_WIG), M_TOK, 6144, DM, DM, 31, 0}; pg8::StaticOrder S; S.init(M_TOK, 6144, G, bx);
              EpiInProj E{Z, GT, KC, SSQ, SSQZ, a.in[I_BGATE] + l * 3072, ROPEC, ROPES}; pg8::gemm_phase(lds, g, S, E, wave); }
#endif
            GSYNC();
#ifndef NO_UQ
            { pg8::Gemm g{Z + Z_CQ, (const bf16_t*)(ws + WS_WUQ), M_TOK, 768, 384, ZC, 31, 0}; pg8::StaticOrder S; S.init(M_TOK, 768, G, bx);
              EpiUQ E{QC, SSQZ, ROPEC, ROPES}; pg8::gemm_phase(lds, g, S, E, wave); }
#endif
#ifndef NO_UKV
            { pg8::Gemm g{Z + Z_CKV, (const bf16_t*)(ws + WS_WUKV), M_TOK, 1024, 256, ZC, 31, 0}; pg8::StaticOrder S; S.init(M_TOK, 1024, G, G - 1 - bx);
              EpiUKV E{KC, VC, SSQZ}; pg8::gemm_phase(lds, g, S, E, wave); }
#endif
            { unsigned* NRM = (unsigned*)(ws + WS_BAR + 32768) + l * 32; const int lane = lane_id(); float mx0 = 0.f, mx1 = 0.f;
              for (int m = gw; m < M_TOK; m += NGW) { const u32x4* zp = (const u32x4*)(Z + (size_t)m * ZC + lane * 16); const u32x4 w0 = zp[0], w1 = zp[1]; float sq = 0.f;
#pragma unroll
                  for (int i = 0; i < 4; ++i) { const float a0 = bf16_lo(w0[i]), a1 = bf16_hi(w0[i]), b0 = bf16_lo(w1[i]), b1 = bf16_hi(w1[i]); sq += (a0 * a0 + a1 * a1) + (b0 * b0 + b1 * b1); }
                  sq += shfl_xor_f(sq, 1); sq += shfl_xor_f(sq, 2);
                  if (m < SEQ) mx0 = fmaxf(mx0, sq); else mx1 = fmaxf(mx1, sq); }
              if ((lane & 3) == 0) { __hip_atomic_fetch_max(NRM + (lane >> 2), __float_as_uint(mx0), __ATOMIC_RELAXED, __HIP_MEMORY_SCOPE_AGENT);
                                     __hip_atomic_fetch_max(NRM + 16 + (lane >> 2), __float_as_uint(mx1), __ATOMIC_RELAXED, __HIP_MEMORY_SCOPE_AGENT); } }
            GSYNC();
            {
                LAS char* al = (LAS char*)lds;
                const int nslot = (G == 256) ? 6 : (1024 + G - 1) / G;
                for (int k_ = 0; k_ < nslot; ++k_) {
                    int L;
                    if (G == 256) {
                        if (vcu < 128) L = k_ < 2 ? 2 * vcu + k_ : k_ < 4 ? 512 + 2 * vcu + (k_ - 2) : (k_ == 4 && (vcu & 1)) ? 512 + 256 + (vcu >> 1) : -1;
                        else { const int u = (vcu - 128) & 63, hi_ = vcu >= 192, hh = k_ == 0 ? (hi_ ? 2 : 3) : (hi_ ? 1 : 0);
                               L = k_ < 2 ? 256 + (((u >> 5) * 4 + hh) << 5) + (u & 31) : hi_ ? (k_ < 4 ? 512 + 384 + 2 * u + (k_ - 2) : -1) : (k_ == 2 ? 512 + 320 + u : -1); }
                    } else { L = vcu + k_ * G; if (L >= 1024) L = -1; }
                    if (L < 0) continue;
                    if (L < 256) {
#ifndef NO_C
                        const int bh = L >> 5, qb = L & 31, b = bh >> 2, h = bh & 3; const size_t r0 = (size_t)b * SEQ + qb * 256;
                        att::EpiStoreBf16<4> E{O3 + r0 * 1536 + 1024 + h * 128, 1536};
                        att::attn_body_simple<192, 128, 0, 768, 768, 512>(QC + r0 * 768 + h * 192, KC + (size_t)b * SEQ * 768 + h * 192, VC + (size_t)b * SEQ * 512 + h * 128,
                                                                     0, SEQ / 64, qb * 256, 0.07216878364870322f, 0.f, 0.f, al, E, wave);
#endif
                    } else if (L < 512) {
#ifndef NO_A
                        const int u = L - 256, bh = u >> 5, qb = u & 31, b = bh >> 2, h = bh & 3; const size_t r0 = (size_t)b * SEQ + qb * 256;
                        int li = l; asm volatile("" : "+s"(li));
                        const float lam_init = __uint_as_float(li == 0 ? 0x3e4ccccdu : li == 1 ? 0x3eb60549u : li == 2 ? 0x3ef1014cu : 0x3f0e59d5u);
                        const float* lp = a.in[I_ALAM] + l * 256; const int lane = lane_id();
                        const float s01 = wave_sum(lp[lane] * lp[64 + lane]), s23 = wave_sum(lp[128 + lane] * lp[192 + lane]);
                        const float lam = uni(expf(s01) - expf(s23) + lam_init);
                        const float slope = uni(exp2f(-2.f * (float)(h + 1)));
                        const bf16_t* zb = Z + (size_t)b * SEQ * ZC;
                        int ks0, nt0, ks1, nt1, sf0 = 0, sf1 = 0;
                        { const unsigned* NRM = (const unsigned*)(ws + WS_BAR + 32768) + l * 32 + b * 16;
#pragma unroll
                          for (int mp = 0; mp < 2; ++mp) {
                              const float q2 = __uint_as_float(__hip_atomic_load(NRM + h * 2 + mp, __ATOMIC_RELAXED, __HIP_MEMORY_SCOPE_AGENT)), k2 = __uint_as_float(__hip_atomic_load(NRM + 8 + h * 2 + mp, __ATOMIC_RELAXED, __HIP_MEMORY_SCOPE_AGENT));
                              const float dmax = uni((2.f * 0.125f * sqrtf(q2 * k2) * 1.01f + 32.f) / slope);
                              const float lo_f = (float)(qb * 256) - dmax, hi_f = (float)(qb * 256 + 256) + dmax;
                              const int lo_i = lo_f <= 0.f ? 0 : ((int)lo_f >> 7) << 7; const int hi_i = hi_f >= (float)SEQ ? SEQ : ((((int)hi_f + 127) >> 7) << 7);
                              const int hi_c = hi_i > SEQ ? SEQ : hi_i;
                              const int sf = (2.f * 0.125f * sqrtf(q2 * k2) * 1.01f + 8.f) < 70.f;
                              if (mp == 0) { ks0 = lo_i; nt0 = (hi_c - lo_i) >> 6; sf0 = sf; } else { ks1 = lo_i; nt1 = (hi_c - lo_i) >> 6; sf1 = sf; } } }
                        { att::EpiDiff0 E{SCR};
                          ATT_A_BODY(Z + r0 * ZC + Z_AQ + h * 128, zb + Z_AK + h * 128, zb + Z_AV + h * 128, ks0, nt0, qb * 256, 0.125f, slope, 0.f, al, E, wave, sf0); }
                        { att::EpiDiff1 E{SCR, O3 + r0 * 1536 + h * 128, 1536, a.in[I_ASUB] + l * 128, lam, 1.f - lam_init};
                          ATT_A_BODY(Z + r0 * ZC + Z_AQ + h * 128 + 64, zb + Z_AK + h * 128 + 64, zb + Z_AV + h * 128, ks1, nt1, qb * 256, 0.125f, slope, 0.f, al, E, wave, sf1); }
#endif
                    } else {
#ifndef NO_B
                        const int u = L - 512, bh = u >> 5, qb = u & 31, b = bh >> 3, hq = bh & 7; const size_t r0 = (size_t)b * SEQ + qb * 256;
                        const int ks = qb * 256 - 128 < 0 ? 0 : qb * 256 - 128, ke = qb * 256 + 384 > SEQ ? SEQ : qb * 256 + 384;
                        const float slope = uni(exp2f(-(float)(hq + 1))); const float sink = uni(a.in[I_BSINK][l * 8 + hq]);
                        const bf16_t* zb = Z + (size_t)b * SEQ * ZC;
                        att::EpiStoreBf16<2> E{O3 + r0 * 1536 + 512 + hq * 64, 1536};
                        att::attn_body<64, 64, 2, 2, ZC, ZC, ZC>(Z + r0 * ZC + Z_BQ + hq * 64, zb + Z_BK + (hq >> 2) * 64, zb + Z_BV + (hq >> 2) * 64, ks, (ke - ks) / 64, qb * 256, 0.125f, slope, sink * LOG2E, al, E, wave);
#endif
                    }
                }
                __syncthreads();
            }
            GSYNC();
#ifndef NO_BR
            { pg8::Gemm g{O3, (const bf16_t*)(ws + WS_WB), M_TOK, 3072, 512, 1536, 2, 1024}; pg8::BranchOrder S; S.init(G, bx);
              EpiGateAcc E{GT, MG, MB}; pg8::gemm_phase(lds, g, S, E, wave); }
#endif
            GSYNC();
#ifndef NO_WOUT
            { pg8::Gemm g{MB, (const bf16_t*)(ws + WS_WO), M_TOK, DM, DM, DM, 31, 0}; pg8::StaticOrder S; S.init(M_TOK, DM, G, bx);
              EpiResid E{X, X, XB, SSQ, 1.0f}; pg8::gemm_phase(lds, g, S, E, wave); }
#endif
            GSYNC();
        }
    }
    {
        const float* fg = a.in[I_FINN]; const int lane = lane_id();
        for (int m = gw; m < M_TOK; m += NGW) {
            const float r = rinv_sum(SSQ + (size_t)m * 16, 4, 1.f / DM);
            f32x4* xo = (f32x4*)(X + (size_t)m * DM) + lane; const f32x4* gp = (const f32x4*)fg + lane;
#pragma unroll
            for (int j = 0; j < 4; ++j) { f32x4 v = xo[64 * j]; v = v * r * gp[64 * j]; xo[64 * j] = v; }
        }
    }
}

extern "C" void kernel_launch(void* const* d_in, const int* in_sizes, int n_in, void* d_out, int out_size, void* d_ws, size_t ws_size, hipStream_t stream) {
    static int grid = 0;
    if (grid == 0) {
        if (n_in != 21 || in_sizes[0] != M_TOK * DM || out_size != M_TOK * DM || ws_size < WS_END) {
            fprintf(stderr, "kernel_launch: shape/workspace mismatch (n_in %d, in0 %d, out %d, ws %zu, need %zu)\n", n_in, n_in > 0 ? in_sizes[0] : -1, out_size, ws_size, (size_t)WS_END); grid = -1; return; }
        int dev = 0, cus = 0, per_cu = 0;
        hipGetDevice(&dev); hipDeviceGetAttribute(&cus, hipDeviceAttributeMultiprocessorCount, dev);
        if (hipFuncSetAttribute((const void*)fwd_megakernel, hipFuncAttributeMaxDynamicSharedMemorySize, LDS_BYTES) != hipSuccess) { fprintf(stderr, "kernel_launch: hipFuncSetAttribute failed\n"); grid = -1; return; }
        if (hipOccupancyMaxActiveBlocksPerMultiprocessor(&per_cu, (const void*)fwd_megakernel, 512, LDS_BYTES) != hipSuccess || per_cu < 1) { fprintf(stderr, "kernel_launch: occupancy query failed (%d)\n", per_cu); per_cu = 1; }
        (void)hipGetLastError();
        grid = cus;
    }
    if (grid < 0) return;
    if (hipMemsetAsync((char*)d_ws + WS_BAR, 0, BAR_BYTES, stream) != hipSuccess) { fprintf(stderr, "kernel_launch: memset failed\n"); return; }
    Args a{};
    for (int i = 0; i < 21; ++i) a.in[i] = (const float*)d_in[i];
    a.out = (float*)d_out; a.ws = (unsigned char*)d_ws; a.ph_lo = 0; a.ph_hi = 0;
    void* args[] = {&a};
    hipError_t e = hipLaunchCooperativeKernel((const void*)fwd_megakernel, dim3(grid), dim3(512), args, LDS_BYTES, stream);
    if (e != hipSuccess) fprintf(stderr, "cooperative launch failed: %s (grid %d)\n", hipGetErrorString(e), grid);
}
```

```cpp
#include <hip/hip_runtime.h>
#include <hip/hip_cooperative_groups.h>
#include <cstdio>
#include <cstdint>
namespace cg = cooperative_groups;

#define LAS __attribute__((address_space(3)))
#define GAS __attribute__((address_space(1)))
typedef unsigned short bf16_t;
typedef short bf16x8 __attribute__((ext_vector_type(8)));
typedef short s16x4 __attribute__((ext_vector_type(4)));
typedef float f32x4 __attribute__((ext_vector_type(4)));
typedef float f32x16 __attribute__((ext_vector_type(16)));
typedef unsigned u32x4 __attribute__((ext_vector_type(4)));
typedef unsigned u32x2 __attribute__((ext_vector_type(2)));

constexpr int M_TOK = 16384, SEQ = 8192, DM = 1024, FF = 2816, DEPTH = 4;
constexpr int ZC = 3072;
constexpr int Z_AQ = 0, Z_AK = 512, Z_AV = 1024, Z_BQ = 1536, Z_BK = 2048, Z_BV = 2176, Z_CQ = 2304, Z_CKV = 2688, Z_CKR = 2944;
constexpr float EPS = 1e-6f;
constexpr float LOG2E = 1.4426950408889634f;

constexpr size_t MiB = 1u << 20;
constexpr size_t WS_W13A = 0, WS_W2A = 11 * MiB, WS_W13B = 33 * MiB / 2, WS_W2B = 55 * MiB / 2, WS_WIG = 33 * MiB, WS_WUQ = 45 * MiB,
                 WS_WUKV = 46 * MiB, WS_WB = 47 * MiB, WS_WO = 50 * MiB;
constexpr size_t WS_BAR = 54 * MiB, BAR_BYTES = 65536;
constexpr size_t WS_XB = 56 * MiB, WS_SSQ = 88 * MiB, WS_SSQZ = 89 * MiB, WS_ROPE = 91 * MiB;
constexpr size_t WS_R0 = 96 * MiB;
constexpr size_t WS_G = 192 * MiB, WS_QC = 288 * MiB, WS_KC = 312 * MiB, WS_VC = 336 * MiB, WS_O3 = 352 * MiB, WS_SCR = 400 * MiB, WS_END = 432 * MiB;

typedef float f32x2_t __attribute__((ext_vector_type(2)));
typedef __bf16 bf16x2_t __attribute__((ext_vector_type(2)));
__device__ __forceinline__ unsigned cvt_pk_bf16(float lo, float hi) { f32x2_t v = {lo, hi}; bf16x2_t b = __builtin_convertvector(v, bf16x2_t); return __builtin_bit_cast(unsigned, b); }
__device__ __forceinline__ int lane_id() { int r; asm volatile("v_mbcnt_lo_u32_b32 %0, -1, 0\n\tv_mbcnt_hi_u32_b32 %0, -1, %0" : "=v"(r)); return r; }
__device__ __forceinline__ float uni(float x) { return __int_as_float(__builtin_amdgcn_readfirstlane(__float_as_int(x))); }
__device__ __forceinline__ float shfl_xor_f(float v, int m) { return __int_as_float(__builtin_amdgcn_ds_bpermute((lane_id() ^ m) << 2, __float_as_int(v))); }
__device__ __forceinline__ float bf16_lo(unsigned w) { return __uint_as_float(w << 16); }
__device__ __forceinline__ float bf16_hi(unsigned w) { return __uint_as_float(w & 0xffff0000u); }
__device__ __forceinline__ float fast_rsq(float x) { return __builtin_amdgcn_rsqf(x); }
__device__ __forceinline__ float sum4(f32x4 a) { return (a.x + a.y) + (a.z + a.w); }
__device__ __forceinline__ float dot4(f32x4 a) { return (a.x * a.x + a.y * a.y) + (a.z * a.z + a.w * a.w); }

namespace pg8 {
constexpr int BM = 256, BK = 64, HALF = 128, HTB = HALF * BK * 2, STAGE_BYTES = 8 * HTB, NXCD = 8, WGM = 8;
__host__ __device__ __forceinline__ int lds_byte(int r, int c) { const int st = (r >> 4) * 2 + (c >> 5), rr = r & 15, cc = c & 31, ob = rr * 64 + cc * 2; return st * 1024 + (ob ^ (((ob >> 9) & 1) << 5)); }
__host__ __device__ __forceinline__ void stage_rc(int b, int& R, int& C) { const int st = b / 1024, sb = b % 1024, swz = sb ^ (((sb >> 9) & 1) << 5); R = (st >> 1) * 16 + swz / 64; C = (st & 1) * 32 + (swz % 64) / 2; }
__host__ __device__ __forceinline__ int perm32(int rho) { const int n = rho >> 4, i = rho & 15; return 8 * (i >> 2) + 4 * n + (i & 3); }

struct Unit { int pm, pn; };
struct Gemm { const bf16_t* A; const bf16_t* Bt; int M, N, K, lda, a_pn_shift, a_pn_stride; };

struct StaticOrder {
    int nM, nN, nwg, G, c;
    __device__ void init(int M, int N, int G_, int c_) { nM = M / BM; nN = N / BM; nwg = nM * nN; G = G_; c = c_; }
    __device__ bool next(int i, Unit& u) const {
        const long L = (long)i * G + c; if (L >= nwg) return false;
        int wgid = (int)L; { const int q = nwg / NXCD, r = nwg % NXCD, xcd = wgid % NXCD, off = wgid / NXCD; wgid = (xcd < r ? xcd * (q + 1) : r * (q + 1) + (xcd - r) * q) + off; }
        const int nig = WGM * nN, gid = wgid / nig, fm = gid * WGM, gsz = (nM - fm) < WGM ? (nM - fm) : WGM;
        u.pm = fm + ((wgid % nig) % gsz); u.pn = (wgid % nig) / gsz; return true;
    }
};
struct BranchOrder {
    StaticOrder so;
    __device__ void init(int G_, int c_) { so.init(M_TOK, DM, G_, c_); }
    __device__ bool next(int i, Unit& u) const { const int j = i / 3, n = i - 3 * j; Unit b; if (!so.next(j, b)) return false; u.pm = b.pm; u.pn = n * 4 + b.pn; return true; }
};

template <class Epi, class Sched>
__device__ __forceinline__ void gemm_phase(LAS unsigned char* lds, const Gemm g, const Sched& S, const Epi& E, int wave_) {
    int tid = wave_ * 64 + lane_id(); asm volatile("" : "+v"(tid));
    const int wid = __builtin_amdgcn_readfirstlane(tid >> 6), lane = tid & 63, wr = wid >> 2, wc = wid & 3, fr = lane & 15, fq = lane >> 4;
    const int K = g.K, nt = K / BK, lda = g.lda;
    const bf16_t* gA = g.A; const bf16_t* gB = g.Bt; asm volatile("" : "+s"(gA), "+s"(gB));
    unsigned voffA[2], voffB[2];
#pragma unroll
    for (int i = 0; i < 2; ++i) { int R, C; stage_rc(tid * 16 + i * 8192, R, C); const int Rb = Epi::PERM ? ((R & ~31) + perm32(R & 31)) : R;
        voffA[i] = (unsigned)(R * lda + C) * 2u; voffB[i] = (unsigned)(Rb * K + C) * 2u; }
    const size_t kstep = (size_t)(BK * 2);
    const size_t hstepA = (size_t)HALF * lda * 2, hstepB = (size_t)HALF * K * 2;
    const size_t tstepA = 2 * hstepA, tstepB = 2 * hstepB;
    const unsigned ldsw = (unsigned)wid * 1024u;
    const int aoff = lds_byte(wr * 64 + fr, fq * 8), boff = lds_byte(wc * 32 + fr, fq * 8);
#define PG8_SA(b, h) (((b) * 2 + (h)) * HTB)
#define PG8_SB(b, h) ((4 + (b) * 2 + (h)) * HTB)
#define PG8_STAGE(bufoff, gbase, voff) do { _Pragma("unroll") for (int _i = 0; _i < 2; ++_i) \
        __builtin_amdgcn_global_load_lds((const unsigned*)((const char*)(gbase) + (voff)[_i]), (LAS unsigned*)(lds + (bufoff) + ldsw + _i * 8192), 16, 0, 0); } while (0)
#define PG8_LDA(dst, b, h) do { _Pragma("unroll") for (int m = 0; m < 4; ++m) _Pragma("unroll") for (int k = 0; k < 2; ++k) dst[m][k] = *(const LAS bf16x8*)(lds + PG8_SA(b, h) + aoff + m * 2048 + k * 1024); } while (0)
#define PG8_LDB(dst, b, h) do { _Pragma("unroll") for (int n = 0; n < 2; ++n) _Pragma("unroll") for (int k = 0; k < 2; ++k) dst[n][k] = *(const LAS bf16x8*)(lds + PG8_SB(b, h) + boff + n * 2048 + k * 1024); } while (0)
#define PG8_MMA(ai, bj, At, Bt) do { __builtin_amdgcn_s_setprio(1); _Pragma("unroll") for (int m = 0; m < 4; ++m) _Pragma("unroll") for (int n = 0; n < 2; ++n) _Pragma("unroll") for (int k = 0; k < 2; ++k) \
        acc[ai][bj][m][n] = __builtin_amdgcn_mfma_f32_16x16x32_bf16(Bt[n][k], At[m][k], acc[ai][bj][m][n], 0, 0, 0); __builtin_amdgcn_s_setprio(0); } while (0)
#define PG8_WAIT_V(n) asm volatile("s_waitcnt vmcnt(" #n ")" ::: "memory")
#define PG8_WAIT_L(n) asm volatile("s_waitcnt lgkmcnt(" #n ")" ::: "memory")
#define PG8_BAR __builtin_amdgcn_s_barrier()
#define PG8_SCHED __builtin_amdgcn_sched_barrier(0)
#define PG8_APTR(u) ((const char*)gA + (size_t)(u).pm * tstepA + (size_t)((u).pn >> g.a_pn_shift) * (size_t)g.a_pn_stride)
    Unit cur, nxt; int ui = 0;
    if (!S.next(0, cur)) return;
    f32x4 acc[2][2][4][2];
#pragma unroll
    for (int a = 0; a < 2; ++a)
#pragma unroll
        for (int b = 0; b < 2; ++b)
#pragma unroll
            for (int m = 0; m < 4; ++m)
#pragma unroll
                for (int n = 0; n < 2; ++n) acc[a][b][m][n] = (f32x4){0.f, 0.f, 0.f, 0.f};
    bf16x8 At[4][2], B0[2][2], B1[2][2];
    const char* cA = PG8_APTR(cur); const char* cB = (const char*)gB + (size_t)cur.pn * tstepB;
    PG8_STAGE(PG8_SB(0, 0), cB, voffB); PG8_STAGE(PG8_SB(0, 1), cB + hstepB, voffB); PG8_STAGE(PG8_SA(0, 0), cA, voffA); PG8_STAGE(PG8_SA(0, 1), cA + hstepA, voffA);
    if (wr == 1) PG8_BAR;
    PG8_WAIT_V(2); PG8_BAR;
    PG8_STAGE(PG8_SB(1, 0), cB + kstep, voffB); PG8_STAGE(PG8_SA(1, 0), cA + kstep, voffA); PG8_STAGE(PG8_SB(1, 1), cB + hstepB + kstep, voffB);
    PG8_WAIT_V(6); PG8_BAR;
    for (;;) {
        const bool has_next = S.next(ui + 1, nxt);
        const char* nA = has_next ? PG8_APTR(nxt) : cA; const char* nB = has_next ? (const char*)gB + (size_t)nxt.pn * tstepB : cB;
        for (int t = 0; t < nt; t += 2) {
            const bool last = (t == nt - 2);
            const char* a1 = cA + (size_t)(t + 1) * kstep;
            const char* a2 = last ? nA : cA + (size_t)(t + 2) * kstep; const char* b2 = last ? nB : cB + (size_t)(t + 2) * kstep;
            const char* a3 = a2 + kstep; const char* b3 = b2 + kstep;
            PG8_LDB(B0, 0, 0); PG8_LDB(B1, 0, 1); PG8_SCHED; PG8_LDA(At, 0, 0); PG8_STAGE(PG8_SA(1, 1), a1 + hstepA, voffA);
            PG8_WAIT_V(8); PG8_WAIT_L(0); PG8_BAR; PG8_MMA(0, 0, At, B0); PG8_MMA(0, 1, At, B1); PG8_BAR; PG8_SCHED;
            PG8_LDA(At, 0, 1); PG8_STAGE(PG8_SB(0, 0), b2, voffB); PG8_STAGE(PG8_SB(0, 1), b2 + hstepB, voffB); PG8_STAGE(PG8_SA(0, 0), a2, voffA);
            PG8_WAIT_V(8); PG8_WAIT_L(0); PG8_BAR; PG8_MMA(1, 0, At, B0); PG8_MMA(1, 1, At, B1); PG8_BAR; PG8_SCHED;
            PG8_LDB(B0, 1, 0); PG8_LDB(B1, 1, 1); PG8_SCHED; PG8_LDA(At, 1, 0); PG8_STAGE(PG8_SA(0, 1), a2 + hstepA, voffA);
            PG8_WAIT_V(8); PG8_WAIT_L(0); PG8_BAR; PG8_MMA(0, 0, At, B0); PG8_MMA(0, 1, At, B1); PG8_BAR; PG8_SCHED;
            PG8_LDA(At, 1, 1); PG8_STAGE(PG8_SB(1, 0), b3, voffB); PG8_STAGE(PG8_SB(1, 1), b3 + hstepB, voffB); PG8_STAGE(PG8_SA(1, 0), a3, voffA);
            PG8_WAIT_V(8); PG8_WAIT_L(0); PG8_BAR; PG8_MMA(1, 0, At, B0); PG8_MMA(1, 1, At, B1); PG8_BAR; PG8_SCHED;
        }
        if (wr == 0) PG8_BAR;
        E(acc, cur, wr, wc, fr, fq);
        if (!has_next) break;
#pragma unroll
        for (int a = 0; a < 2; ++a)
#pragma unroll
            for (int b = 0; b < 2; ++b)
#pragma unroll
                for (int m = 0; m < 4; ++m)
#pragma unroll
                    for (int n = 0; n < 2; ++n) acc[a][b][m][n] = (f32x4){0.f, 0.f, 0.f, 0.f};
        cur = nxt; cA = nA; cB = nB; ++ui;
        if (wr == 1) PG8_BAR;
    }
    PG8_WAIT_V(0);
    PG8_BAR;
#undef PG8_SA
#undef PG8_SB
#undef PG8_STAGE
#undef PG8_LDA
#undef PG8_LDB
#undef PG8_MMA
#undef PG8_WAIT_V
#undef PG8_WAIT_L
#undef PG8_BAR
#undef PG8_SCHED
#undef PG8_APTR
}
}

typedef f32x4 Acc[2][2][4][2];
__device__ __forceinline__ float rinv_sum(const float* p, int n4, float invn) {
    float s = 0.f;
#pragma unroll
    for (int i = 0; i < 5; ++i) if (i < n4) s += sum4(*(const f32x4*)(p + 4 * i));
    return fast_rsq(s * invn + EPS);
}
__device__ __forceinline__ float silu_mul(float a, float g) { return a * __builtin_amdgcn_rcpf(1.f + __builtin_amdgcn_exp2f(-a * LOG2E)) * g; }
__device__ __forceinline__ float sigmoidf(float a) { return __builtin_amdgcn_rcpf(1.f + __builtin_amdgcn_exp2f(-a * LOG2E)); }
__device__ __forceinline__ u32x4 pack8(f32x4 v0, f32x4 v1) { u32x4 w; w.x = cvt_pk_bf16(v0[0], v0[1]); w.y = cvt_pk_bf16(v0[2], v0[3]); w.z = cvt_pk_bf16(v1[0], v1[1]); w.w = cvt_pk_bf16(v1[2], v1[3]); return w; }

struct EpiSwiGLU {
    static constexpr bool PERM = true;
    bf16_t* H; const float* ssq;
    __device__ __forceinline__ void operator()(const Acc& acc, const pg8::Unit& u, int wr, int wc, int fr, int fq) const {
        const int row0 = u.pm * 256 + wr * 64 + fr, col0 = u.pn * 128 + wc * 32 + 8 * fq;
#pragma unroll
        for (int ai = 0; ai < 2; ++ai)
#pragma unroll
            for (int m = 0; m < 4; ++m) { const int row = row0 + ai * 128 + m * 16; const float r = rinv_sum(ssq + (size_t)row * 16, 4, 1.f / DM);
                f32x4 h0, h1;
#pragma unroll
                for (int j = 0; j < 4; ++j) { h0[j] = silu_mul(acc[ai][0][m][0][j] * r, acc[ai][1][m][0][j] * r); h1[j] = silu_mul(acc[ai][0][m][1][j] * r, acc[ai][1][m][1][j] * r); }
                *(u32x4*)(H + (size_t)row * FF + col0) = pack8(h0, h1); asm volatile("" ::: "memory"); }
    }
};
struct EpiResid {
    static constexpr bool PERM = false;
    const float* xin; float* x; bf16_t* xb; float* ssq; float coef;
    __device__ __forceinline__ void operator()(const Acc& acc, const pg8::Unit& u, int wr, int wc, int fr, int fq) const {
        const int row0 = u.pm * 256 + wr * 64 + fr, col0 = u.pn * 256 + wc * 32 + 4 * fq;
#pragma unroll
        for (int ai = 0; ai < 2; ++ai) {
            f32x4 xv[4][2][2];
#pragma unroll
            for (int m = 0; m < 4; ++m)
#pragma unroll
                for (int bj = 0; bj < 2; ++bj)
#pragma unroll
                    for (int n = 0; n < 2; ++n) xv[m][bj][n] = *(const f32x4*)(xin + (size_t)(row0 + ai * 128 + m * 16) * DM + col0 + bj * 128 + n * 16);
#pragma unroll
            for (int m = 0; m < 4; ++m) { const int row = row0 + ai * 128 + m * 16; float s = 0.f;
#pragma unroll
                for (int bj = 0; bj < 2; ++bj)
#pragma unroll
                    for (int n = 0; n < 2; ++n) { const size_t off = (size_t)row * DM + col0 + bj * 128 + n * 16;
                        const f32x4 v = xv[m][bj][n] + acc[ai][bj][m][n] * coef;
                        *(f32x4*)(x + off) = v; s += dot4(v);
                        u32x2 w; w.x = cvt_pk_bf16(v[0], v[1]); w.y = cvt_pk_bf16(v[2], v[3]); *(u32x2*)(xb + off) = w; }
                s += shfl_xor_f(s, 16); s += shfl_xor_f(s, 32);
                if (fq == 0) ssq[(size_t)row * 16 + u.pn * 4 + wc] = s; }
            asm volatile("" ::: "memory"); }
    }
};
struct EpiInProj {
    static constexpr bool PERM = true;
    bf16_t* Z; bf16_t* Gt; bf16_t* KC; const float* ssq; float* ssqz; const float* bgate; const float* ropeC; const float* ropeS;
    __device__ __forceinline__ void operator()(const Acc& acc, const pg8::Unit& u, int wr, int wc, int fr, int fq) const {
        const int row0 = u.pm * 256 + wr * 64 + fr, cw = wc * 32 + 8 * fq;
        if (u.pn < 12) {
#pragma unroll
            for (int ai = 0; ai < 2; ++ai)
#pragma unroll
                for (int m = 0; m < 4; ++m) { const int row = row0 + ai * 128 + m * 16; const float r = rinv_sum(ssq + (size_t)row * 16, 4, 1.f / DM);
#pragma unroll
                    for (int bj = 0; bj < 2; ++bj) { f32x4 v0 = acc[ai][bj][m][0] * r, v1 = acc[ai][bj][m][1] * r;
                        if (u.pn >= 9) { float s = dot4(v0) + dot4(v1); s += shfl_xor_f(s, 16); s += shfl_xor_f(s, 32);
                            if (fq == 0) ssqz[(size_t)row * 24 + (u.pn - 9) * 8 + bj * 4 + wc] = s; }
                        if (u.pn == 11 && bj == 1 && wc < 2) {
                            const int pos = row & (SEQ - 1), j0 = 16 * wc + 4 * fq;
                            const f32x4 c = *(const f32x4*)(ropeC + pos * 32 + j0), s = *(const f32x4*)(ropeS + pos * 32 + j0);
                            f32x4 o0, o1;
                            o0[0] = v0[0] * c[0] - v0[1] * s[0]; o0[1] = v0[0] * s[0] + v0[1] * c[0]; o0[2] = v0[2] * c[1] - v0[3] * s[1]; o0[3] = v0[2] * s[1] + v0[3] * c[1];
                            o1[0] = v1[0] * c[2] - v1[1] * s[2]; o1[1] = v1[0] * s[2] + v1[1] * c[2]; o1[2] = v1[2] * c[3] - v1[3] * s[3]; o1[3] = v1[2] * s[3] + v1[3] * c[3];
                            const u32x4 w = pack8(o0, o1);
#pragma unroll
                            for (int h = 0; h < 4; ++h) *(u32x4*)(KC + (size_t)row * 768 + h * 192 + 128 + cw) = w;
                        }
                        *(u32x4*)(Z + (size_t)row * ZC + u.pn * 256 + bj * 128 + cw) = pack8(v0, v1); } asm volatile("" ::: "memory"); }
        } else {
            const int gc0 = (u.pn - 12) * 256 + cw;
#pragma unroll
            for (int bj = 0; bj < 2; ++bj) { const f32x4 b0 = *(const f32x4*)(bgate + gc0 + bj * 128), b1 = *(const f32x4*)(bgate + gc0 + bj * 128 + 4);
#pragma unroll
                for (int ai = 0; ai < 2; ++ai)
#pragma unroll
                    for (int m = 0; m < 4; ++m) { const int row = row0 + ai * 128 + m * 16; const float r = rinv_sum(ssq + (size_t)row * 16, 4, 1.f / DM);
                        f32x4 v0 = acc[ai][bj][m][0] * r + b0, v1 = acc[ai][bj][m][1] * r + b1;
#pragma unroll
                        for (int j = 0; j < 4; ++j) { v0[j] = sigmoidf(v0[j]); v1[j] = sigmoidf(v1[j]); }
                        *(u32x4*)(Gt + (size_t)row * 3072 + gc0 + bj * 128) = pack8(v0, v1); asm volatile("" ::: "memory"); } }
        }
    }
};
struct EpiUQ {
    static constexpr bool PERM = true;
    bf16_t* QC; const float* ssqz; const float* ropeC; const float* ropeS;
    __device__ __forceinline__ void operator()(const Acc& acc, const pg8::Unit& u, int wr, int wc, int fr, int fq) const {
        const int row0 = u.pm * 256 + wr * 64 + fr;
#pragma unroll
        for (int ai = 0; ai < 2; ++ai)
#pragma unroll
            for (int m = 0; m < 4; ++m) { const int row = row0 + ai * 128 + m * 16; const float r = rinv_sum(ssqz + (size_t)row * 24, 3, 1.f / 384.f);
#pragma unroll
                for (int bj = 0; bj < 2; ++bj) { const int c = u.pn * 256 + bj * 128 + wc * 32 + 8 * fq; const int e = c % 192;
                    f32x4 v0 = acc[ai][bj][m][0] * r, v1 = acc[ai][bj][m][1] * r;
                    if (e >= 128) { const int pos = row & (SEQ - 1), j0 = (e - 128) >> 1;
                        const f32x4 cc = *(const f32x4*)(ropeC + pos * 32 + j0), s = *(const f32x4*)(ropeS + pos * 32 + j0);
                        f32x4 o0, o1;
                        o0[0] = v0[0] * cc[0] - v0[1] * s[0]; o0[1] = v0[0] * s[0] + v0[1] * cc[0]; o0[2] = v0[2] * cc[1] - v0[3] * s[1]; o0[3] = v0[2] * s[1] + v0[3] * cc[1];
                        o1[0] = v1[0] * cc[2] - v1[1] * s[2]; o1[1] = v1[0] * s[2] + v1[1] * cc[2]; o1[2] = v1[2] * cc[3] - v1[3] * s[3]; o1[3] = v1[2] * s[3] + v1[3] * cc[3];
                        v0 = o0; v1 = o1; }
                    *(u32x4*)(QC + (size_t)row * 768 + c) = pack8(v0, v1); } asm volatile("" ::: "memory"); }
    }
};
struct EpiUKV {
    static constexpr bool PERM = true;
    bf16_t* KC; bf16_t* VC; const float* ssqz;
    __device__ __forceinline__ void operator()(const Acc& acc, const pg8::Unit& u, int wr, int wc, int fr, int fq) const {
        const int row0 = u.pm * 256 + wr * 64 + fr, cw = wc * 32 + 8 * fq, h = u.pn;
#pragma unroll
        for (int ai = 0; ai < 2; ++ai)
#pragma unroll
            for (int m = 0; m < 4; ++m) { const int row = row0 + ai * 128 + m * 16; const float r = rinv_sum(ssqz + (size_t)row * 24 + 12, 2, 1.f / 256.f);
                *(u32x4*)(KC + (size_t)row * 768 + h * 192 + cw) = pack8(acc[ai][0][m][0] * r, acc[ai][0][m][1] * r);
                *(u32x4*)(VC + (size_t)row * 512 + h * 128 + cw) = pack8(acc[ai][1][m][0] * r, acc[ai][1][m][1] * r); asm volatile("" ::: "memory"); }
    }
};
struct EpiGateAcc {
    static constexpr bool PERM = true;
    const bf16_t* Gt; float* mg; bf16_t* MB;
    __device__ __forceinline__ void operator()(const Acc& acc, const pg8::Unit& u, int wr, int wc, int fr, int fq) const {
        const int nb = u.pn >> 2, pno = u.pn & 3;
        const int row0 = u.pm * 256 + wr * 64 + fr, col0 = pno * 256 + wc * 32 + 8 * fq;
        bf16_t* mgb = (bf16_t*)mg;
#pragma unroll
        for (int ai = 0; ai < 2; ++ai)
#pragma unroll
            for (int m = 0; m < 4; ++m) { const int row = row0 + ai * 128 + m * 16;
#pragma unroll
                for (int bj = 0; bj < 2; ++bj) { const int col = col0 + bj * 128; const size_t off = (size_t)row * DM + col;
                    const u32x4 gw = *(const u32x4*)(Gt + (size_t)row * 3072 + nb * 1024 + col);
                    f32x4 v0 = acc[ai][bj][m][0], v1 = acc[ai][bj][m][1];
                    v0[0] *= bf16_lo(gw.x); v0[1] *= bf16_hi(gw.x); v0[2] *= bf16_lo(gw.y); v0[3] *= bf16_hi(gw.y);
                    v1[0] *= bf16_lo(gw.z); v1[1] *= bf16_hi(gw.z); v1[2] *= bf16_lo(gw.w); v1[3] *= bf16_hi(gw.w);
                    if (nb > 0) { const u32x4 pw = *(const u32x4*)(mgb + off);
                        v0[0] += bf16_lo(pw.x); v0[1] += bf16_hi(pw.x); v0[2] += bf16_lo(pw.y); v0[3] += bf16_hi(pw.y);
                        v1[0] += bf16_lo(pw.z); v1[1] += bf16_hi(pw.z); v1[2] += bf16_lo(pw.w); v1[3] += bf16_hi(pw.w); }
                    *(u32x4*)((nb < 2 ? mgb : MB) + off) = pack8(v0, v1); }
                asm volatile("" ::: "memory"); }
    }
};


#ifdef A_SIMPLE
#define ATT_A_BODY att::attn_body_simple<64, 128, 1, ZC, ZC, ZC>
#else
#define ATT_A_BODY att::attn_body<64, 128, 1, 1, ZC, ZC, ZC>
#endif
namespace att {
#define SBAR() __builtin_amdgcn_sched_barrier(0)
__device__ __forceinline__ int crow(int r, int hi) { return (r & 3) + 8 * (r >> 2) + 4 * hi; }
template <int DQK> __device__ __forceinline__ int kswz(int row, int colB) { return row * (DQK * 2) + (colB ^ (((row >> 1) & 7) << 4)); }
template <int DV> __device__ __forceinline__ int v_st(int k, int c) { constexpr int NCB = DV / 32; const int kk = (k & ~0xC) | ((k & 4) << 1) | ((k & 8) >> 1); return ((kk >> 3) * NCB + (c >> 5)) * 512 + ((kk & 7) * 32 + (c & 31)) * 2; }
__device__ __forceinline__ int v_rd_base(int lane) { return ((lane & 3) << 3) | (((lane >> 2) & 3) << 6) | (((lane >> 4) & 1) << 5) | (((lane >> 5) & 1) << 8); }
template <int DV> constexpr int v_rd_off(int d0, int ks, int half) { return d0 * 512 + ks * (2 * (DV / 32) * 512) + half * ((DV / 32) * 512); }
template <int OFF> __device__ __forceinline__ s16x4 tr_read(int vb) { s16x4 r; asm volatile("ds_read_b64_tr_b16 %0, %1 offset:%2" : "=&v"(r) : "v"(vb), "i"(OFF) : "memory"); return r; }

__device__ __forceinline__ void partialSM(f32x16& p0, f32x16& p1, float& m_reg, float& mn, float& alpha, float C, float thr, float aoff = 0.f, bool nomax = false) {
    if (nomax) { mn = m_reg; alpha = 1.f; }
    else {
    float pmax = p0[0];
#pragma unroll
    for (int r = 1; r < 16; ++r) pmax = fmaxf(pmax, p0[r]);
#pragma unroll
    for (int r = 0; r < 16; ++r) pmax = fmaxf(pmax, p1[r]);
    pmax += aoff;
    { auto rr = __builtin_amdgcn_permlane32_swap(__float_as_uint(pmax), __float_as_uint(pmax), false, false); pmax = fmaxf(__uint_as_float(rr[0]), __uint_as_float(rr[1])); }
    if (__builtin_expect(__all(pmax - m_reg <= thr), 1)) { mn = m_reg; alpha = 1.f; }
    else { mn = fmaxf(m_reg, pmax); alpha = __builtin_amdgcn_exp2f((m_reg - mn) * C); m_reg = mn; }
    }
    const float mnC = mn < -1e29f ? 0.f : (aoff - mn) * C;
#pragma unroll
    for (int r = 0; r < 16; ++r) p0[r] = fmaf(p0[r], C, mnC);
#pragma unroll
    for (int r = 0; r < 16; ++r) p1[r] = fmaf(p1[r], C, mnC);
#pragma unroll
    for (int r = 0; r < 16; ++r) p0[r] = __builtin_amdgcn_exp2f(p0[r]);
}
__device__ __forceinline__ void finishSM(f32x16& p0, f32x16& p1, float alpha, float& l_reg, bf16x8& pa0, bf16x8& pa1, bf16x8& pa2, bf16x8& pa3) {
#pragma unroll
    for (int r = 0; r < 16; ++r) p1[r] = __builtin_amdgcn_exp2f(p1[r]);
    float ps = 0;
#pragma unroll
    for (int r = 0; r < 16; ++r) ps += p0[r];
#pragma unroll
    for (int r = 0; r < 16; ++r) ps += p1[r];
    { auto rr = __builtin_amdgcn_permlane32_swap(__float_as_uint(ps), __float_as_uint(ps), false, false); ps = __uint_as_float(rr[0]) + __uint_as_float(rr[1]); }
    l_reg = l_reg * alpha + ps;
#define PK4(P, BASE, OUT) do { unsigned a0 = cvt_pk_bf16(P[BASE + 0], P[BASE + 1]), a1 = cvt_pk_bf16(P[BASE + 2], P[BASE + 3]);   \
    unsigned b0 = cvt_pk_bf16(P[BASE + 4], P[BASE + 5]), b1 = cvt_pk_bf16(P[BASE + 6], P[BASE + 7]);                              \
    auto r0 = __builtin_amdgcn_permlane32_swap(a0, b0, false, false); auto r1 = __builtin_amdgcn_permlane32_swap(a1, b1, false, false); \
    u32x4 w = {r0[0], r1[0], r0[1], r1[1]}; OUT = *reinterpret_cast<bf16x8*>(&w); } while (0)
    PK4(p0, 0, pa0); PK4(p0, 8, pa1); PK4(p1, 0, pa2); PK4(p1, 8, pa3);
#undef PK4
}
template <int MODE> __device__ __forceinline__ float alibi_off(int rel, float dq, float sl) { return (MODE == 1 && (rel > 63 || rel < -31)) ? (rel > 63 ? -sl : sl) * dq : 0.f; }
template <int DQK, int MODE, int NQR = DQK / 16> __device__ __forceinline__ void qkt(f32x16& p0, f32x16& p1, LAS const char* Ks, const bf16x8* qr, int r32, int hi, float dq, float sl, LAS const char* qlds = nullptr, int rel = 0) {
    p0 = f32x16{}; p1 = f32x16{};
    if (NQR < DQK / 16) asm volatile("" : "+v"(qlds));
    const int x_ = ((r32 >> 1) & 7) << 4; int kb[4];
#pragma unroll
    for (int j = 0; j < 4; ++j) kb[j] = r32 * (DQK * 2) + ((j * 32 + hi * 16) ^ x_);
#pragma unroll
    for (int d0 = 0; d0 < DQK / 16; ++d0) {
        bf16x8 qf; if (d0 < NQR) qf = qr[d0 < NQR ? d0 : 0]; else qf = *(LAS const bf16x8*)(qlds + (d0 - NQR) * 1024);
        const bf16x8 b0 = *(LAS const bf16x8*)(Ks + kb[d0 & 3] + (d0 >> 2) * 128);
        const bf16x8 b1 = *(LAS const bf16x8*)(Ks + kb[d0 & 3] + (d0 >> 2) * 128 + 32 * (DQK * 2));
        p0 = __builtin_amdgcn_mfma_f32_32x32x16_bf16(b0, qf, p0, 0, 0, 0);
        p1 = __builtin_amdgcn_mfma_f32_32x32x16_bf16(b1, qf, p1, 0, 0, 0); }
    if (MODE == 1 && (rel > 63 || rel < -31)) {
        const float ss = rel > 63 ? sl : -sl;
#pragma unroll
        for (int r = 0; r < 16; ++r) { const float c = (float)((r & 3) + 8 * (r >> 2)); p0[r] = fmaf(ss, c, p0[r]); p1[r] = fmaf(ss, c + 32.f, p1[r]); }
    } else if (MODE != 0) {
#pragma unroll
        for (int r = 0; r < 16; ++r) { const float c = (float)((r & 3) + 8 * (r >> 2)); const float d0 = fabsf(dq - c), d1 = fabsf(dq - 32.f - c);
            if (MODE == 1) { p0[r] = fmaf(-sl, d0, p0[r]); p1[r] = fmaf(-sl, d1, p1[r]); }
            else { p0[r] = d0 > 128.f ? -1e30f : fmaf(-sl, d0, p0[r]); p1[r] = d1 > 128.f ? -1e30f : fmaf(-sl, d1, p1[r]); } }
    }
}
template <int D0, int DV> __device__ __forceinline__ void pv_one(f32x16& od, int vb, bf16x8 pa0, bf16x8 pa1, bf16x8 pa2, bf16x8 pa3) {
    const s16x4 l0 = tr_read<v_rd_off<DV>(D0, 0, 0)>(vb), h0 = tr_read<v_rd_off<DV>(D0, 0, 1)>(vb), l1 = tr_read<v_rd_off<DV>(D0, 1, 0)>(vb), h1 = tr_read<v_rd_off<DV>(D0, 1, 1)>(vb);
    const s16x4 l2 = tr_read<v_rd_off<DV>(D0, 2, 0)>(vb), h2 = tr_read<v_rd_off<DV>(D0, 2, 1)>(vb), l3 = tr_read<v_rd_off<DV>(D0, 3, 0)>(vb), h3 = tr_read<v_rd_off<DV>(D0, 3, 1)>(vb);
    asm volatile("s_waitcnt lgkmcnt(0)" ::: "memory"); SBAR();
#define PK(L, H) (bf16x8){L[0], L[1], L[2], L[3], H[0], H[1], H[2], H[3]}
    od = __builtin_amdgcn_mfma_f32_32x32x16_bf16(pa0, PK(l0, h0), od, 0, 0, 0);
    od = __builtin_amdgcn_mfma_f32_32x32x16_bf16(pa1, PK(l1, h1), od, 0, 0, 0);
    od = __builtin_amdgcn_mfma_f32_32x32x16_bf16(pa2, PK(l2, h2), od, 0, 0, 0);
    od = __builtin_amdgcn_mfma_f32_32x32x16_bf16(pa3, PK(l3, h3), od, 0, 0, 0);
#undef PK
}
template <int DV> __device__ __forceinline__ void pv_all(f32x16* o, int vb, bf16x8 pa0, bf16x8 pa1, bf16x8 pa2, bf16x8 pa3) {
    pv_one<0, DV>(o[0], vb, pa0, pa1, pa2, pa3); pv_one<1, DV>(o[1], vb, pa0, pa1, pa2, pa3);
    if constexpr (DV == 128) { pv_one<2, DV>(o[2], vb, pa0, pa1, pa2, pa3); pv_one<3, DV>(o[3], vb, pa0, pa1, pa2, pa3); }
}

template <int DQK, int DV, int MODE, int SD, int LDQ, int LDK, int LDV, int NQL = 0, class Epi>
__device__ __forceinline__ void attn_body(const bf16_t* __restrict__ Qb, const bf16_t* __restrict__ Kh, const bf16_t* __restrict__ Vh, int kstart, int NT, int qpos0,
                                          float scale, float slope, float sinkl2, LAS char* lds, const Epi& epi, int wave_, int safe_nomax = 0) {
    asm volatile("" : "+s"(Qb), "+s"(Kh), "+s"(Vh));
    constexpr int SHM_V = 64 * DV * 2, SHM_K = 64 * DQK * 2, NQ = DQK / 16, NO = DV / 32;
    constexpr int KCH = DQK / 8, NKC = 64 * KCH / 512, VCH = DV / 8, NVC = 64 * VCH / 512;
    int tid = wave_ * 64 + lane_id(); asm volatile("" : "+v"(tid));
    const int wid = tid >> 6, lane = tid & 63, r32 = lane & 31, hi = lane >> 5;
    LAS char* V_lds = lds; LAS char* K_lds = lds + 2 * SHM_V;
    LAS float* wsf = (LAS float*)(lds + 2 * SHM_V + 2 * SHM_K) + wid * 64; LAS float* li_l = wsf; LAS float* al_l = wsf + 32;
    const float C = scale * LOG2E, thr = 8.f / scale, sl = slope / scale;
    const float dq0 = (float)(qpos0 + wid * 32 + r32 - kstart - 4 * hi);
    constexpr int NQR = NQ - NQL;
    LAS char* qlds = lds + 2 * SHM_V + 2 * SHM_K + 2048 + wid * (NQL * 1024) + lane * 16;
    float m_reg = -1e30f, l_reg = 0; f32x16 o[NO]; bf16x8 qr[NQR > 0 ? NQR : 1];
#pragma unroll
    for (int d = 0; d < NO; ++d) o[d] = f32x16{};
    const GAS bf16_t* Qw = (const GAS bf16_t*)Qb + (size_t)(wid * 32 + r32) * LDQ + hi * 8;
#pragma unroll
    for (int d0 = 0; d0 < NQ; ++d0) { const bf16x8 qv = *(const GAS bf16x8*)(Qw + d0 * 16); if (d0 < NQR) qr[d0 < NQR ? d0 : 0] = qv; else *(LAS bf16x8*)(qlds + (d0 - NQR) * 1024) = qv; }
    int koff[NKC], kst[NKC], voff[NVC], vst[NVC];
#pragma unroll
    for (int i = 0; i < NKC; ++i) { const int c = tid + 512 * i, row = c / KCH, c8 = c % KCH; koff[i] = row * LDK + c8 * 8; kst[i] = kswz<DQK>(row, c8 * 16); }
#pragma unroll
    for (int i = 0; i < NVC; ++i) { const int c = tid + 512 * i, row = c / VCH, c8 = c % VCH; voff[i] = row * LDV + c8 * 8; vst[i] = v_st<DV>(row, c8 * 8); }
    const int vb0 = (int)(unsigned)(size_t)V_lds + v_rd_base(lane);
    struct { bf16x8 k[NKC]; bf16x8 v[NVC]; } sr_[SD];
    const GAS bf16_t* Kp = (const GAS bf16_t*)Kh + (size_t)kstart * LDK; const GAS bf16_t* Vp = (const GAS bf16_t*)Vh + (size_t)kstart * LDV;
#define SLOAD(i, k0) do { if constexpr (NQL > 0) { int t_ = tid; asm volatile("" : "+v"(t_)); \
      _Pragma("unroll") for (int _c = 0; _c < NVC; ++_c) { const int c_ = t_ + 512 * _c; sr_[i].v[_c] = *(const GAS bf16x8*)(Vp + (size_t)((k0) + c_ / VCH) * LDV + (c_ % VCH) * 8); } \
      _Pragma("unroll") for (int _c = 0; _c < NKC; ++_c) { const int c_ = t_ + 512 * _c; sr_[i].k[_c] = *(const GAS bf16x8*)(Kp + (size_t)((k0) + c_ / KCH) * LDK + (c_ % KCH) * 8); } } else { \
    _Pragma("unroll") for (int _c = 0; _c < NVC; ++_c) sr_[i].v[_c] = *(const GAS bf16x8*)(Vp + (size_t)(k0) * LDV + voff[_c]); \
    _Pragma("unroll") for (int _c = 0; _c < NKC; ++_c) sr_[i].k[_c] = *(const GAS bf16x8*)(Kp + (size_t)(k0) * LDK + koff[_c]); } } while (0)
#define SWRITE(b, i) do { if constexpr (NQL > 0) { int t_ = tid; asm volatile("" : "+v"(t_)); \
      _Pragma("unroll") for (int _c = 0; _c < NVC; ++_c) { const int c_ = t_ + 512 * _c; *(LAS bf16x8*)(V_lds + (b) * SHM_V + v_st<DV>(c_ / VCH, (c_ % VCH) * 8)) = sr_[i].v[_c]; } \
      _Pragma("unroll") for (int _c = 0; _c < NKC; ++_c) { const int c_ = t_ + 512 * _c; *(LAS bf16x8*)(K_lds + (b) * SHM_K + kswz<DQK>(c_ / KCH, (c_ % KCH) * 16)) = sr_[i].k[_c]; } } else { \
    _Pragma("unroll") for (int _c = 0; _c < NVC; ++_c) *(LAS bf16x8*)(V_lds + (b) * SHM_V + vst[_c]) = sr_[i].v[_c]; \
    _Pragma("unroll") for (int _c = 0; _c < NKC; ++_c) *(LAS bf16x8*)(K_lds + (b) * SHM_K + kst[_c]) = sr_[i].k[_c]; } } while (0)
#define RESC(a) do { if (__any((a) < 1.f)) { if (hi == 0) al_l[r32] = (a); asm volatile("s_waitcnt lgkmcnt(0)" ::: "memory"); \
    _Pragma("unroll") for (int d = 0; d < NO; ++d) _Pragma("unroll") for (int r = 0; r < 16; ++r) o[d][r] *= al_l[crow(r, hi)]; } } while (0)
    f32x16 pA0, pA1, pB0, pB1; float mnA, mnB, alA, alB; bf16x8 pa0, pa1, pa2, pa3;
    const int rel0 = qpos0 + __builtin_amdgcn_readfirstlane(wid) * 32 - kstart;
    constexpr int SE = 0, SO = SD - 1;
    __syncthreads();
    SLOAD(SE, 0); asm volatile("s_waitcnt vmcnt(0)" ::: "memory"); SWRITE(0, SE); __syncthreads();
    qkt<DQK, MODE, NQR>(pA0, pA1, K_lds, qr, r32, hi, dq0, sl, qlds, rel0); partialSM(pA0, pA1, m_reg, mnA, alA, C, thr, alibi_off<MODE>(rel0, dq0, sl), MODE == 1 && safe_nomax && rel0 < -31);
    SLOAD(SO, 64); if constexpr (SD == 2) { if (2 < NT) SLOAD(SE, 128); }
    SWRITE(1, SO); __syncthreads();
    for (int j = 1; j + 1 < NT; j += 2) {
        SBAR(); qkt<DQK, MODE, NQR>(pB0, pB1, K_lds + SHM_K, qr, r32, hi, dq0 - 64.f * (float)j, sl, qlds, rel0 - 64 * j);
        finishSM(pA0, pA1, alA, l_reg, pa0, pa1, pa2, pa3); SBAR();
        SLOAD(SO, (j + SD) * 64); SBAR();
        pv_all<DV>(o, vb0, pa0, pa1, pa2, pa3); partialSM(pB0, pB1, m_reg, mnB, alB, C, thr, alibi_off<MODE>(rel0 - 64 * j, dq0 - 64.f * (float)j, sl), MODE == 1 && safe_nomax && rel0 - 64 * j < -31);
        __syncthreads(); SWRITE(0, SE);
        RESC(alB); __syncthreads();
        SBAR(); qkt<DQK, MODE, NQR>(pA0, pA1, K_lds, qr, r32, hi, dq0 - 64.f * (float)(j + 1), sl, qlds, rel0 - 64 * (j + 1));
        finishSM(pB0, pB1, alB, l_reg, pa0, pa1, pa2, pa3); SBAR();
        if (SD == 1 || j + 3 < NT) SLOAD(SE, (j + 1 + SD) * 64); SBAR();
        pv_all<DV>(o, vb0 + SHM_V, pa0, pa1, pa2, pa3); partialSM(pA0, pA1, m_reg, mnA, alA, C, thr, alibi_off<MODE>(rel0 - 64 * (j + 1), dq0 - 64.f * (float)(j + 1), sl), MODE == 1 && safe_nomax && rel0 - 64 * (j + 1) < -31);
        __syncthreads(); SWRITE(1, SO);
        RESC(alA); __syncthreads();
    }
    SBAR(); qkt<DQK, MODE, NQR>(pB0, pB1, K_lds + SHM_K, qr, r32, hi, dq0 - 64.f * (float)(NT - 1), sl, qlds, rel0 - 64 * (NT - 1));
    finishSM(pA0, pA1, alA, l_reg, pa0, pa1, pa2, pa3); SBAR();
    pv_all<DV>(o, vb0, pa0, pa1, pa2, pa3); partialSM(pB0, pB1, m_reg, mnB, alB, C, thr, alibi_off<MODE>(rel0 - 64 * (NT - 1), dq0 - 64.f * (float)(NT - 1), sl), MODE == 1 && safe_nomax && rel0 - 64 * (NT - 1) < -31);
    __syncthreads(); RESC(alB);
    finishSM(pB0, pB1, alB, l_reg, pa0, pa1, pa2, pa3); SBAR();
    pv_all<DV>(o, vb0 + SHM_V, pa0, pa1, pa2, pa3);
    if (MODE == 2) l_reg += __builtin_amdgcn_exp2f(sinkl2 - m_reg * C);
    if (hi == 0) li_l[r32] = l_reg; asm volatile("s_waitcnt lgkmcnt(0)" ::: "memory");
    float rli[16];
#pragma unroll
    for (int r = 0; r < 16; ++r) rli[r] = __builtin_amdgcn_rcpf(li_l[crow(r, hi)]);
    epi(o, rli, wid, r32, hi);
#undef SLOAD
#undef SWRITE
#undef RESC
}

template <int DQK, int DV, int MODE, int LDQ, int LDK, int LDV, class Epi>
__device__ __forceinline__ void attn_body_simple(const bf16_t* __restrict__ Qb, const bf16_t* __restrict__ Kh, const bf16_t* __restrict__ Vh, int kstart, int NT, int qpos0,
                                                 float scale, float slope, float sinkl2, LAS char* lds, const Epi& epi, int wave_) {
    asm volatile("" : "+s"(Qb), "+s"(Kh), "+s"(Vh));
    constexpr int SHM_V = 64 * DV * 2, SHM_K = 64 * DQK * 2, NQ = DQK / 16, NO = DV / 32;
    constexpr int KCH = DQK / 8, NKC = 64 * KCH / 512, VCH = DV / 8, NVC = 64 * VCH / 512;
    int tid = wave_ * 64 + lane_id(); asm volatile("" : "+v"(tid));
    const int wid = tid >> 6, lane = tid & 63, r32 = lane & 31, hi = lane >> 5;
    LAS char* V_lds = lds; LAS char* K_lds = lds + 3 * SHM_V;
    LAS float* wsf = (LAS float*)(lds + 3 * SHM_V + 3 * SHM_K) + wid * 64; LAS float* li_l = wsf; LAS float* al_l = wsf + 32;
    const float C = scale * LOG2E, thr = 8.f / scale, sl = slope / scale;
    const float dq0 = (float)(qpos0 + wid * 32 + r32 - kstart - 4 * hi);
    float m_reg = -1e30f, l_reg = 0; f32x16 o[NO]; bf16x8 qr[NQ];
#pragma unroll
    for (int d = 0; d < NO; ++d) o[d] = f32x16{};
    const GAS bf16_t* Qw = (const GAS bf16_t*)Qb + (size_t)(wid * 32 + r32) * LDQ + hi * 8;
#pragma unroll
    for (int d0 = 0; d0 < NQ; ++d0) qr[d0] = *(const GAS bf16x8*)(Qw + d0 * 16);
    const int vb0 = (int)(unsigned)(size_t)V_lds + v_rd_base(lane);
    bf16x8 sk[NKC], sv[NVC];
    const GAS bf16_t* Kp = (const GAS bf16_t*)Kh + (size_t)kstart * LDK; const GAS bf16_t* Vp = (const GAS bf16_t*)Vh + (size_t)kstart * LDV;
#define S1LOAD(k0) do { _Pragma("unroll") for (int _c = 0; _c < NVC; ++_c) { const int c_ = tid + 512 * _c; sv[_c] = *(const GAS bf16x8*)(Vp + (size_t)((k0) + c_ / VCH) * LDV + (c_ % VCH) * 8); } \
    _Pragma("unroll") for (int _c = 0; _c < NKC; ++_c) { const int c_ = tid + 512 * _c; sk[_c] = *(const GAS bf16x8*)(Kp + (size_t)((k0) + c_ / KCH) * LDK + (c_ % KCH) * 8); } } while (0)
#define S1WRITE(b) do { _Pragma("unroll") for (int _c = 0; _c < NVC; ++_c) { const int c_ = tid + 512 * _c; *(LAS bf16x8*)(V_lds + (b) * SHM_V + v_st<DV>(c_ / VCH, (c_ % VCH) * 8)) = sv[_c]; } \
    _Pragma("unroll") for (int _c = 0; _c < NKC; ++_c) { const int c_ = tid + 512 * _c; *(LAS bf16x8*)(K_lds + (b) * SHM_K + kswz<DQK>(c_ / KCH, (c_ % KCH) * 16)) = sk[_c]; } } while (0)
    __syncthreads();
    S1LOAD(0); S1WRITE(0); S1LOAD(64); S1WRITE(1);
    if (2 < NT) S1LOAD(128);
    int slot = 0;
    for (int j = 0; j < NT; ++j) {
        __syncthreads();
        { const int wslot = slot == 0 ? 2 : slot - 1;
          if (j + 2 < NT) { S1WRITE(wslot); if (j + 3 < NT) S1LOAD((j + 3) * 64); } }
        f32x16 p0, p1; float mn, al; bf16x8 pa0, pa1, pa2, pa3;
        qkt<DQK, MODE>(p0, p1, K_lds + slot * SHM_K, qr, r32, hi, dq0 - 64.f * (float)j, sl);
        partialSM(p0, p1, m_reg, mn, al, C, thr);
        finishSM(p0, p1, al, l_reg, pa0, pa1, pa2, pa3);
        if (__any(al < 1.f)) { if (hi == 0) al_l[r32] = al; asm volatile("s_waitcnt lgkmcnt(0)" ::: "memory");
#pragma unroll
            for (int d = 0; d < NO; ++d)
#pragma unroll
                for (int r = 0; r < 16; ++r) o[d][r] *= al_l[crow(r, hi)]; }
        SBAR();
        pv_all<DV>(o, vb0 + slot * SHM_V, pa0, pa1, pa2, pa3);
        slot = slot == 2 ? 0 : slot + 1;
    }
#undef S1LOAD
#undef S1WRITE
    if (MODE == 2) l_reg += __builtin_amdgcn_exp2f(sinkl2 - m_reg * C);
    if (hi == 0) li_l[r32] = l_reg; asm volatile("s_waitcnt lgkmcnt(0)" ::: "memory");
    float rli[16];
#pragma unroll
    for (int r = 0; r < 16; ++r) rli[r] = __builtin_amdgcn_rcpf(li_l[crow(r, hi)]);
    epi(o, rli, wid, r32, hi);
}

template <int NO> struct EpiStoreBf16 {
    bf16_t* O; int ldo;
    __device__ __forceinline__ void operator()(const f32x16* o, const float* rli, int wid, int r32, int hi) const {
        bf16_t* Ob = O; asm volatile("" : "+s"(Ob));
#pragma unroll
        for (int r = 0; r < 16; ++r) { GAS bf16_t* p = (GAS bf16_t*)Ob + (size_t)(wid * 32 + crow(r, hi)) * ldo + r32;
#pragma unroll
            for (int d0 = 0; d0 < NO; ++d0) p[d0 * 32] = (bf16_t)(cvt_pk_bf16(o[d0][r] * rli[r], 0.f) & 0xffffu); }
    }
};
struct EpiDiff0 {
    float* scr;
    __device__ __forceinline__ void operator()(const f32x16* o, const float* rli, int wid, int r32, int hi) const {
        float* sb = scr; asm volatile("" : "+s"(sb));
        int t_ = wid * 64 + hi * 32 + r32; GAS f32x4* p = (GAS f32x4*)(sb + t_ * 64);
#pragma unroll
        for (int d0 = 0; d0 < 4; ++d0)
#pragma unroll
            for (int q = 0; q < 4; ++q) { f32x4 v;
#pragma unroll
                for (int i = 0; i < 4; ++i) v[i] = o[d0][4 * q + i] * rli[4 * q + i];
                p[d0 * 4 + q] = v; }
    }
};
struct EpiDiff1 {
    const float* scr; bf16_t* O; int ldo; const float* g; float lam, oscale;
    __device__ __forceinline__ void operator()(const f32x16* o, const float* rli, int wid, int r32, int hi) const {
        const float* sb = scr; bf16_t* Ob = O; asm volatile("" : "+s"(sb), "+s"(Ob));
        int t_ = wid * 64 + hi * 32 + r32; const GAS f32x4* p = (const GAS f32x4*)(sb + t_ * 64); float gv[4];
#pragma unroll
        for (int d0 = 0; d0 < 4; ++d0) gv[d0] = g[d0 * 32 + r32] * oscale;
#pragma unroll
        for (int q = 0; q < 4; ++q) { f32x4 t[4];
#pragma unroll
            for (int d0 = 0; d0 < 4; ++d0) t[d0] = p[d0 * 4 + q];
#pragma unroll
            for (int i = 0; i < 4; ++i) { const int r = 4 * q + i; float s = 0.f;
#pragma unroll
                for (int d0 = 0; d0 < 4; ++d0) { t[d0][i] -= lam * (o[d0][r] * rli[r]); s += t[d0][i] * t[d0][i]; }
                s += shfl_xor_f(s, 1); s += shfl_xor_f(s, 2); s += shfl_xor_f(s, 4); s += shfl_xor_f(s, 8); s += shfl_xor_f(s, 16);
                const float rn = fast_rsq(s * (1.f / 128.f) + EPS);
                GAS bf16_t* qp = (GAS bf16_t*)Ob + (size_t)(wid * 32 + crow(r, hi)) * ldo + r32;
#pragma unroll
                for (int d0 = 0; d0 < 4; ++d0) qp[d0 * 32] = (bf16_t)(cvt_pk_bf16(t[d0][i] * rn * gv[d0], 0.f) & 0xffffu); }
            asm volatile("" ::: "memory"); }
    }
};
}

__device__ __forceinline__ float wave_sum(float v) {
#pragma unroll
    for (int o = 1; o < 64; o <<= 1) v += shfl_xor_f(v, o);
    return v;
}
template <int MODE> __device__ __forceinline__ int src_col(int n) {
    if (MODE == 1) { const int t = n >> 8, j = n & 255; return j < 128 ? t * 128 + j : FF + t * 128 + (j - 128); }
    if (MODE == 2) { if (n < Z_CKR) return n; if (n < 3008) { const int e = n - Z_CKR; return Z_CKR + (e >> 1) + 32 * (e & 1); } return -1; }
    if (MODE == 3) { const int h = n / 192, e = n - h * 192; if (e < 128) return n; const int e2 = e - 128; return h * 192 + 128 + (e2 >> 1) + 32 * (e2 & 1); }
    return n;
}
template <int MODE> __device__ __forceinline__ void tr_item(const float* __restrict__ W, int K, int Nsrc, const float* __restrict__ gain, bf16_t* WT, int nblk, LAS float* scr, int item, int lane) {
    const int kb = item / nblk, nb = item - kb * nblk, k0 = 64 * kb, n0 = 32 * nb;
    const int sc0 = src_col<MODE>(n0), sc31 = src_col<MODE>(n0 + 31);
    if (sc0 >= 0 && sc31 == sc0 + 31 && (sc0 & 3) == 0) {
        const int row8 = lane >> 3, n4 = (lane & 7) * 4;
#pragma unroll
        for (int i = 0; i < 8; ++i) { const int kk = 8 * i + row8; f32x4 v = *(const f32x4*)(W + (size_t)(k0 + kk) * Nsrc + sc0 + n4);
            if (gain) v = v * gain[k0 + kk];
            LAS float* d = scr + kk * 33 + n4; d[0] = v[0]; d[1] = v[1]; d[2] = v[2]; d[3] = v[3]; }
    } else {
        const int sc = src_col<MODE>(n0 + (lane & 31));
#pragma unroll
        for (int i = 0; i < 32; ++i) { const int kk = 2 * i + (lane >> 5); float v = 0.f;
            if (sc >= 0) { v = W[(size_t)(k0 + kk) * Nsrc + sc]; if (gain) v *= gain[k0 + kk]; }
            scr[kk * 33 + (lane & 31)] = v; }
    }
    asm volatile("s_waitcnt lgkmcnt(0)" ::: "memory");
    const int c = lane & 7;
#pragma unroll
    for (int j = 0; j < 4; ++j) { const int n = (lane >> 3) + 8 * j; const LAS float* s = scr + (8 * c) * 33 + n;
        u32x4 o; o.x = cvt_pk_bf16(s[0 * 33], s[1 * 33]); o.y = cvt_pk_bf16(s[2 * 33], s[3 * 33]); o.z = cvt_pk_bf16(s[4 * 33], s[5 * 33]); o.w = cvt_pk_bf16(s[6 * 33], s[7 * 33]);
        *(u32x4*)(WT + (size_t)(n0 + n) * K + k0 + 8 * c) = o; }
    asm volatile("s_waitcnt lgkmcnt(0)" ::: "memory");
}

struct Args { const float* in[21]; float* out; unsigned char* ws; int ph_lo, ph_hi; };
enum { I_X = 0, I_F1N, I_F1W13, I_F1W2, I_MIXN, I_WIN, I_WGATE, I_BGATE, I_ALAM, I_ASUB, I_BSINK, I_CQN, I_CWUQ, I_CKVN, I_CWUKV, I_WBR, I_WOUT, I_F2N, I_F2W13, I_F2W2, I_FINN };

constexpr int LDS_BYTES = 155648;

struct TrDesc { const float* W; const float* gain; bf16_t* WT; int K, Nsrc, nblk, mode, r; };
__device__ __forceinline__ int src_col_rt(int mode, int n) { return mode == 1 ? src_col<1>(n) : mode == 2 ? src_col<2>(n) : mode == 3 ? src_col<3>(n) : n; }
__device__ __forceinline__ bool tr_decode(const Args& a, int l, unsigned char* ws, int it, TrDesc& d) {
    constexpr int I_W13 = (DM / 64) * (2 * FF / 32), I_W2 = (FF / 64) * (DM / 32), I_IN = (DM / 64) * (3072 / 32), I_GT = I_IN,
                  I_UQ = (384 / 64) * (768 / 32), I_UKV = (256 / 64) * (1024 / 32), I_BR = (512 / 64) * (1024 / 32), I_OUT = (DM / 64) * (DM / 32);
    constexpr int NITEMS = 2 * I_W13 + 2 * I_W2 + I_IN + I_GT + I_UQ + I_UKV + 3 * I_BR + I_OUT;
    if (it >= NITEMS) return false;
    int r = it;
#define TR_SET(W_, K_, NS_, G_, WT_, NB_, M_) do { d.W = (W_); d.K = (K_); d.Nsrc = (NS_); d.gain = (G_); d.WT = (WT_); d.nblk = (NB_); d.mode = (M_); d.r = r; return true; } while (0)
    if (r < I_W13) TR_SET(a.in[I_F1W13] + (size_t)l * DM * 2 * FF, DM, 2 * FF, a.in[I_F1N] + l * DM, (bf16_t*)(ws + WS_W13A), 2 * FF / 32, 1); r -= I_W13;
    if (r < I_W13) TR_SET(a.in[I_F2W13] + (size_t)l * DM * 2 * FF, DM, 2 * FF, a.in[I_F2N] + l * DM, (bf16_t*)(ws + WS_W13B), 2 * FF / 32, 1); r -= I_W13;
    if (r < I_W2) TR_SET(a.in[I_F1W2] + (size_t)l * FF * DM, FF, DM, nullptr, (bf16_t*)(ws + WS_W2A), DM / 32, 0); r -= I_W2;
    if (r < I_W2) TR_SET(a.in[I_F2W2] + (size_t)l * FF * DM, FF, DM, nullptr, (bf16_t*)(ws + WS_W2B), DM / 32, 0); r -= I_W2;
    if (r < I_IN) TR_SET(a.in[I_WIN] + (size_t)l * DM * 3008, DM, 3008, a.in[I_MIXN] + l * DM, (bf16_t*)(ws + WS_WIG), 3072 / 32, 2); r -= I_IN;
    if (r < I_GT) TR_SET(a.in[I_WGATE] + (size_t)l * DM * 3072, DM, 3072, a.in[I_MIXN] + l * DM, (bf16_t*)(ws + WS_WIG) + (size_t)3072 * DM, 3072 / 32, 0); r -= I_GT;
    if (r < I_UQ) TR_SET(a.in[I_CWUQ] + (size_t)l * 384 * 768, 384, 768, a.in[I_CQN] + l * 384, (bf16_t*)(ws + WS_WUQ), 768 / 32, 3); r -= I_UQ;
    if (r < I_UKV) TR_SET(a.in[I_CWUKV] + (size_t)l * 256 * 1024, 256, 1024, a.in[I_CKVN] + l * 256, (bf16_t*)(ws + WS_WUKV), 1024 / 32, 0); r -= I_UKV;
    if (r < 3 * I_BR) { const int n = r / I_BR; r -= n * I_BR; TR_SET(a.in[I_WBR] + ((size_t)l * 3 + n) * 512 * 1024, 512, 1024, nullptr, (bf16_t*)(ws + WS_WB) + (size_t)n * 1024 * 512, 1024 / 32, 0); } r -= 3 * I_BR;
    TR_SET(a.in[I_WOUT] + (size_t)l * DM * DM, DM, DM, nullptr, (bf16_t*)(ws + WS_WO), DM / 32, 0);
#undef TR_SET
}
__device__ __forceinline__ bool tr_load(const TrDesc& d, int lane, f32x4 (&v)[8]) {
    const int kb = d.r / d.nblk, nb = d.r - kb * d.nblk, k0 = 64 * kb, n0 = 32 * nb;
    const int sc0 = src_col_rt(d.mode, n0), sc31 = src_col_rt(d.mode, n0 + 31);
    const bool vec = sc0 >= 0 && sc31 == sc0 + 31 && (sc0 & 3) == 0;
    if (vec) { const int row8 = lane >> 3, n4 = (lane & 7) * 4;
#pragma unroll
        for (int i = 0; i < 8; ++i) { const int kk = 8 * i + row8; v[i] = *(const f32x4*)(d.W + (size_t)(k0 + kk) * d.Nsrc + sc0 + n4); } }
    return vec;
}
__device__ __forceinline__ void tr_finish(const TrDesc& d, bool vec, int lane, const f32x4 (&v)[8], LAS float* scr) {
    const int kb = d.r / d.nblk, nb = d.r - kb * d.nblk, k0 = 64 * kb, n0 = 32 * nb;
    if (vec) { const int row8 = lane >> 3, n4 = (lane & 7) * 4;
#pragma unroll
        for (int i = 0; i < 8; ++i) { const int kk = 8 * i + row8; const f32x4 x = d.gain ? v[i] * d.gain[k0 + kk] : v[i]; LAS float* p = scr + kk * 33 + n4; p[0] = x[0]; p[1] = x[1]; p[2] = x[2]; p[3] = x[3]; }
    } else { const int sc = src_col_rt(d.mode, n0 + (lane & 31));
#pragma unroll 8
        for (int i = 0; i < 32; ++i) { const int kk = 2 * i + (lane >> 5); float x = 0.f;
            if (sc >= 0) { x = d.W[(size_t)(k0 + kk) * d.Nsrc + sc]; if (d.gain) x *= d.gain[k0 + kk]; }
            scr[kk * 33 + (lane & 31)] = x; } }
    asm volatile("s_waitcnt lgkmcnt(0)" ::: "memory");
    const int c = lane & 7;
#pragma unroll
    for (int j = 0; j < 4; ++j) { const int n = (lane >> 3) + 8 * j; const LAS float* s = scr + (8 * c) * 33 + n;
        u32x4 o; o.x = cvt_pk_bf16(s[0 * 33], s[1 * 33]); o.y = cvt_pk_bf16(s[2 * 33], s[3 * 33]); o.z = cvt_pk_bf16(s[4 * 33], s[5 * 33]); o.w = cvt_pk_bf16(s[6 * 33], s[7 * 33]);
        *(u32x4*)(d.WT + (size_t)(n0 + n) * d.K + k0 + 8 * c) = o; }
    asm volatile("s_waitcnt lgkmcnt(0)" ::: "memory");
}
__device__ __forceinline__ void convert_layer(const Args& a, int l, LAS unsigned char* lds, int gw, int NGW, int wave, int mask = 0) {
    constexpr int I_W13 = (DM / 64) * (2 * FF / 32), I_W2 = (FF / 64) * (DM / 32), I_IN = (DM / 64) * (3072 / 32),
                  I_UQ = (384 / 64) * (768 / 32), I_UKV = (256 / 64) * (1024 / 32), I_BR = (512 / 64) * (1024 / 32), I_OUT = (DM / 64) * (DM / 32);
    constexpr int NITEMS = 2 * I_W13 + 2 * I_W2 + 2 * I_IN + I_UQ + I_UKV + 3 * I_BR + I_OUT, OFF_W2B = 2 * I_W13 + I_W2;
    int lane = lane_id(); asm volatile("" : "+v"(lane));
    LAS float* scr0 = (LAS float*)(lds + wave * 17408); LAS float* scr1 = scr0 + 64 * 33 + 32;
    unsigned char* ws = a.ws; asm volatile("" : "+s"(ws));
    const int limit = mask == 0 ? NITEMS : mask == 1 ? NITEMS - I_W2 : I_W2;
#define CV_MAP(i_) (mask == 0 ? (i_) : mask == 1 ? ((i_) >= OFF_W2B ? (i_) + I_W2 : (i_)) : OFF_W2B + (i_))
    for (int it = gw; it < limit; it += 2 * NGW) {
        TrDesc d0, d1; f32x4 v0[8], v1[8];
        if (!tr_decode(a, l, ws, CV_MAP(it), d0)) break;
        const bool has1 = (it + NGW < limit) && tr_decode(a, l, ws, CV_MAP(it + NGW), d1);
        const bool vec0 = tr_load(d0, lane, v0);
        bool vec1 = false; if (has1) vec1 = tr_load(d1, lane, v1);
        tr_finish(d0, vec0, lane, v0, scr0);
        if (has1) tr_finish(d1, vec1, lane, v1, scr1);
    }
#undef CV_MAP
}

#define XB_TMO      128
#define XB_XCNT(j)  (256  + 64 * (j))
#define XB_XSUB(j)  (1280 + 64 * (j))
#define XB_XGEN(j)  (2304 + 64 * (j))
#define XB_TOP      3328
#define XB_TOPGEN   3392
#define XCD_BAR_WORDS 3456
#define XB_SPIN_CAP (1u << 18)

__device__ __forceinline__ unsigned xb_ld(unsigned* p)              { return __hip_atomic_load(p, __ATOMIC_RELAXED, __HIP_MEMORY_SCOPE_AGENT); }
__device__ __forceinline__ unsigned xb_add(unsigned* p, unsigned v) { return __hip_atomic_fetch_add(p, v, __ATOMIC_RELAXED, __HIP_MEMORY_SCOPE_AGENT); }
__device__ __forceinline__ unsigned xb_xcc_id() { return (unsigned)__builtin_amdgcn_s_getreg((3 << 11) | 20) & 0xFu; }
#define XB_SPIN(cond, bar) do { unsigned _sp = 0; while (cond) { __builtin_amdgcn_s_sleep(1); \
    if ((++_sp & 255u) == 0u) { if (xb_ld(&(bar)[XB_TMO])) break; if (_sp > XB_SPIN_CAP) { atomicAdd(&(bar)[XB_TMO], 1u); break; } } } } while (0)

struct XcdBarrier {
    unsigned* bar; unsigned x;
    volatile LAS unsigned* st;
};

__device__ __forceinline__ XcdBarrier xcd_barrier_post(unsigned* bar, volatile LAS unsigned* st) {
    XcdBarrier b; b.bar = bar; b.x = xb_xcc_id(); b.st = st;
    if (threadIdx.x == 0) (void)xb_add(&bar[XB_XCNT(b.x)], 1u);
    return b;
}
__device__ __forceinline__ void xcd_barrier_complete(unsigned* bar, unsigned x, unsigned& nloc, unsigned& nx) {
    const unsigned G = gridDim.x * gridDim.y * gridDim.z;
    unsigned sum, cnt, mine, sp = 0u;
    for (;;) {
        sum = 0u; cnt = 0u; mine = 0u;
#pragma unroll
        for (unsigned j = 0; j < 16; ++j) { const unsigned c = xb_ld(&bar[XB_XCNT(j)]); sum += c; cnt += (c > 0u) ? 1u : 0u; mine = (j == x) ? c : mine; }
        if (sum == G) break;
        __builtin_amdgcn_s_sleep(1);
        if ((++sp & 255u) == 0u) { if (xb_ld(&bar[XB_TMO])) break; if (sp > XB_SPIN_CAP) { atomicAdd(&bar[XB_TMO], 1u); break; } }
    }
    nloc = mine > 0u ? mine : 1u; nx = cnt > 0u ? cnt : 1u;
}

__device__ __forceinline__ void xcd_barrier(const XcdBarrier& b0_) {
    XcdBarrier b; b.bar = b0_.bar; b.st = b0_.st; b.x = xb_xcc_id(); { unsigned* bb = b.bar; asm volatile("" : "+s"(bb)); b.bar = bb; }
    asm volatile("s_waitcnt vmcnt(0)" ::: "memory");
    __syncthreads();
    if (threadIdx.x == 0) {
        unsigned* bar = b.bar;
        __builtin_amdgcn_s_waitcnt(0);
        unsigned nloc = b.st[0], nx = b.st[1];
        if (nloc == 0u) { xcd_barrier_complete(bar, b.x, nloc, nx); b.st[0] = nloc; b.st[1] = nx; }
        const unsigned old = xb_add(&bar[XB_XSUB(b.x)], 1u);
        const unsigned gen = old / nloc;
        if (old + 1u == (gen + 1u) * nloc) {
            __builtin_amdgcn_fence(__ATOMIC_RELEASE, "agent");
            asm volatile("s_waitcnt vmcnt(0)" ::: "memory");
            const unsigned og = xb_add(&bar[XB_TOP], 1u);
            const unsigned tg = og / nx;
            if (og + 1u == (tg + 1u) * nx) xb_add(&bar[XB_TOPGEN], 1u);
            else XB_SPIN(xb_ld(&bar[XB_TOPGEN]) == tg, bar);
            __builtin_amdgcn_fence(__ATOMIC_ACQUIRE, "agent");
            xb_add(&bar[XB_XGEN(b.x)], 1u);
            asm volatile("s_waitcnt vmcnt(0)" ::: "memory");
        } else {
            XB_SPIN(xb_ld(&bar[XB_XGEN(b.x)]) == gen, bar);
            __builtin_amdgcn_fence(__ATOMIC_ACQUIRE, "agent");
            asm volatile("s_waitcnt vmcnt(0)" ::: "memory");
        }
    }
    __syncthreads();
}


__global__ void __launch_bounds__(512) fwd_megakernel(Args a) {
    extern __shared__ __attribute__((aligned(16))) unsigned char lds_raw[];
    LAS unsigned char* lds = (LAS unsigned char*)lds_raw;
    cg::grid_group grid = cg::this_grid();
#define GSYNC() xcd_barrier(xbar)
    const int wave = __builtin_amdgcn_readfirstlane(threadIdx.x >> 6);
    const int G = gridDim.x, bx = blockIdx.x;
    volatile LAS unsigned* xst = (volatile LAS unsigned*)(lds + LDS_BYTES - 64);
    if (threadIdx.x < 2) xst[threadIdx.x] = 0u;
    __syncthreads();
    grid.sync();
    XcdBarrier xbar = xcd_barrier_post((unsigned*)(a.ws + WS_BAR), xst);
    const int vcu = (G % 8 == 0) ? (bx % 8) * (G / 8) + bx / 8 : bx;
    const int gw = vcu * 8 + wave, NGW = G * 8;
    unsigned char* ws = a.ws;
    float* X = a.out;
    bf16_t* XB = (bf16_t*)(ws + WS_XB); float* SSQ = (float*)(ws + WS_SSQ); float* SSQZ = (float*)(ws + WS_SSQZ);
    float* ROPEC = (float*)(ws + WS_ROPE); float* ROPES = ROPEC + SEQ * 32;
    bf16_t* Z = (bf16_t*)(ws + WS_R0); bf16_t* H = (bf16_t*)(ws + WS_R0); float* MG = (float*)(ws + WS_R0); bf16_t* MB = (bf16_t*)(ws + WS_R0 + 64 * MiB);
    bf16_t* GT = (bf16_t*)(ws + WS_G); bf16_t* QC = (bf16_t*)(ws + WS_QC); bf16_t* KC = (bf16_t*)(ws + WS_KC); bf16_t* VC = (bf16_t*)(ws + WS_VC);
    bf16_t* O3 = (bf16_t*)(ws + WS_O3); float* SCR = (float*)(ws + WS_SCR) + (size_t)bx * (512 * 64);

    {
        const float* xin = a.in[I_X]; const int lane = lane_id();
        for (int m = gw; m < M_TOK; m += NGW) {
            const f32x4* xr = (const f32x4*)(xin + (size_t)m * DM) + lane; u32x2* bo = (u32x2*)(XB + (size_t)m * DM) + lane;
            float s = 0.f;
#pragma unroll
            for (int j = 0; j < 4; ++j) { const f32x4 v = xr[64 * j]; s += dot4(v); u32x2 w; w.x = cvt_pk_bf16(v[0], v[1]); w.y = cvt_pk_bf16(v[2], v[3]); bo[64 * j] = w; }
            s = wave_sum(s);
            if (lane < 16) SSQ[(size_t)m * 16 + lane] = lane == 0 ? s : 0.f;
        }
        for (int i = gw * 64 + lane; i < SEQ * 32; i += NGW * 64) {
            const int pos = i >> 5, j = i & 31;
            const float inv_freq = (float)exp2(-(double)(2 * j) / 64.0 * 13.287712379549449);
            const float ang = (float)pos * inv_freq;
            const double rev = (double)ang * 0.15915494309189535; const float f = (float)(rev - floor(rev));
            ROPEC[i] = __builtin_amdgcn_cosf(f); ROPES[i] = __builtin_amdgcn_sinf(f);
        }
#ifndef NO_CONV
        convert_layer(a, 0, lds, gw, NGW, wave);
#endif
    }
    GSYNC();

    for (int l = 0; l < DEPTH; ++l) {
        for (int half = 0; half < 2; ++half) {
#ifndef NO_FFNUP
            { pg8::Gemm g{XB, (const bf16_t*)(ws + (half ? WS_W13B : WS_W13A)), M_TOK, 2 * FF, DM, DM, 31, 0}; pg8::StaticOrder S; S.init(M_TOK, 2 * FF, G, bx);
              EpiSwiGLU E{H, SSQ}; pg8::gemm_phase(lds, g, S, E, wave); }
#endif
            GSYNC();
#ifndef NO_FFNDN
            { pg8::Gemm g{H, (const bf16_t*)(ws + (half ? WS_W2B : WS_W2A)), M_TOK, DM, FF, FF, 31, 0}; pg8::StaticOrder S; S.init(M_TOK, DM, G, bx);
              EpiResid E{(l == 0 && half == 0) ? a.in[I_X] : (const float*)X, X, XB, SSQ, 0.5f};   pg8::gemm_phase(lds, g, S, E, wave); }
#endif
            if (half == 1) { if (l + 1 < DEPTH) convert_layer(a, l + 1, lds, gw, NGW, wave, 1); }
            else if (l > 0) convert_layer(a, l, lds, gw, NGW, wave, 2);
            GSYNC();
            if (half == 1) break;
#ifndef NO_INPROJ
            { pg8::Gemm g{XB, (const bf16_t*)(ws + WS_WIG), M_TOK, 6144, DM, DM, 31, 0}; pg8::StaticOrder S; S.init(M_TOK, 6144, G, bx);
              EpiInProj E{Z, GT, KC, SSQ, SSQZ, a.in[I_BGATE] + l * 3072, ROPEC, ROPES}; pg8::gemm_phase(lds, g, S, E, wave); }
#endif
            GSYNC();
#ifndef NO_UQ
            { pg8::Gemm g{Z + Z_CQ, (const bf16_t*)(ws + WS_WUQ), M_TOK, 768, 384, ZC, 31, 0}; pg8::StaticOrder S; S.init(M_TOK, 768, G, bx);
              EpiUQ E{QC, SSQZ, ROPEC, ROPES}; pg8::gemm_phase(lds, g, S, E, wave); }
#endif
#ifndef NO_UKV
            { pg8::Gemm g{Z + Z_CKV, (const bf16_t*)(ws + WS_WUKV), M_TOK, 1024, 256, ZC, 31, 0}; pg8::StaticOrder S; S.init(M_TOK, 1024, G, G - 1 - bx);
              EpiUKV E{KC, VC, SSQZ}; pg8::gemm_phase(lds, g, S, E, wave); }
#endif
            { unsigned* NRM = (unsigned*)(ws + WS_BAR + 32768) + l * 32; const int lane = lane_id(); float mx0 = 0.f, mx1 = 0.f;
              for (int m = gw; m < M_TOK; m += NGW) { const u32x4* zp = (const u32x4*)(Z + (size_t)m * ZC + lane * 16); const u32x4 w0 = zp[0], w1 = zp[1]; float sq = 0.f;
#pragma unroll
                  for (int i = 0; i < 4; ++i) { const float a0 = bf16_lo(w0[i]), a1 = bf16_hi(w0[i]), b0 = bf16_lo(w1[i]), b1 = bf16_hi(w1[i]); sq += (a0 * a0 + a1 * a1) + (b0 * b0 + b1 * b1); }
                  sq += shfl_xor_f(sq, 1); sq += shfl_xor_f(sq, 2);
                  if (m < SEQ) mx0 = fmaxf(mx0, sq); else mx1 = fmaxf(mx1, sq); }
              if ((lane & 3) == 0) { __hip_atomic_fetch_max(NRM + (lane >> 2), __float_as_uint(mx0), __ATOMIC_RELAXED, __HIP_MEMORY_SCOPE_AGENT);
                                     __hip_atomic_fetch_max(NRM + 16 + (lane >> 2), __float_as_uint(mx1), __ATOMIC_RELAXED, __HIP_MEMORY_SCOPE_AGENT); } }
            GSYNC();
            {
                LAS char* al = (LAS char*)lds;
                const int nslot = (G == 256) ? 6 : (1024 + G - 1) / G;
                for (int k_ = 0; k_ < nslot; ++k_) {
                    int L;
                    if (G == 256) {
                        if (vcu < 128) L = k_ < 2 ? 2 * vcu + k_ : k_ < 4 ? 512 + 2 * vcu + (k_ - 2) : (k_ == 4 && (vcu & 1)) ? 512 + 256 + (vcu >> 1) : -1;
                        else { const int u = (vcu - 128) & 63, hi_ = vcu >= 192, hh = k_ == 0 ? (hi_ ? 2 : 3) : (hi_ ? 1 : 0);
                               L = k_ < 2 ? 256 + (((u >> 5) * 4 + hh) << 5) + (u & 31) : hi_ ? (k_ < 4 ? 512 + 384 + 2 * u + (k_ - 2) : -1) : (k_ == 2 ? 512 + 320 + u : -1); }
                    } else { L = vcu + k_ * G; if (L >= 1024) L = -1; }
                    if (L < 0) continue;
                    if (L < 256) {
#ifndef NO_C
                        const int bh = L >> 5, qb = L & 31, b = bh >> 2, h = bh & 3; const size_t r0 = (size_t)b * SEQ + qb * 256;
                        att::EpiStoreBf16<4> E{O3 + r0 * 1536 + 1024 + h * 128, 1536};
                        att::attn_body_simple<192, 128, 0, 768, 768, 512>(QC + r0 * 768 + h * 192, KC + (size_t)b * SEQ * 768 + h * 192, VC + (size_t)b * SEQ * 512 + h * 128,
                                                                     0, SEQ / 64, qb * 256, 0.07216878364870322f, 0.f, 0.f, al, E, wave);
#endif
                    } else if (L < 512) {
#ifndef NO_A
                        const int u = L - 256, bh = u >> 5, qb = u & 31, b = bh >> 2, h = bh & 3; const size_t r0 = (size_t)b * SEQ + qb * 256;
                        int li = l; asm volatile("" : "+s"(li));
                        const float lam_init = __uint_as_float(li == 0 ? 0x3e4ccccdu : li == 1 ? 0x3eb60549u : li == 2 ? 0x3ef1014cu : 0x3f0e59d5u);
                        const float* lp = a.in[I_ALAM] + l * 256; const int lane = lane_id();
                        const float s01 = wave_sum(lp[lane] * lp[64 + lane]), s23 = wave_sum(lp[128 + lane] * lp[192 + lane]);
                        const float lam = uni(expf(s01) - expf(s23) + lam_init);
                        const float slope = uni(exp2f(-2.f * (float)(h + 1)));
                        const bf16_t* zb = Z + (size_t)b * SEQ * ZC;
                        int ks0, nt0, ks1, nt1, sf0 = 0, sf1 = 0;
                        { const unsigned* NRM = (const unsigned*)(ws + WS_BAR + 32768) + l * 32 + b * 16;
#pragma unroll
                          for (int mp = 0; mp < 2; ++mp) {
                              const float q2 = __uint_as_float(__hip_atomic_load(NRM + h * 2 + mp, __ATOMIC_RELAXED, __HIP_MEMORY_SCOPE_AGENT)), k2 = __uint_as_float(__hip_atomic_load(NRM + 8 + h * 2 + mp, __ATOMIC_RELAXED, __HIP_MEMORY_SCOPE_AGENT));
                              const float dmax = uni((2.f * 0.125f * sqrtf(q2 * k2) * 1.01f + 32.f) / slope);
                              const float lo_f = (float)(qb * 256) - dmax, hi_f = (float)(qb * 256 + 256) + dmax;
                              const int lo_i = lo_f <= 0.f ? 0 : ((int)lo_f >> 7) << 7; const int hi_i = hi_f >= (float)SEQ ? SEQ : ((((int)hi_f + 127) >> 7) << 7);
                              const int hi_c = hi_i > SEQ ? SEQ : hi_i;
                              const int sf = (2.f * 0.125f * sqrtf(q2 * k2) * 1.01f + 8.f) < 70.f;
                              if (mp == 0) { ks0 = lo_i; nt0 = (hi_c - lo_i) >> 6; sf0 = sf; } else { ks1 = lo_i; nt1 = (hi_c - lo_i) >> 6; sf1 = sf; } } }
                        { att::EpiDiff0 E{SCR};
                          ATT_A_BODY(Z + r0 * ZC + Z_AQ + h * 128, zb + Z_AK + h * 128, zb + Z_AV + h * 128, ks0, nt0, qb * 256, 0.125f, slope, 0.f, al, E, wave, sf0); }
                        { att::EpiDiff1 E{SCR, O3 + r0 * 1536 + h * 128, 1536, a.in[I_ASUB] + l * 128, lam, 1.f - lam_init};
                          ATT_A_BODY(Z + r0 * ZC + Z_AQ + h * 128 + 64, zb + Z_AK + h * 128 + 64, zb + Z_AV + h * 128, ks1, nt1, qb * 256, 0.125f, slope, 0.f, al, E, wave, sf1); }
#endif
                    } else {
#ifndef NO_B
                        const int u = L - 512, bh = u >> 5, qb = u & 31, b = bh >> 3, hq = bh & 7; const size_t r0 = (size_t)b * SEQ + qb * 256;
                        const int ks = qb * 256 - 128 < 0 ? 0 : qb * 256 - 128, ke = qb * 256 + 384 > SEQ ? SEQ : qb * 256 + 384;
                        const float slope = uni(exp2f(-(float)(hq + 1))); const float sink = uni(a.in[I_BSINK][l * 8 + hq]);
                        const bf16_t* zb = Z + (size_t)b * SEQ * ZC;
                        att::EpiStoreBf16<2> E{O3 + r0 * 1536 + 512 + hq * 64, 1536};
                        att::attn_body<64, 64, 2, 2, ZC, ZC, ZC>(Z + r0 * ZC + Z_BQ + hq * 64, zb + Z_BK + (hq >> 2) * 64, zb + Z_BV + (hq >> 2) * 64, ks, (ke - ks) / 64, qb * 256, 0.125f, slope, sink * LOG2E, al, E, wave);
#endif
                    }
                }
                __syncthreads();
            }
            GSYNC();
#ifndef NO_BR
            { pg8::Gemm g{O3, (const bf16_t*)(ws + WS_WB), M_TOK, 3072, 512, 1536, 2, 1024}; pg8::BranchOrder S; S.init(G, bx);
              EpiGateAcc E{GT, MG, MB}; pg8::gemm_phase(lds, g, S, E, wave); }
#endif
            GSYNC();
#ifndef NO_WOUT
            { pg8::Gemm g{MB, (const bf16_t*)(ws + WS_WO), M_TOK, DM, DM, DM, 31, 0}; pg8::StaticOrder S; S.init(M_TOK, DM, G, bx);
              EpiResid E{X, X, XB, SSQ, 1.0f}; pg8::gemm_phase(lds, g, S, E, wave); }
#endif
            GSYNC();
        }
    }
    {
        const float* fg = a.in[I_FINN]; const int lane = lane_id();
        for (int m = gw; m < M_TOK; m += NGW) {
            const float r = rinv_sum(SSQ + (size_t)m * 16, 4, 1.f / DM);
            f32x4* xo = (f32x4*)(X + (size_t)m * DM) + lane; const f32x4* gp = (const f32x4*)fg + lane;
#pragma unroll
            for (int j = 0; j < 4; ++j) { f32x4 v = xo[64 * j]; v = v * r * gp[64 * j]; xo[64 * j] = v; }
        }
    }
}

extern "C" void kernel_launch(void* const* d_in, const int* in_sizes, int n_in, void* d_out, int out_size, void* d_ws, size_t ws_size, hipStream_t stream) {
    static int grid = 0;
    if (grid == 0) {
        if (n_in != 21 || in_sizes[0] != M_TOK * DM || out_size != M_TOK * DM || ws_size < WS_END) {
            fprintf(stderr, "kernel_launch: shape/workspace mismatch (n_in %d, in0 %d, out %d, ws %zu, need %zu)\n", n_in, n_in > 0 ? in_sizes[0] : -1, out_size, ws_size, (size_t)WS_END); grid = -1; return; }
        int dev = 0, cus = 0, per_cu = 0;
        hipGetDevice(&dev); hipDeviceGetAttribute(&cus, hipDeviceAttributeMultiprocessorCount, dev);
        if (hipFuncSetAttribute((const void*)fwd_megakernel, hipFuncAttributeMaxDynamicSharedMemorySize, LDS_BYTES) != hipSuccess) { fprintf(stderr, "kernel_launch: hipFuncSetAttribute failed\n"); grid = -1; return; }
        if (hipOccupancyMaxActiveBlocksPerMultiprocessor(&per_cu, (const void*)fwd_megakernel, 512, LDS_BYTES) != hipSuccess || per_cu < 1) { fprintf(stderr, "kernel_launch: occupancy query failed (%d)\n", per_cu); per_cu = 1; }
        (void)hipGetLastError();
        grid = cus;
    }
    if (grid < 0) return;
    if (hipMemsetAsync((char*)d_ws + WS_BAR, 0, BAR_BYTES, stream) != hipSuccess) { fprintf(stderr, "kernel_launch: memset failed\n"); return; }
    Args a{};
    for (int i = 0; i < 21; ++i) a.in[i] = (const float*)d_in[i];
    a.out = (float*)d_out; a.ws = (unsigned char*)d_ws; a.ph_lo = 0; a.ph_hi = 0;
    void* args[] = {&a};
    hipError_t e = hipLaunchCooperativeKernel((const void*)fwd_megakernel, dim3(grid), dim3(512), args, LDS_BYTES, stream);
    if (e != hipSuccess) fprintf(stderr, "cooperative launch failed: %s (grid %d)\n", hipGetErrorString(e), grid);
}
```

```cpp
#include <hip/hip_runtime.h>
#include <hip/hip_cooperative_groups.h>
#include <cstdio>
#include <cstdint>
namespace cg = cooperative_groups;

#define LAS __attribute__((address_space(3)))
#define GAS __attribute__((address_space(1)))
typedef unsigned short bf16_t;
typedef short bf16x8 __attribute__((ext_vector_type(8)));
typedef short s16x4 __attribute__((ext_vector_type(4)));
typedef float f32x4 __attribute__((ext_vector_type(4)));
typedef float f32x16 __attribute__((ext_vector_type(16)));
typedef unsigned u32x4 __attribute__((ext_vector_type(4)));
typedef unsigned u32x2 __attribute__((ext_vector_type(2)));

constexpr int M_TOK = 16384, SEQ = 8192, DM = 1024, FF = 2816, DEPTH = 4;
constexpr int ZC = 3072;
constexpr int Z_AQ = 0, Z_AK = 512, Z_AV = 1024, Z_BQ = 1536, Z_BK = 2048, Z_BV = 2176, Z_CQ = 2304, Z_CKV = 2688, Z_CKR = 2944;
constexpr float EPS = 1e-6f;
constexpr float LOG2E = 1.4426950408889634f;

constexpr size_t MiB = 1u << 20;
constexpr size_t WS_W13A = 0, WS_W2A = 11 * MiB, WS_W13B = 33 * MiB / 2, WS_W2B = 55 * MiB / 2, WS_WIG = 33 * MiB, WS_WUQ = 45 * MiB,
                 WS_WUKV = 46 * MiB, WS_WB = 47 * MiB, WS_WO = 50 * MiB;
constexpr size_t WS_BAR = 54 * MiB, BAR_BYTES = 65536;
constexpr size_t WS_XB = 56 * MiB, WS_SSQ = 88 * MiB, WS_SSQZ = 89 * MiB, WS_ROPE = 91 * MiB;
constexpr size_t WS_R0 = 96 * MiB;
constexpr size_t WS_G = 192 * MiB, WS_QC = 288 * MiB, WS_KC = 312 * MiB, WS_VC = 336 * MiB, WS_O3 = 352 * MiB, WS_SCR = 400 * MiB, WS_END = 432 * MiB;

typedef float f32x2_t __attribute__((ext_vector_type(2)));
typedef __bf16 bf16x2_t __attribute__((ext_vector_type(2)));
__device__ __forceinline__ unsigned cvt_pk_bf16(float lo, float hi) { f32x2_t v = {lo, hi}; bf16x2_t b = __builtin_convertvector(v, bf16x2_t); return __builtin_bit_cast(unsigned, b); }
__device__ __forceinline__ int lane_id() { int r; asm volatile("v_mbcnt_lo_u32_b32 %0, -1, 0\n\tv_mbcnt_hi_u32_b32 %0, -1, %0" : "=v"(r)); return r; }
__device__ __forceinline__ float uni(float x) { return __int_as_float(__builtin_amdgcn_readfirstlane(__float_as_int(x))); }
__device__ __forceinline__ float shfl_xor_f(float v, int m) { return __int_as_float(__builtin_amdgcn_ds_bpermute((lane_id() ^ m) << 2, __float_as_int(v))); }
__device__ __forceinline__ float bf16_lo(unsigned w) { return __uint_as_float(w << 16); }
__device__ __forceinline__ float bf16_hi(unsigned w) { return __uint_as_float(w & 0xffff0000u); }
__device__ __forceinline__ float fast_rsq(float x) { return __builtin_amdgcn_rsqf(x); }
__device__ __forceinline__ float sum4(f32x4 a) { return (a.x + a.y) + (a.z + a.w); }
__device__ __forceinline__ float dot4(f32x4 a) { return (a.x * a.x + a.y * a.y) + (a.z * a.z + a.w * a.w); }

namespace pg8 {
constexpr int BM = 256, BK = 64, HALF = 128, HTB = HALF * BK * 2, STAGE_BYTES = 8 * HTB, NXCD = 8, WGM = 8;
__host__ __device__ __forceinline__ int lds_byte(int r, int c) { const int st = (r >> 4) * 2 + (c >> 5), rr = r & 15, cc = c & 31, ob = rr * 64 + cc * 2; return st * 1024 + (ob ^ (((ob >> 9) & 1) << 5)); }
__host__ __device__ __forceinline__ void stage_rc(int b, int& R, int& C) { const int st = b / 1024, sb = b % 1024, swz = sb ^ (((sb >> 9) & 1) << 5); R = (st >> 1) * 16 + swz / 64; C = (st & 1) * 32 + (swz % 64) / 2; }
__host__ __device__ __forceinline__ int perm32(int rho) { const int n = rho >> 4, i = rho & 15; return 8 * (i >> 2) + 4 * n + (i & 3); }

struct Unit { int pm, pn; };
struct Gemm { const bf16_t* A; const bf16_t* Bt; int M, N, K, lda, a_pn_shift, a_pn_stride; };

struct StaticOrder {
    int nM, nN, nwg, G, c;
    __device__ void init(int M, int N, int G_, int c_) { nM = M / BM; nN = N / BM; nwg = nM * nN; G = G_; c = c_; }
    __device__ bool next(int i, Unit& u) const {
        const long L = (long)i * G + c; if (L >= nwg) return false;
        int wgid = (int)L; { const int q = nwg / NXCD, r = nwg % NXCD, xcd = wgid % NXCD, off = wgid / NXCD; wgid = (xcd < r ? xcd * (q + 1) : r * (q + 1) + (xcd - r) * q) + off; }
        const int nig = WGM * nN, gid = wgid / nig, fm = gid * WGM, gsz = (nM - fm) < WGM ? (nM - fm) : WGM;
        u.pm = fm + ((wgid % nig) % gsz); u.pn = (wgid % nig) / gsz; return true;
    }
};
struct BranchOrder {
    StaticOrder so;
    __device__ void init(int G_, int c_) { so.init(M_TOK, DM, G_, c_); }
    __device__ bool next(int i, Unit& u) const { const int j = i / 3, n = i - 3 * j; Unit b; if (!so.next(j, b)) return false; u.pm = b.pm; u.pn = n * 4 + b.pn; return true; }
};

template <class Epi, class Sched>
__device__ __forceinline__ void gemm_phase(LAS unsigned char* lds, const Gemm g, const Sched& S, const Epi& E, int wave_) {
    int tid = wave_ * 64 + lane_id(); asm volatile("" : "+v"(tid));
    const int wid = __builtin_amdgcn_readfirstlane(tid >> 6), lane = tid & 63, wr = wid >> 2, wc = wid & 3, fr = lane & 15, fq = lane >> 4;
    const int K = g.K, nt = K / BK, lda = g.lda;
    const bf16_t* gA = g.A; const bf16_t* gB = g.Bt; asm volatile("" : "+s"(gA), "+s"(gB));
    unsigned voffA[2], voffB[2];
#pragma unroll
    for (int i = 0; i < 2; ++i) { int R, C; stage_rc(tid * 16 + i * 8192, R, C); const int Rb = Epi::PERM ? ((R & ~31) + perm32(R & 31)) : R;
        voffA[i] = (unsigned)(R * lda + C) * 2u; voffB[i] = (unsigned)(Rb * K + C) * 2u; }
    const size_t kstep = (size_t)(BK * 2);
    const size_t hstepA = (size_t)HALF * lda * 2, hstepB = (size_t)HALF * K * 2;
    const size_t tstepA = 2 * hstepA, tstepB = 2 * hstepB;
    const unsigned ldsw = (unsigned)wid * 1024u;
    const int aoff = lds_byte(wr * 64 + fr, fq * 8), boff = lds_byte(wc * 32 + fr, fq * 8);
#define PG8_SA(b, h) (((b) * 2 + (h)) * HTB)
#define PG8_SB(b, h) ((4 + (b) * 2 + (h)) * HTB)
#define PG8_STAGE(bufoff, gbase, voff) do { _Pragma("unroll") for (int _i = 0; _i < 2; ++_i) \
        __builtin_amdgcn_global_load_lds((const unsigned*)((const char*)(gbase) + (voff)[_i]), (LAS unsigned*)(lds + (bufoff) + ldsw + _i * 8192), 16, 0, 0); } while (0)
#define PG8_LDA(dst, b, h) do { _Pragma("unroll") for (int m = 0; m < 4; ++m) _Pragma("unroll") for (int k = 0; k < 2; ++k) dst[m][k] = *(const LAS bf16x8*)(lds + PG8_SA(b, h) + aoff + m * 2048 + k * 1024); } while (0)
#define PG8_LDB(dst, b, h) do { _Pragma("unroll") for (int n = 0; n < 2; ++n) _Pragma("unroll") for (int k = 0; k < 2; ++k) dst[n][k] = *(const LAS bf16x8*)(lds + PG8_SB(b, h) + boff + n * 2048 + k * 1024); } while (0)
#define PG8_MMA(ai, bj, At, Bt) do { __builtin_amdgcn_s_setprio(1); _Pragma("unroll") for (int m = 0; m < 4; ++m) _Pragma("unroll") for (int n = 0; n < 2; ++n) _Pragma("unroll") for (int k = 0; k < 2; ++k) \
        acc[ai][bj][m][n] = __builtin_amdgcn_mfma_f32_16x16x32_bf16(Bt[n][k], At[m][k], acc[ai][bj][m][n], 0, 0, 0); __builtin_amdgcn_s_setprio(0); } while (0)
#define PG8_WAIT_V(n) asm volatile("s_waitcnt vmcnt(" #n ")" ::: "memory")
#define PG8_WAIT_L(n) asm volatile("s_waitcnt lgkmcnt(" #n ")" ::: "memory")
#define PG8_BAR __builtin_amdgcn_s_barrier()
#define PG8_SCHED __builtin_amdgcn_sched_barrier(0)
#define PG8_APTR(u) ((const char*)gA + (size_t)(u).pm * tstepA + (size_t)((u).pn >> g.a_pn_shift) * (size_t)g.a_pn_stride)
    Unit cur, nxt; int ui = 0;
    if (!S.next(0, cur)) return;
    f32x4 acc[2][2][4][2];
#pragma unroll
    for (int a = 0; a < 2; ++a)
#pragma unroll
        for (int b = 0; b < 2; ++b)
#pragma unroll
            for (int m = 0; m < 4; ++m)
#pragma unroll
                for (int n = 0; n < 2; ++n) acc[a][b][m][n] = (f32x4){0.f, 0.f, 0.f, 0.f};
    bf16x8 At[4][2], B0[2][2], B1[2][2];
    const char* cA = PG8_APTR(cur); const char* cB = (const char*)gB + (size_t)cur.pn * tstepB;
    PG8_STAGE(PG8_SB(0, 0), cB, voffB); PG8_STAGE(PG8_SB(0, 1), cB + hstepB, voffB); PG8_STAGE(PG8_SA(0, 0), cA, voffA); PG8_STAGE(PG8_SA(0, 1), cA + hstepA, voffA);
    if (wr == 1) PG8_BAR;
    PG8_WAIT_V(2); PG8_BAR;
    PG8_STAGE(PG8_SB(1, 0), cB + kstep, voffB); PG8_STAGE(PG8_SA(1, 0), cA + kstep, voffA); PG8_STAGE(PG8_SB(1, 1), cB + hstepB + kstep, voffB);
    PG8_WAIT_V(6); PG8_BAR;
    for (;;) {
        const bool has_next = S.next(ui + 1, nxt);
        const char* nA = has_next ? PG8_APTR(nxt) : cA; const char* nB = has_next ? (const char*)gB + (size_t)nxt.pn * tstepB : cB;
        for (int t = 0; t < nt; t += 2) {
            const bool last = (t == nt - 2);
            const char* a1 = cA + (size_t)(t + 1) * kstep;
            const char* a2 = last ? nA : cA + (size_t)(t + 2) * kstep; const char* b2 = last ? nB : cB + (size_t)(t + 2) * kstep;
            const char* a3 = a2 + kstep; const char* b3 = b2 + kstep;
            PG8_LDB(B0, 0, 0); PG8_LDB(B1, 0, 1); PG8_SCHED; PG8_LDA(At, 0, 0); PG8_STAGE(PG8_SA(1, 1), a1 + hstepA, voffA);
            PG8_WAIT_V(8); PG8_WAIT_L(0); PG8_BAR; PG8_MMA(0, 0, At, B0); PG8_MMA(0, 1, At, B1); PG8_BAR; PG8_SCHED;
            PG8_LDA(At, 0, 1); PG8_STAGE(PG8_SB(0, 0), b2, voffB); PG8_STAGE(PG8_SB(0, 1), b2 + hstepB, voffB); PG8_STAGE(PG8_SA(0, 0), a2, voffA);
            PG8_WAIT_V(8); PG8_WAIT_L(0); PG8_BAR; PG8_MMA(1, 0, At, B0); PG8_MMA(1, 1, At, B1); PG8_BAR; PG8_SCHED;
            PG8_LDB(B0, 1, 0); PG8_LDB(B1, 1, 1); PG8_SCHED; PG8_LDA(At, 1, 0); PG8_STAGE(PG8_SA(0, 1), a2 + hstepA, voffA);
            PG8_WAIT_V(8); PG8_WAIT_L(0); PG8_BAR; PG8_MMA(0, 0, At, B0); PG8_MMA(0, 1, At, B1); PG8_BAR; PG8_SCHED;
            PG8_LDA(At, 1, 1); PG8_STAGE(PG8_SB(1, 0), b3, voffB); PG8_STAGE(PG8_SB(1, 1), b3 + hstepB, voffB); PG8_STAGE(PG8_SA(1, 0), a3, voffA);
            PG8_WAIT_V(8); PG8_WAIT_L(0); PG8_BAR; PG8_MMA(1, 0, At, B0); PG8_MMA(1, 1, At, B1); PG8_BAR; PG8_SCHED;
        }
        if (wr == 0) PG8_BAR;
        E(acc, cur, wr, wc, fr, fq);
        if (!has_next) break;
#pragma unroll
        for (int a = 0; a < 2; ++a)
#pragma unroll
            for (int b = 0; b < 2; ++b)
#pragma unroll
                for (int m = 0; m < 4; ++m)
#pragma unroll
                    for (int n = 0; n < 2; ++n) acc[a][b][m][n] = (f32x4){0.f, 0.f, 0.f, 0.f};
        cur = nxt; cA = nA; cB = nB; ++ui;
        if (wr == 1) PG8_BAR;
    }
    PG8_WAIT_V(0);
    PG8_BAR;
#undef PG8_SA
#undef PG8_SB
#undef PG8_STAGE
#undef PG8_LDA
#undef PG8_LDB
#undef PG8_MMA
#undef PG8_WAIT_V
#undef PG8_WAIT_L
#undef PG8_BAR
#undef PG8_SCHED
#undef PG8_APTR
}
}

typedef f32x4 Acc[2][2][4][2];
__device__ __forceinline__ float rinv_sum(const float* p, int n4, float invn) {
    float s = 0.f;
#pragma unroll
    for (int i = 0; i < 5; ++i) if (i < n4) s += sum4(*(const f32x4*)(p + 4 * i));
    return fast_rsq(s * invn + EPS);
}
__device__ __forceinline__ float silu_mul(float a, float g) { return a * __builtin_amdgcn_rcpf(1.f + __builtin_amdgcn_exp2f(-a * LOG2E)) * g; }
__device__ __forceinline__ float sigmoidf(float a) { return __builtin_amdgcn_rcpf(1.f + __builtin_amdgcn_exp2f(-a * LOG2E)); }
__device__ __forceinline__ u32x4 pack8(f32x4 v0, f32x4 v1) { u32x4 w; w.x = cvt_pk_bf16(v0[0], v0[1]); w.y = cvt_pk_bf16(v0[2], v0[3]); w.z = cvt_pk_bf16(v1[0], v1[1]); w.w = cvt_pk_bf16(v1[2], v1[3]); return w; }

struct EpiSwiGLU {
    static constexpr bool PERM = true;
    bf16_t* H; const float* ssq;
    __device__ __forceinline__ void operator()(const Acc& acc, const pg8::Unit& u, int wr, int wc, int fr, int fq) const {
        const int row0 = u.pm * 256 + wr * 64 + fr, col0 = u.pn * 128 + wc * 32 + 8 * fq;
#pragma unroll
        for (int ai = 0; ai < 2; ++ai)
#pragma unroll
            for (int m = 0; m < 4; ++m) { const int row = row0 + ai * 128 + m * 16; const float r = rinv_sum(ssq + (size_t)row * 16, 4, 1.f / DM);
                f32x4 h0, h1;
#pragma unroll
                for (int j = 0; j < 4; ++j) { h0[j] = silu_mul(acc[ai][0][m][0][j] * r, acc[ai][1][m][0][j] * r); h1[j] = silu_mul(acc[ai][0][m][1][j] * r, acc[ai][1][m][1][j] * r); }
                *(u32x4*)(H + (size_t)row * FF + col0) = pack8(h0, h1); asm volatile("" ::: "memory"); }
    }
};
struct EpiResid {
    static constexpr bool PERM = false;
    const float* xin; float* x; bf16_t* xb; float* ssq; float coef;
    __device__ __forceinline__ void operator()(const Acc& acc, const pg8::Unit& u, int wr, int wc, int fr, int fq) const {
        const int row0 = u.pm * 256 + wr * 64 + fr, col0 = u.pn * 256 + wc * 32 + 4 * fq;
#pragma unroll
        for (int ai = 0; ai < 2; ++ai) {
            f32x4 xv[4][2][2];
#pragma unroll
            for (int m = 0; m < 4; ++m)
#pragma unroll
                for (int bj = 0; bj < 2; ++bj)
#pragma unroll
                    for (int n = 0; n < 2; ++n) xv[m][bj][n] = *(const f32x4*)(xin + (size_t)(row0 + ai * 128 + m * 16) * DM + col0 + bj * 128 + n * 16);
#pragma unroll
            for (int m = 0; m < 4; ++m) { const int row = row0 + ai * 128 + m * 16; float s = 0.f;
#pragma unroll
                for (int bj = 0; bj < 2; ++bj)
#pragma unroll
                    for (int n = 0; n < 2; ++n) { const size_t off = (size_t)row * DM + col0 + bj * 128 + n * 16;
                        const f32x4 v = xv[m][bj][n] + acc[ai][bj][m][n] * coef;
                        *(f32x4*)(x + off) = v; s += dot4(v);
                        u32x2 w; w.x = cvt_pk_bf16(v[0], v[1]); w.y = cvt_pk_bf16(v[2], v[3]); *(u32x2*)(xb + off) = w; }
                s += shfl_xor_f(s, 16); s += shfl_xor_f(s, 32);
                if (fq == 0) ssq[(size_t)row * 16 + u.pn * 4 + wc] = s; }
            asm volatile("" ::: "memory"); }
    }
};
struct EpiInProj {
    static constexpr bool PERM = true;
    bf16_t* Z; bf16_t* Gt; bf16_t* KC; const float* ssq; float* ssqz; const float* bgate; const float* ropeC; const float* ropeS;
    __device__ __forceinline__ void operator()(const Acc& acc, const pg8::Unit& u, int wr, int wc, int fr, int fq) const {
        const int row0 = u.pm * 256 + wr * 64 + fr, cw = wc * 32 + 8 * fq;
        if (u.pn < 12) {
#pragma unroll
            for (int ai = 0; ai < 2; ++ai)
#pragma unroll
                for (int m = 0; m < 4; ++m) { const int row = row0 + ai * 128 + m * 16; const float r = rinv_sum(ssq + (size_t)row * 16, 4, 1.f / DM);
#pragma unroll
                    for (int bj = 0; bj < 2; ++bj) { f32x4 v0 = acc[ai][bj][m][0] * r, v1 = acc[ai][bj][m][1] * r;
                        if (u.pn >= 9) { float s = dot4(v0) + dot4(v1); s += shfl_xor_f(s, 16); s += shfl_xor_f(s, 32);
                            if (fq == 0) ssqz[(size_t)row * 24 + (u.pn - 9) * 8 + bj * 4 + wc] = s; }
                        if (u.pn == 11 && bj == 1 && wc < 2) {
                            const int pos = row & (SEQ - 1), j0 = 16 * wc + 4 * fq;
                            const f32x4 c = *(const f32x4*)(ropeC + pos * 32 + j0), s = *(const f32x4*)(ropeS + pos * 32 + j0);
                            f32x4 o0, o1;
                            o0[0] = v0[0] * c[0] - v0[1] * s[0]; o0[1] = v0[0] * s[0] + v0[1] * c[0]; o0[2] = v0[2] * c[1] - v0[3] * s[1]; o0[3] = v0[2] * s[1] + v0[3] * c[1];
                            o1[0] = v1[0] * c[2] - v1[1] * s[2]; o1[1] = v1[0] * s[2] + v1[1] * c[2]; o1[2] = v1[2] * c[3] - v1[3] * s[3]; o1[3] = v1[2] * s[3] + v1[3] * c[3];
                            const u32x4 w = pack8(o0, o1);
#pragma unroll
                            for (int h = 0; h < 4; ++h) *(u32x4*)(KC + (size_t)row * 768 + h * 192 + 128 + cw) = w;
                        }
                        *(u32x4*)(Z + (size_t)row * ZC + u.pn * 256 + bj * 128 + cw) = pack8(v0, v1); } asm volatile("" ::: "memory"); }
        } else {
            const int gc0 = (u.pn - 12) * 256 + cw;
#pragma unroll
            for (int bj = 0; bj < 2; ++bj) { const f32x4 b0 = *(const f32x4*)(bgate + gc0 + bj * 128), b1 = *(const f32x4*)(bgate + gc0 + bj * 128 + 4);
#pragma unroll
                for (int ai = 0; ai < 2; ++ai)
#pragma unroll
                    for (int m = 0; m < 4; ++m) { const int row = row0 + ai * 128 + m * 16; const float r = rinv_sum(ssq + (size_t)row * 16, 4, 1.f / DM);
                        f32x4 v0 = acc[ai][bj][m][0] * r + b0, v1 = acc[ai][bj][m][1] * r + b1;
#pragma unroll
                        for (int j = 0; j < 4; ++j) { v0[j] = sigmoidf(v0[j]); v1[j] = sigmoidf(v1[j]); }
                        *(u32x4*)(Gt + (size_t)row * 3072 + gc0 + bj * 128) = pack8(v0, v1); asm volatile("" ::: "memory"); } }
        }
    }
};
struct EpiUQ {
    static constexpr bool PERM = true;
    bf16_t* QC; const float* ssqz; const float* ropeC; const float* ropeS;
    __device__ __forceinline__ void operator()(const Acc& acc, const pg8::Unit& u, int wr, int wc, int fr, int fq) const {
        const int row0 = u.pm * 256 + wr * 64 + fr;
#pragma unroll
        for (int ai = 0; ai < 2; ++ai)
#pragma unroll
            for (int m = 0; m < 4; ++m) { const int row = row0 + ai * 128 + m * 16; const float r = rinv_sum(ssqz + (size_t)row * 24, 3, 1.f / 384.f);
#pragma unroll
                for (int bj = 0; bj < 2; ++bj) { const int c = u.pn * 256 + bj * 128 + wc * 32 + 8 * fq; const int e = c % 192;
                    f32x4 v0 = acc[ai][bj][m][0] * r, v1 = acc[ai][bj][m][1] * r;
                    if (e >= 128) { const int pos = row & (SEQ - 1), j0 = (e - 128) >> 1;
                        const f32x4 cc = *(const f32x4*)(ropeC + pos * 32 + j0), s = *(const f32x4*)(ropeS + pos * 32 + j0);
                        f32x4 o0, o1;
                        o0[0] = v0[0] * cc[0] - v0[1] * s[0]; o0[1] = v0[0] * s[0] + v0[1] * cc[0]; o0[2] = v0[2] * cc[1] - v0[3] * s[1]; o0[3] = v0[2] * s[1] + v0[3] * cc[1];
                        o1[0] = v1[0] * cc[2] - v1[1] * s[2]; o1[1] = v1[0] * s[2] + v1[1] * cc[2]; o1[2] = v1[2] * cc[3] - v1[3] * s[3]; o1[3] = v1[2] * s[3] + v1[3] * cc[3];
                        v0 = o0; v1 = o1; }
                    *(u32x4*)(QC + (size_t)row * 768 + c) = pack8(v0, v1); } asm volatile("" ::: "memory"); }
    }
};
struct EpiUKV {
    static constexpr bool PERM = true;
    bf16_t* KC; bf16_t* VC; const float* ssqz;
    __device__ __forceinline__ void operator()(const Acc& acc, const pg8::Unit& u, int wr, int wc, int fr, int fq) const {
        const int row0 = u.pm * 256 + wr * 64 + fr, cw = wc * 32 + 8 * fq, h = u.pn;
#pragma unroll
        for (int ai = 0; ai < 2; ++ai)
#pragma unroll
            for (int m = 0; m < 4; ++m) { const int row = row0 + ai * 128 + m * 16; const float r = rinv_sum(ssqz + (size_t)row * 24 + 12, 2, 1.f / 256.f);
                *(u32x4*)(KC + (size_t)row * 768 + h * 192 + cw) = pack8(acc[ai][0][m][0] * r, acc[ai][0][m][1] * r);
                *(u32x4*)(VC + (size_t)row * 512 + h * 128 + cw) = pack8(acc[ai][1][m][0] * r, acc[ai][1][m][1] * r); asm volatile("" ::: "memory"); }
    }
};
struct EpiGateAcc {
    static constexpr bool PERM = true;
    const bf16_t* Gt; float* mg; bf16_t* MB;
    __device__ __forceinline__ void operator()(const Acc& acc, const pg8::Unit& u, int wr, int wc, int fr, int fq) const {
        const int nb = u.pn >> 2, pno = u.pn & 3;
        const int row0 = u.pm * 256 + wr * 64 + fr, col0 = pno * 256 + wc * 32 + 8 * fq;
        bf16_t* mgb = (bf16_t*)mg;
#pragma unroll
        for (int ai = 0; ai < 2; ++ai)
#pragma unroll
            for (int m = 0; m < 4; ++m) { const int row = row0 + ai * 128 + m * 16;
#pragma unroll
                for (int bj = 0; bj < 2; ++bj) { const int col = col0 + bj * 128; const size_t off = (size_t)row * DM + col;
                    const u32x4 gw = *(const u32x4*)(Gt + (size_t)row * 3072 + nb * 1024 + col);
                    f32x4 v0 = acc[ai][bj][m][0], v1 = acc[ai][bj][m][1];
                    v0[0] *= bf16_lo(gw.x); v0[1] *= bf16_hi(gw.x); v0[2] *= bf16_lo(gw.y); v0[3] *= bf16_hi(gw.y);
                    v1[0] *= bf16_lo(gw.z); v1[1] *= bf16_hi(gw.z); v1[2] *= bf16_lo(gw.w); v1[3] *= bf16_hi(gw.w);
                    if (nb > 0) { const u32x4 pw = *(const u32x4*)(mgb + off);
                        v0[0] += bf16_lo(pw.x); v0[1] += bf16_hi(pw.x); v0[2] += bf16_lo(pw.y); v0[3] += bf16_hi(pw.y);
                        v1[0] += bf16_lo(pw.z); v1[1] += bf16_hi(pw.z); v1[2] += bf16_lo(pw.w); v1[3] += bf16_hi(pw.w); }
                    *(u32x4*)((nb < 2 ? mgb : MB) + off) = pack8(v0, v1); }
                asm volatile("" ::: "memory"); }
    }
};


#ifdef A_SIMPLE
#define ATT_A_BODY att::attn_body_simple<64, 128, 1, ZC, ZC, ZC>
#else
#define ATT_A_BODY att::attn_body<64, 128, 1, 1, ZC, ZC, ZC>
#endif
namespace att {
#define SBAR() __builtin_amdgcn_sched_barrier(0)
__device__ __forceinline__ int crow(int r, int hi) { return (r & 3) + 8 * (r >> 2) + 4 * hi; }
template <int DQK> __device__ __forceinline__ int kswz(int row, int colB) { return row * (DQK * 2) + (colB ^ (((row >> 1) & 7) << 4)); }
template <int DV> __device__ __forceinline__ int v_st(int k, int c) { constexpr int NCB = DV / 32; const int kk = (k & ~0xC) | ((k & 4) << 1) | ((k & 8) >> 1); return ((kk >> 3) * NCB + (c >> 5)) * 512 + ((kk & 7) * 32 + (c & 31)) * 2; }
__device__ __forceinline__ int v_rd_base(int lane) { return ((lane & 3) << 3) | (((lane >> 2) & 3) << 6) | (((lane >> 4) & 1) << 5) | (((lane >> 5) & 1) << 8); }
template <int DV> constexpr int v_rd_off(int d0, int ks, int half) { return d0 * 512 + ks * (2 * (DV / 32) * 512) + half * ((DV / 32) * 512); }
template <int OFF> __device__ __forceinline__ s16x4 tr_read(int vb) { s16x4 r; asm volatile("ds_read_b64_tr_b16 %0, %1 offset:%2" : "=&v"(r) : "v"(vb), "i"(OFF) : "memory"); return r; }

__device__ __forceinline__ void partialSM(f32x16& p0, f32x16& p1, float& m_reg, float& mn, float& alpha, float C, float thr, float aoff = 0.f, bool nomax = false) {
    if (nomax) { mn = m_reg; alpha = 1.f; }
    else {
    float pmax = p0[0];
#pragma unroll
    for (int r = 1; r < 16; ++r) pmax = fmaxf(pmax, p0[r]);
#pragma unroll
    for (int r = 0; r < 16; ++r) pmax = fmaxf(pmax, p1[r]);
    pmax += aoff;
    { auto rr = __builtin_amdgcn_permlane32_swap(__float_as_uint(pmax), __float_as_uint(pmax), false, false); pmax = fmaxf(__uint_as_float(rr[0]), __uint_as_float(rr[1])); }
    if (__builtin_expect(__all(pmax - m_reg <= thr), 1)) { mn = m_reg; alpha = 1.f; }
    else { mn = fmaxf(m_reg, pmax); alpha = __builtin_amdgcn_exp2f((m_reg - mn) * C); m_reg = mn; }
    }
    const float mnC = mn < -1e29f ? 0.f : (aoff - mn) * C;
#pragma unroll
    for (int r = 0; r < 16; ++r) p0[r] = fmaf(p0[r], C, mnC);
#pragma unroll
    for (int r = 0; r < 16; ++r) p1[r] = fmaf(p1[r], C, mnC);
#pragma unroll
    for (int r = 0; r < 16; ++r) p0[r] = __builtin_amdgcn_exp2f(p0[r]);
}
__device__ __forceinline__ void finishSM(f32x16& p0, f32x16& p1, float alpha, float& l_reg, bf16x8& pa0, bf16x8& pa1, bf16x8& pa2, bf16x8& pa3) {
#pragma unroll
    for (int r = 0; r < 16; ++r) p1[r] = __builtin_amdgcn_exp2f(p1[r]);
    float ps = 0;
#pragma unroll
    for (int r = 0; r < 16; ++r) ps += p0[r];
#pragma unroll
    for (int r = 0; r < 16; ++r) ps += p1[r];
    { auto rr = __builtin_amdgcn_permlane32_swap(__float_as_uint(ps), __float_as_uint(ps), false, false); ps = __uint_as_float(rr[0]) + __uint_as_float(rr[1]); }
    l_reg = l_reg * alpha + ps;
#define PK4(P, BASE, OUT) do { unsigned a0 = cvt_pk_bf16(P[BASE + 0], P[BASE + 1]), a1 = cvt_pk_bf16(P[BASE + 2], P[BASE + 3]);   \
    unsigned b0 = cvt_pk_bf16(P[BASE + 4], P[BASE + 5]), b1 = cvt_pk_bf16(P[BASE + 6], P[BASE + 7]);                              \
    auto r0 = __builtin_amdgcn_permlane32_swap(a0, b0, false, false); auto r1 = __builtin_amdgcn_permlane32_swap(a1, b1, false, false); \
    u32x4 w = {r0[0], r1[0], r0[1], r1[1]}; OUT = *reinterpret_cast<bf16x8*>(&w); } while (0)
    PK4(p0, 0, pa0); PK4(p0, 8, pa1); PK4(p1, 0, pa2); PK4(p1, 8, pa3);
#undef PK4
}
template <int MODE> __device__ __forceinline__ float alibi_off(int rel, float dq, float sl) { return (MODE == 1 && (rel > 63 || rel < -31)) ? (rel > 63 ? -sl : sl) * dq : 0.f; }
template <int DQK, int MODE, int NQR = DQK / 16> __device__ __forceinline__ void qkt(f32x16& p0, f32x16& p1, LAS const char* Ks, const bf16x8* qr, int r32, int hi, float dq, float sl, LAS const char* qlds = nullptr, int rel = 0) {
    p0 = f32x16{}; p1 = f32x16{};
    if (NQR < DQK / 16) asm volatile("" : "+v"(qlds));
    const int x_ = ((r32 >> 1) & 7) << 4; int kb[4];
#pragma unroll
    for (int j = 0; j < 4; ++j) kb[j] = r32 * (DQK * 2) + ((j * 32 + hi * 16) ^ x_);
#pragma unroll
    for (int d0 = 0; d0 < DQK / 16; ++d0) {
        bf16x8 qf; if (d0 < NQR) qf = qr[d0 < NQR ? d0 : 0]; else qf = *(LAS const bf16x8*)(qlds + (d0 - NQR) * 1024);
        const bf16x8 b0 = *(LAS const bf16x8*)(Ks + kb[d0 & 3] + (d0 >> 2) * 128);
        const bf16x8 b1 = *(LAS const bf16x8*)(Ks + kb[d0 & 3] + (d0 >> 2) * 128 + 32 * (DQK * 2));
        p0 = __builtin_amdgcn_mfma_f32_32x32x16_bf16(b0, qf, p0, 0, 0, 0);
        p1 = __builtin_amdgcn_mfma_f32_32x32x16_bf16(b1, qf, p1, 0, 0, 0); }
    if (MODE == 1 && (rel > 63 || rel < -31)) {
        const float ss = rel > 63 ? sl : -sl;
#pragma unroll
        for (int r = 0; r < 16; ++r) { const float c = (float)((r & 3) + 8 * (r >> 2)); p0[r] = fmaf(ss, c, p0[r]); p1[r] = fmaf(ss, c + 32.f, p1[r]); }
    } else if (MODE != 0) {
#pragma unroll
        for (int r = 0; r < 16; ++r) { const float c = (float)((r & 3) + 8 * (r >> 2)); const float d0 = fabsf(dq - c), d1 = fabsf(dq - 32.f - c);
            if (MODE == 1) { p0[r] = fmaf(-sl, d0, p0[r]); p1[r] = fmaf(-sl, d1, p1[r]); }
            else { p0[r] = d0 > 128.f ? -1e30f : fmaf(-sl, d0, p0[r]); p1[r] = d1 > 128.f ? -1e30f : fmaf(-sl, d1, p1[r]); } }
    }
}
template <int D0, int DV> __device__ __forceinline__ void pv_one(f32x16& od, int vb, bf16x8 pa0, bf16x8 pa1, bf16x8 pa2, bf16x8 pa3) {
    const s16x4 l0 = tr_read<v_rd_off<DV>(D0, 0, 0)>(vb), h0 = tr_read<v_rd_off<DV>(D0, 0, 1)>(vb), l1 = tr_read<v_rd_off<DV>(D0, 1, 0)>(vb), h1 = tr_read<v_rd_off<DV>(D0, 1, 1)>(vb);
    const s16x4 l2 = tr_read<v_rd_off<DV>(D0, 2, 0)>(vb), h2 = tr_read<v_rd_off<DV>(D0, 2, 1)>(vb), l3 = tr_read<v_rd_off<DV>(D0, 3, 0)>(vb), h3 = tr_read<v_rd_off<DV>(D0, 3, 1)>(vb);
    asm volatile("s_waitcnt lgkmcnt(0)" ::: "memory"); SBAR();
#define PK(L, H) (bf16x8){L[0], L[1], L[2], L[3], H[0], H[1], H[2], H[3]}
    od = __builtin_amdgcn_mfma_f32_32x32x16_bf16(pa0, PK(l0, h0), od, 0, 0, 0);
    od = __builtin_amdgcn_mfma_f32_32x32x16_bf16(pa1, PK(l1, h1), od, 0, 0, 0);
    od = __builtin_amdgcn_mfma_f32_32x32x16_bf16(pa2, PK(l2, h2), od, 0, 0, 0);
    od = __builtin_amdgcn_mfma_f32_32x32x16_bf16(pa3, PK(l3, h3), od, 0, 0, 0);
#undef PK
}
template <int DV> __device__ __forceinline__ void pv_all(f32x16* o, int vb, bf16x8 pa0, bf16x8 pa1, bf16x8 pa2, bf16x8 pa3) {
    pv_one<0, DV>(o[0], vb, pa0, pa1, pa2, pa3); pv_one<1, DV>(o[1], vb, pa0, pa1, pa2, pa3);
    if constexpr (DV == 128) { pv_one<2, DV>(o[2], vb, pa0, pa1, pa2, pa3); pv_one<3, DV>(o[3], vb, pa0, pa1, pa2, pa3); }
}

template <int DQK, int DV, int MODE, int SD, int LDQ, int LDK, int LDV, int NQL = 0, class Epi>
__device__ __forceinline__ void attn_body(const bf16_t* __restrict__ Qb, const bf16_t* __restrict__ Kh, const bf16_t* __restrict__ Vh, int kstart, int NT, int qpos0,
                                          float scale, float slope, float sinkl2, LAS char* lds, const Epi& epi, int wave_, int safe_nomax = 0) {
    asm volatile("" : "+s"(Qb), "+s"(Kh), "+s"(Vh));
    constexpr int SHM_V = 64 * DV * 2, SHM_K = 64 * DQK * 2, NQ = DQK / 16, NO = DV / 32;
    constexpr int KCH = DQK / 8, NKC = 64 * KCH / 512, VCH = DV / 8, NVC = 64 * VCH / 512;
    int tid = wave_ * 64 + lane_id(); asm volatile("" : "+v"(tid));
    const int wid = tid >> 6, lane = tid & 63, r32 = lane & 31, hi = lane >> 5;
    LAS char* V_lds = lds; LAS char* K_lds = lds + 2 * SHM_V;
    LAS float* wsf = (LAS float*)(lds + 2 * SHM_V + 2 * SHM_K) + wid * 64; LAS float* li_l = wsf; LAS float* al_l = wsf + 32;
    const float C = scale * LOG2E, thr = 8.f / scale, sl = slope / scale;
    const float dq0 = (float)(qpos0 + wid * 32 + r32 - kstart - 4 * hi);
    constexpr int NQR = NQ - NQL;
    LAS char* qlds = lds + 2 * SHM_V + 2 * SHM_K + 2048 + wid * (NQL * 1024) + lane * 16;
    float m_reg = -1e30f, l_reg = 0; f32x16 o[NO]; bf16x8 qr[NQR > 0 ? NQR : 1];
#pragma unroll
    for (int d = 0; d < NO; ++d) o[d] = f32x16{};
    const GAS bf16_t* Qw = (const GAS bf16_t*)Qb + (size_t)(wid * 32 + r32) * LDQ + hi * 8;
#pragma unroll
    for (int d0 = 0; d0 < NQ; ++d0) { const bf16x8 qv = *(const GAS bf16x8*)(Qw + d0 * 16); if (d0 < NQR) qr[d0 < NQR ? d0 : 0] = qv; else *(LAS bf16x8*)(qlds + (d0 - NQR) * 1024) = qv; }
    int koff[NKC], kst[NKC], voff[NVC], vst[NVC];
#pragma unroll
    for (int i = 0; i < NKC; ++i) { const int c = tid + 512 * i, row = c / KCH, c8 = c % KCH; koff[i] = row * LDK + c8 * 8; kst[i] = kswz<DQK>(row, c8 * 16); }
#pragma unroll
    for (int i = 0; i < NVC; ++i) { const int c = tid + 512 * i, row = c / VCH, c8 = c % VCH; voff[i] = row * LDV + c8 * 8; vst[i] = v_st<DV>(row, c8 * 8); }
    const int vb0 = (int)(unsigned)(size_t)V_lds + v_rd_base(lane);
    struct { bf16x8 k[NKC]; bf16x8 v[NVC]; } sr_[SD];
    const GAS bf16_t* Kp = (const GAS bf16_t*)Kh + (size_t)kstart * LDK; const GAS bf16_t* Vp = (const GAS bf16_t*)Vh + (size_t)kstart * LDV;
#define SLOAD(i, k0) do { if constexpr (NQL > 0) { int t_ = tid; asm volatile("" : "+v"(t_)); \
      _Pragma("unroll") for (int _c = 0; _c < NVC; ++_c) { const int c_ = t_ + 512 * _c; sr_[i].v[_c] = *(const GAS bf16x8*)(Vp + (size_t)((k0) + c_ / VCH) * LDV + (c_ % VCH) * 8); } \
      _Pragma("unroll") for (int _c = 0; _c < NKC; ++_c) { const int c_ = t_ + 512 * _c; sr_[i].k[_c] = *(const GAS bf16x8*)(Kp + (size_t)((k0) + c_ / KCH) * LDK + (c_ % KCH) * 8); } } else { \
    _Pragma("unroll") for (int _c = 0; _c < NVC; ++_c) sr_[i].v[_c] = *(const GAS bf16x8*)(Vp + (size_t)(k0) * LDV + voff[_c]); \
    _Pragma("unroll") for (int _c = 0; _c < NKC; ++_c) sr_[i].k[_c] = *(const GAS bf16x8*)(Kp + (size_t)(k0) * LDK + koff[_c]); } } while (0)
#define SWRITE(b, i) do { if constexpr (NQL > 0) { int t_ = tid; asm volatile("" : "+v"(t_)); \
      _Pragma("unroll") for (int _c = 0; _c < NVC; ++_c) { const int c_ = t_ + 512 * _c; *(LAS bf16x8*)(V_lds + (b) * SHM_V + v_st<DV>(c_ / VCH, (c_ % VCH) * 8)) = sr_[i].v[_c]; } \
      _Pragma("unroll") for (int _c = 0; _c < NKC; ++_c) { const int c_ = t_ + 512 * _c; *(LAS bf16x8*)(K_lds + (b) * SHM_K + kswz<DQK>(c_ / KCH, (c_ % KCH) * 16)) = sr_[i].k[_c]; } } else { \
    _Pragma("unroll") for (int _c = 0; _c < NVC; ++_c) *(LAS bf16x8*)(V_lds + (b) * SHM_V + vst[_c]) = sr_[i].v[_c]; \
    _Pragma("unroll") for (int _c = 0; _c < NKC; ++_c) *(LAS bf16x8*)(K_lds + (b) * SHM_K + kst[_c]) = sr_[i].k[_c]; } } while (0)
#define RESC(a) do { if (__any((a) < 1.f)) { if (hi == 0) al_l[r32] = (a); asm volatile("s_waitcnt lgkmcnt(0)" ::: "memory"); \
    _Pragma("unroll") for (int d = 0; d < NO; ++d) _Pragma("unroll") for (int r = 0; r < 16; ++r) o[d][r] *= al_l[crow(r, hi)]; } } while (0)
    f32x16 pA0, pA1, pB0, pB1; float mnA, mnB, alA, alB; bf16x8 pa0, pa1, pa2, pa3;
    const int rel0 = qpos0 + __builtin_amdgcn_readfirstlane(wid) * 32 - kstart;
    constexpr int SE = 0, SO = SD - 1;
    __syncthreads();
    SLOAD(SE, 0); asm volatile("s_waitcnt vmcnt(0)" ::: "memory"); SWRITE(0, SE); __syncthreads();
    qkt<DQK, MODE, NQR>(pA0, pA1, K_lds, qr, r32, hi, dq0, sl, qlds, rel0); partialSM(pA0, pA1, m_reg, mnA, alA, C, thr, alibi_off<MODE>(rel0, dq0, sl), MODE == 1 && safe_nomax && rel0 < -31);
    SLOAD(SO, 64); if constexpr (SD == 2) { if (2 < NT) SLOAD(SE, 128); }
    SWRITE(1, SO); __syncthreads();
    for (int j = 1; j + 1 < NT; j += 2) {
        SBAR(); qkt<DQK, MODE, NQR>(pB0, pB1, K_lds + SHM_K, qr, r32, hi, dq0 - 64.f * (float)j, sl, qlds, rel0 - 64 * j);
        finishSM(pA0, pA1, alA, l_reg, pa0, pa1, pa2, pa3); SBAR();
        SLOAD(SO, (j + SD) * 64); SBAR();
        pv_all<DV>(o, vb0, pa0, pa1, pa2, pa3); partialSM(pB0, pB1, m_reg, mnB, alB, C, thr, alibi_off<MODE>(rel0 - 64 * j, dq0 - 64.f * (float)j, sl), MODE == 1 && safe_nomax && rel0 - 64 * j < -31);
        __syncthreads(); SWRITE(0, SE);
        RESC(alB); __syncthreads();
        SBAR(); qkt<DQK, MODE, NQR>(pA0, pA1, K_lds, qr, r32, hi, dq0 - 64.f * (float)(j + 1), sl, qlds, rel0 - 64 * (j + 1));
        finishSM(pB0, pB1, alB, l_reg, pa0, pa1, pa2, pa3); SBAR();
        if (SD == 1 || j + 3 < NT) SLOAD(SE, (j + 1 + SD) * 64); SBAR();
        pv_all<DV>(o, vb0 + SHM_V, pa0, pa1, pa2, pa3); partialSM(pA0, pA1, m_reg, mnA, alA, C, thr, alibi_off<MODE>(rel0 - 64 * (j + 1), dq0 - 64.f * (float)(j + 1), sl), MODE == 1 && safe_nomax && rel0 - 64 * (j + 1) < -31);
        __syncthreads(); SWRITE(1, SO);
        RESC(alA); __syncthreads();
    }
    SBAR(); qkt<DQK, MODE, NQR>(pB0, pB1, K_lds + SHM_K, qr, r32, hi, dq0 - 64.f * (float)(NT - 1), sl, qlds, rel0 - 64 * (NT - 1));
    finishSM(pA0, pA1, alA, l_reg, pa0, pa1, pa2, pa3); SBAR();
    pv_all<DV>(o, vb0, pa0, pa1, pa2, pa3); partialSM(pB0, pB1, m_reg, mnB, alB, C, thr, alibi_off<MODE>(rel0 - 64 * (NT - 1), dq0 - 64.f * (float)(NT - 1), sl), MODE == 1 && safe_nomax && rel0 - 64 * (NT - 1) < -31);
    __syncthreads(); RESC(alB);
    finishSM(pB0, pB1, alB, l_reg, pa0, pa1, pa2, pa3); SBAR();
    pv_all<DV>(o, vb0 + SHM_V, pa0, pa1, pa2, pa3);
    if (MODE == 2) l_reg += __builtin_amdgcn_exp2f(sinkl2 - m_reg * C);
    if (hi == 0) li_l[r32] = l_reg; asm volatile("s_waitcnt lgkmcnt(0)" ::: "memory");
    float rli[16];
#pragma unroll
    for (int r = 0; r < 16; ++r) rli[r] = __builtin_amdgcn_rcpf(li_l[crow(r, hi)]);
    epi(o, rli, wid, r32, hi);
#undef SLOAD
#undef SWRITE
#undef RESC
}

template <int DQK, int DV, int MODE, int LDQ, int LDK, int LDV, class Epi>
__device__ __forceinline__ void attn_body_simple(const bf16_t* __restrict__ Qb, const bf16_t* __restrict__ Kh, const bf16_t* __restrict__ Vh, int kstart, int NT, int qpos0,
                                                 float scale, float slope, float sinkl2, LAS char* lds, const Epi& epi, int wave_) {
    asm volatile("" : "+s"(Qb), "+s"(Kh), "+s"(Vh));
    constexpr int SHM_V = 64 * DV * 2, SHM_K = 64 * DQK * 2, NQ = DQK / 16, NO = DV / 32;
    constexpr int KCH = DQK / 8, NKC = 64 * KCH / 512, VCH = DV / 8, NVC = 64 * VCH / 512;
    int tid = wave_ * 64 + lane_id(); asm volatile("" : "+v"(tid));
    const int wid = tid >> 6, lane = tid & 63, r32 = lane & 31, hi = lane >> 5;
    LAS char* V_lds = lds; LAS char* K_lds = lds + 3 * SHM_V;
    LAS float* wsf = (LAS float*)(lds + 3 * SHM_V + 3 * SHM_K) + wid * 64; LAS float* li_l = wsf; LAS float* al_l = wsf + 32;
    const float C = scale * LOG2E, thr = 8.f / scale, sl = slope / scale;
    const float dq0 = (float)(qpos0 + wid * 32 + r32 - kstart - 4 * hi);
    float m_reg = -1e30f, l_reg = 0; f32x16 o[NO]; bf16x8 qr[NQ];
#pragma unroll
    for (int d = 0; d < NO; ++d) o[d] = f32x16{};
    const GAS bf16_t* Qw = (const GAS bf16_t*)Qb + (size_t)(wid * 32 + r32) * LDQ + hi * 8;
#pragma unroll
    for (int d0 = 0; d0 < NQ; ++d0) qr[d0] = *(const GAS bf16x8*)(Qw + d0 * 16);
    const int vb0 = (int)(unsigned)(size_t)V_lds + v_rd_base(lane);
    bf16x8 sk[NKC], sv[NVC];
    const GAS bf16_t* Kp = (const GAS bf16_t*)Kh + (size_t)kstart * LDK; const GAS bf16_t* Vp = (const GAS bf16_t*)Vh + (size_t)kstart * LDV;
#define S1LOAD(k0) do { _Pragma("unroll") for (int _c = 0; _c < NVC; ++_c) { const int c_ = tid + 512 * _c; sv[_c] = *(const GAS bf16x8*)(Vp + (size_t)((k0) + c_ / VCH) * LDV + (c_ % VCH) * 8); } \
    _Pragma("unroll") for (int _c = 0; _c < NKC; ++_c) { const int c_ = tid + 512 * _c; sk[_c] = *(const GAS bf16x8*)(Kp + (size_t)((k0) + c_ / KCH) * LDK + (c_ % KCH) * 8); } } while (0)
#define S1WRITE(b) do { _Pragma("unroll") for (int _c = 0; _c < NVC; ++_c) { const int c_ = tid + 512 * _c; *(LAS bf16x8*)(V_lds + (b) * SHM_V + v_st<DV>(c_ / VCH, (c_ % VCH) * 8)) = sv[_c]; } \
    _Pragma("unroll") for (int _c = 0; _c < NKC; ++_c) { const int c_ = tid + 512 * _c; *(LAS bf16x8*)(K_lds + (b) * SHM_K + kswz<DQK>(c_ / KCH, (c_ % KCH) * 16)) = sk[_c]; } } while (0)
    __syncthreads();
    S1LOAD(0); S1WRITE(0); S1LOAD(64); S1WRITE(1);
    if (2 < NT) S1LOAD(128);
    int slot = 0;
    for (int j = 0; j < NT; ++j) {
        __syncthreads();
        { const int wslot = slot == 0 ? 2 : slot - 1;
          if (j + 2 < NT) { S1WRITE(wslot); if (j + 3 < NT) S1LOAD((j + 3) * 64); } }
        f32x16 p0, p1; float mn, al; bf16x8 pa0, pa1, pa2, pa3;
        qkt<DQK, MODE>(p0, p1, K_lds + slot * SHM_K, qr, r32, hi, dq0 - 64.f * (float)j, sl);
        partialSM(p0, p1, m_reg, mn, al, C, thr);
        finishSM(p0, p1, al, l_reg, pa0, pa1, pa2, pa3);
        if (__any(al < 1.f)) { if (hi == 0) al_l[r32] = al; asm volatile("s_waitcnt lgkmcnt(0)" ::: "memory");
#pragma unroll
            for (int d = 0; d < NO; ++d)
#pragma unroll
                for (int r = 0; r < 16; ++r) o[d][r] *= al_l[crow(r, hi)]; }
        SBAR();
        pv_all<DV>(o, vb0 + slot * SHM_V, pa0, pa1, pa2, pa3);
        slot = slot == 2 ? 0 : slot + 1;
    }
#undef S1LOAD
#undef S1WRITE
    if (MODE == 2) l_reg += __builtin_amdgcn_exp2f(sinkl2 - m_reg * C);
    if (hi == 0) li_l[r32] = l_reg; asm volatile("s_waitcnt lgkmcnt(0)" ::: "memory");
    float rli[16];
#pragma unroll
    for (int r = 0; r < 16; ++r) rli[r] = __builtin_amdgcn_rcpf(li_l[crow(r, hi)]);
    epi(o, rli, wid, r32, hi);
}

template <int NO> struct EpiStoreBf16 {
    bf16_t* O; int ldo;
    __device__ __forceinline__ void operator()(const f32x16* o, const float* rli, int wid, int r32, int hi) const {
        bf16_t* Ob = O; asm volatile("" : "+s"(Ob));
#pragma unroll
        for (int r = 0; r < 16; ++r) { GAS bf16_t* p = (GAS bf16_t*)Ob + (size_t)(wid * 32 + crow(r, hi)) * ldo + r32;
#pragma unroll
            for (int d0 = 0; d0 < NO; ++d0) p[d0 * 32] = (bf16_t)(cvt_pk_bf16(o[d0][r] * rli[r], 0.f) & 0xffffu); }
    }
};
struct EpiDiff0 {
    float* scr;
    __device__ __forceinline__ void operator()(const f32x16* o, const float* rli, int wid, int r32, int hi) const {
        float* sb = scr; asm volatile("" : "+s"(sb));
        int t_ = wid * 64 + hi * 32 + r32; GAS f32x4* p = (GAS f32x4*)(sb + t_ * 64);
#pragma unroll
        for (int d0 = 0; d0 < 4; ++d0)
#pragma unroll
            for (int q = 0; q < 4; ++q) { f32x4 v;
#pragma unroll
                for (int i = 0; i < 4; ++i) v[i] = o[d0][4 * q + i] * rli[4 * q + i];
                p[d0 * 4 + q] = v; }
    }
};
struct EpiDiff1 {
    const float* scr; bf16_t* O; int ldo; const float* g; float lam, oscale;
    __device__ __forceinline__ void operator()(const f32x16* o, const float* rli, int wid, int r32, int hi) const {
        const float* sb = scr; bf16_t* Ob = O; asm volatile("" : "+s"(sb), "+s"(Ob));
        int t_ = wid * 64 + hi * 32 + r32; const GAS f32x4* p = (const GAS f32x4*)(sb + t_ * 64); float gv[4];
#pragma unroll
        for (int d0 = 0; d0 < 4; ++d0) gv[d0] = g[d0 * 32 + r32] * oscale;
#pragma unroll
        for (int q = 0; q < 4; ++q) { f32x4 t[4];
#pragma unroll
            for (int d0 = 0; d0 < 4; ++d0) t[d0] = p[d0 * 4 + q];
#pragma unroll
            for (int i = 0; i < 4; ++i) { const int r = 4 * q + i; float s = 0.f;
#pragma unroll
                for (int d0 = 0; d0 < 4; ++d0) { t[d0][i] -= lam * (o[d0][r] * rli[r]); s += t[d0][i] * t[d0][i]; }
                s += shfl_xor_f(s, 1); s += shfl_xor_f(s, 2); s += shfl_xor_f(s, 4); s += shfl_xor_f(s, 8); s += shfl_xor_f(s, 16);
                const float rn = fast_rsq(s * (1.f / 128.f) + EPS);
                GAS bf16_t* qp = (GAS bf16_t*)Ob + (size_t)(wid * 32 + crow(r, hi)) * ldo + r32;
#pragma unroll
                for (int d0 = 0; d0 < 4; ++d0) qp[d0 * 32] = (bf16_t)(cvt_pk_bf16(t[d0][i] * rn * gv[d0], 0.f) & 0xffffu); }
            asm volatile("" ::: "memory"); }
    }
};
}

__device__ __forceinline__ float wave_sum(float v) {
#pragma unroll
    for (int o = 1; o < 64; o <<= 1) v += shfl_xor_f(v, o);
    return v;
}
template <int MODE> __device__ __forceinline__ int src_col(int n) {
    if (MODE == 1) { const int t = n >> 8, j = n & 255; return j < 128 ? t * 128 + j : FF + t * 128 + (j - 128); }
    if (MODE == 2) { if (n < Z_CKR) return n; if (n < 3008) { const int e = n - Z_CKR; return Z_CKR + (e >> 1) + 32 * (e & 1); } return -1; }
    if (MODE == 3) { const int h = n / 192, e = n - h * 192; if (e < 128) return n; const int e2 = e - 128; return h * 192 + 128 + (e2 >> 1) + 32 * (e2 & 1); }
    return n;
}
template <int MODE> __device__ __forceinline__ void tr_item(const float* __restrict__ W, int K, int Nsrc, const float* __restrict__ gain, bf16_t* WT, int nblk, LAS float* scr, int item, int lane) {
    const int kb = item / nblk, nb = item - kb * nblk, k0 = 64 * kb, n0 = 32 * nb;
    const int sc0 = src_col<MODE>(n0), sc31 = src_col<MODE>(n0 + 31);
    if (sc0 >= 0 && sc31 == sc0 + 31 && (sc0 & 3) == 0) {
        const int row8 = lane >> 3, n4 = (lane & 7) * 4;
#pragma unroll
        for (int i = 0; i < 8; ++i) { const int kk = 8 * i + row8; f32x4 v = *(const f32x4*)(W + (size_t)(k0 + kk) * Nsrc + sc0 + n4);
            if (gain) v = v * gain[k0 + kk];
            LAS float* d = scr + kk * 33 + n4; d[0] = v[0]; d[1] = v[1]; d[2] = v[2]; d[3] = v[3]; }
    } else {
        const int sc = src_col<MODE>(n0 + (lane & 31));
#pragma unroll
        for (int i = 0; i < 32; ++i) { const int kk = 2 * i + (lane >> 5); float v = 0.f;
            if (sc >= 0) { v = W[(size_t)(k0 + kk) * Nsrc + sc]; if (gain) v *= gain[k0 + kk]; }
            scr[kk * 33 + (lane & 31)] = v; }
    }
    asm volatile("s_waitcnt lgkmcnt(0)" ::: "memory");
    const int c = lane & 7;
#pragma unroll
    for (int j = 0; j < 4; ++j) { const int n = (lane >> 3) + 8 * j; const LAS float* s = scr + (8 * c) * 33 + n;
        u32x4 o; o.x = cvt_pk_bf16(s[0 * 33], s[1 * 33]); o.y = cvt_pk_bf16(s[2 * 33], s[3 * 33]); o.z = cvt_pk_bf16(s[4 * 33], s[5 * 33]); o.w = cvt_pk_bf16(s[6 * 33], s[7 * 33]);
        *(u32x4*)(WT + (size_t)(n0 + n) * K + k0 + 8 * c) = o; }
    asm volatile("s_waitcnt lgkmcnt(0)" ::: "memory");
}

struct Args { const float* in[21]; float* out; unsigned char* ws; int ph_lo, ph_hi; };
enum { I_X = 0, I_F1N, I_F1W13, I_F1W2, I_MIXN, I_WIN, I_WGATE, I_BGATE, I_ALAM, I_ASUB, I_BSINK, I_CQN, I_CWUQ, I_CKVN, I_CWUKV, I_WBR, I_WOUT, I_F2N, I_F2W13, I_F2W2, I_FINN };

constexpr int LDS_BYTES = 155648;

struct TrDesc { const float* W; const float* gain; bf16_t* WT; int K, Nsrc, nblk, mode, r; };
__device__ __forceinline__ int src_col_rt(int mode, int n) { return mode == 1 ? src_col<1>(n) : mode == 2 ? src_col<2>(n) : mode == 3 ? src_col<3>(n) : n; }
__device__ __forceinline__ bool tr_decode(const Args& a, int l, unsigned char* ws, int it, TrDesc& d) {
    constexpr int I_W13 = (DM / 64) * (2 * FF / 32), I_W2 = (FF / 64) * (DM / 32), I_IN = (DM / 64) * (3072 / 32), I_GT = I_IN,
                  I_UQ = (384 / 64) * (768 / 32), I_UKV = (256 / 64) * (1024 / 32), I_BR = (512 / 64) * (1024 / 32), I_OUT = (DM / 64) * (DM / 32);
    constexpr int NITEMS = 2 * I_W13 + 2 * I_W2 + I_IN + I_GT + I_UQ + I_UKV + 3 * I_BR + I_OUT;
    if (it >= NITEMS) return false;
    int r = it;
#define TR_SET(W_, K_, NS_, G_, WT_, NB_, M_) do { d.W = (W_); d.K = (K_); d.Nsrc = (NS_); d.gain = (G_); d.WT = (WT_); d.nblk = (NB_); d.mode = (M_); d.r = r; return true; } while (0)
    if (r < I_W13) TR_SET(a.in[I_F1W13] + (size_t)l * DM * 2 * FF, DM, 2 * FF, a.in[I_F1N] + l * DM, (bf16_t*)(ws + WS_W13A), 2 * FF / 32, 1); r -= I_W13;
    if (r < I_W13) TR_SET(a.in[I_F2W13] + (size_t)l * DM * 2 * FF, DM, 2 * FF, a.in[I_F2N] + l * DM, (bf16_t*)(ws + WS_W13B), 2 * FF / 32, 1); r -= I_W13;
    if (r < I_W2) TR_SET(a.in[I_F1W2] + (size_t)l * FF * DM, FF, DM, nullptr, (bf16_t*)(ws + WS_W2A), DM / 32, 0); r -= I_W2;
    if (r < I_W2) TR_SET(a.in[I_F2W2] + (size_t)l * FF * DM, FF, DM, nullptr, (bf16_t*)(ws + WS_W2B), DM / 32, 0); r -= I_W2;
    if (r < I_IN) TR_SET(a.in[I_WIN] + (size_t)l * DM * 3008, DM, 3008, a.in[I_MIXN] + l * DM, (bf16_t*)(ws + WS_WIG), 3072 / 32, 2); r -= I_IN;
    if (r < I_GT) TR_SET(a.in[I_WGATE] + (size_t)l * DM * 3072, DM, 3072, a.in[I_MIXN] + l * DM, (bf16_t*)(ws + WS_WIG) + (size_t)3072 * DM, 3072 / 32, 0); r -= I_GT;
    if (r < I_UQ) TR_SET(a.in[I_CWUQ] + (size_t)l * 384 * 768, 384, 768, a.in[I_CQN] + l * 384, (bf16_t*)(ws + WS_WUQ), 768 / 32, 3); r -= I_UQ;
    if (r < I_UKV) TR_SET(a.in[I_CWUKV] + (size_t)l * 256 * 1024, 256, 1024, a.in[I_CKVN] + l * 256, (bf16_t*)(ws + WS_WUKV), 1024 / 32, 0); r -= I_UKV;
    if (r < 3 * I_BR) { const int n = r / I_BR; r -= n * I_BR; TR_SET(a.in[I_WBR] + ((size_t)l * 3 + n) * 512 * 1024, 512, 1024, nullptr, (bf16_t*)(ws + WS_WB) + (size_t)n * 1024 * 512, 1024 / 32, 0); } r -= 3 * I_BR;
    TR_SET(a.in[I_WOUT] + (size_t)l * DM * DM, DM, DM, nullptr, (bf16_t*)(ws + WS_WO), DM / 32, 0);
#undef TR_SET
}
__device__ __forceinline__ bool tr_load(const TrDesc& d, int lane, f32x4 (&v)[8]) {
    const int kb = d.r / d.nblk, nb = d.r - kb * d.nblk, k0 = 64 * kb, n0 = 32 * nb;
    const int sc0 = src_col_rt(d.mode, n0), sc31 = src_col_rt(d.mode, n0 + 31);
    const bool vec = sc0 >= 0 && sc31 == sc0 + 31 && (sc0 & 3) == 0;
    if (vec) { const int row8 = lane >> 3, n4 = (lane & 7) * 4;
#pragma unroll
        for (int i = 0; i < 8; ++i) { const int kk = 8 * i + row8; v[i] = *(const f32x4*)(d.W + (size_t)(k0 + kk) * d.Nsrc + sc0 + n4); } }
    return vec;
}
__device__ __forceinline__ void tr_finish(const TrDesc& d, bool vec, int lane, const f32x4 (&v)[8], LAS float* scr) {
    const int kb = d.r / d.nblk, nb = d.r - kb * d.nblk, k0 = 64 * kb, n0 = 32 * nb;
    if (vec) { const int row8 = lane >> 3, n4 = (lane & 7) * 4;
#pragma unroll
        for (int i = 0; i < 8; ++i) { const int kk = 8 * i + row8; const f32x4 x = d.gain ? v[i] * d.gain[k0 + kk] : v[i]; LAS float* p = scr + kk * 33 + n4; p[0] = x[0]; p[1] = x[1]; p[2] = x[2]; p[3] = x[3]; }
    } else { const int sc = src_col_rt(d.mode, n0 + (lane & 31));
#pragma unroll 8
        for (int i = 0; i < 32; ++i) { const int kk = 2 * i + (lane >> 5); float x = 0.f;
            if (sc >= 0) { x = d.W[(size_t)(k0 + kk) * d.Nsrc + sc]; if (d.gain) x *= d.gain[k0 + kk]; }
            scr[kk * 33 + (lane & 31)] = x; } }
    asm volatile("s_waitcnt lgkmcnt(0)" ::: "memory");
    const int c = lane & 7;
#pragma unroll
    for (int j = 0; j < 4; ++j) { const int n = (lane >> 3) + 8 * j; const LAS float* s = scr + (8 * c) * 33 + n;
        u32x4 o; o.x = cvt_pk_bf16(s[0 * 33], s[1 * 33]); o.y = cvt_pk_bf16(s[2 * 33], s[3 * 33]); o.z = cvt_pk_bf16(s[4 * 33], s[5 * 33]); o.w = cvt_pk_bf16(s[6 * 33], s[7 * 33]);
        *(u32x4*)(d.WT + (size_t)(n0 + n) * d.K + k0 + 8 * c) = o; }
    asm volatile("s_waitcnt lgkmcnt(0)" ::: "memory");
}
__device__ __forceinline__ void convert_layer(const Args& a, int l, LAS unsigned char* lds, int gw, int NGW, int wave, int mask = 0) {
    constexpr int I_W13 = (DM / 64) * (2 * FF / 32), I_W2 = (FF / 64) * (DM / 32), I_IN = (DM / 64) * (3072 / 32),
                  I_UQ = (384 / 64) * (768 / 32), I_UKV = (256 / 64) * (1024 / 32), I_BR = (512 / 64) * (1024 / 32), I_OUT = (DM / 64) * (DM / 32);
    constexpr int NITEMS = 2 * I_W13 + 2 * I_W2 + 2 * I_IN + I_UQ + I_UKV + 3 * I_BR + I_OUT, OFF_W2B = 2 * I_W13 + I_W2;
    int lane = lane_id(); asm volatile("" : "+v"(lane));
    LAS float* scr0 = (LAS float*)(lds + wave * 17408); LAS float* scr1 = scr0 + 64 * 33 + 32;
    unsigned char* ws = a.ws; asm volatile("" : "+s"(ws));
    const int limit = mask == 0 ? NITEMS : mask == 1 ? NITEMS - I_W2 : I_W2;
#define CV_MAP(i_) (mask == 0 ? (i_) : mask == 1 ? ((i_) >= OFF_W2B ? (i_) + I_W2 : (i_)) : OFF_W2B + (i_))
    for (int it = gw; it < limit; it += 2 * NGW) {
        TrDesc d0, d1; f32x4 v0[8], v1[8];
        if (!tr_decode(a, l, ws, CV_MAP(it), d0)) break;
        const bool has1 = (it + NGW < limit) && tr_decode(a, l, ws, CV_MAP(it + NGW), d1);
        const bool vec0 = tr_load(d0, lane, v0);
        bool vec1 = false; if (has1) vec1 = tr_load(d1, lane, v1);
        tr_finish(d0, vec0, lane, v0, scr0);
        if (has1) tr_finish(d1, vec1, lane, v1, scr1);
    }
#undef CV_MAP
}

#define XB_TMO      128
#define XB_XCNT(j)  (256  + 64 * (j))
#define XB_XSUB(j)  (1280 + 64 * (j))
#define XB_XGEN(j)  (2304 + 64 * (j))
#define XB_TOP      3328
#define XB_TOPGEN   3392
#define XCD_BAR_WORDS 3456
#define XB_SPIN_CAP (1u << 18)

__device__ __forceinline__ unsigned xb_ld(unsigned* p)              { return __hip_atomic_load(p, __ATOMIC_RELAXED, __HIP_MEMORY_SCOPE_AGENT); }
__device__ __forceinline__ unsigned xb_add(unsigned* p, unsigned v) { return __hip_atomic_fetch_add(p, v, __ATOMIC_RELAXED, __HIP_MEMORY_SCOPE_AGENT); }
__device__ __forceinline__ unsigned xb_xcc_id() { return (unsigned)__builtin_amdgcn_s_getreg((3 << 11) | 20) & 0xFu; }
#define XB_SPIN(cond, bar) do { unsigned _sp = 0; while (cond) { __builtin_amdgcn_s_sleep(1); \
    if ((++_sp & 255u) == 0u) { if (xb_ld(&(bar)[XB_TMO])) break; if (_sp > XB_SPIN_CAP) { atomicAdd(&(bar)[XB_TMO], 1u); break; } } } } while (0)

struct XcdBarrier {
    unsigned* bar; unsigned x;
    volatile LAS unsigned* st;
};

__device__ __forceinline__ XcdBarrier xcd_barrier_post(unsigned* bar, volatile LAS unsigned* st) {
    XcdBarrier b; b.bar = bar; b.x = xb_xcc_id(); b.st = st;
    if (threadIdx.x == 0) (void)xb_add(&bar[XB_XCNT(b.x)], 1u);
    return b;
}
__device__ __forceinline__ void xcd_barrier_complete(unsigned* bar, unsigned x, unsigned& nloc, unsigned& nx) {
    const unsigned G = gridDim.x * gridDim.y * gridDim.z;
    unsigned sum, cnt, mine, sp = 0u;
    for (;;) {
        sum = 0u; cnt = 0u; mine = 0u;
#pragma unroll
        for (unsigned j = 0; j < 16; ++j) { const unsigned c = xb_ld(&bar[XB_XCNT(j)]); sum += c; cnt += (c > 0u) ? 1u : 0u; mine = (j == x) ? c : mine; }
        if (sum == G) break;
        __builtin_amdgcn_s_sleep(1);
        if ((++sp & 255u) == 0u) { if (xb_ld(&bar[XB_TMO])) break; if (sp > XB_SPIN_CAP) { atomicAdd(&bar[XB_TMO], 1u); break; } }
    }
    nloc = mine > 0u ? mine : 1u; nx = cnt > 0u ? cnt : 1u;
}

__device__ __forceinline__ void xcd_barrier(const XcdBarrier& b0_) {
    XcdBarrier b; b.bar = b0_.bar; b.st = b0_.st; b.x = xb_xcc_id(); { unsigned* bb = b.bar; asm volatile("" : "+s"(bb)); b.bar = bb; }
    asm volatile("s_waitcnt vmcnt(0)" ::: "memory");
    __syncthreads();
    if (threadIdx.x == 0) {
        unsigned* bar = b.bar;
        __builtin_amdgcn_s_waitcnt(0);
        unsigned nloc = b.st[0], nx = b.st[1];
        if (nloc == 0u) { xcd_barrier_complete(bar, b.x, nloc, nx); b.st[0] = nloc; b.st[1] = nx; }
        const unsigned old = xb_add(&bar[XB_XSUB(b.x)], 1u);
        const unsigned gen = old / nloc;
        if (old + 1u == (gen + 1u) * nloc) {
            __builtin_amdgcn_fence(__ATOMIC_RELEASE, "agent");
            asm volatile("s_waitcnt vmcnt(0)" ::: "memory");
            const unsigned og = xb_add(&bar[XB_TOP], 1u);
            const unsigned tg = og / nx;
            if (og + 1u == (tg + 1u) * nx) xb_add(&bar[XB_TOPGEN], 1u);
            else XB_SPIN(xb_ld(&bar[XB_TOPGEN]) == tg, bar);
            __builtin_amdgcn_fence(__ATOMIC_ACQUIRE, "agent");
            xb_add(&bar[XB_XGEN(b.x)], 1u);
            asm volatile("s_waitcnt vmcnt(0)" ::: "memory");
        } else {
            XB_SPIN(xb_ld(&bar[XB_XGEN(b.x)]) == gen, bar);
            __builtin_amdgcn_fence(__ATOMIC_ACQUIRE, "agent");
            asm volatile("s_waitcnt vmcnt(0)" ::: "memory");
        }
    }
    __syncthreads();
}


__global__ void __launch_bounds__(512) fwd_megakernel(Args a) {
    extern __shared__ __attribute__((aligned(16))) unsigned char lds_raw[];
    LAS unsigned char* lds = (LAS unsigned char*)lds_raw;
    cg::grid_group grid = cg::this_grid();
#define GSYNC() xcd_barrier(xbar)
    const int wave = __builtin_amdgcn_readfirstlane(threadIdx.x >> 6);
    const int G = gridDim.x, bx = blockIdx.x;
    volatile LAS unsigned* xst = (volatile LAS unsigned*)(lds + LDS_BYTES - 64);
    if (threadIdx.x < 2) xst[threadIdx.x] = 0u;
    __syncthreads();
    grid.sync();
    XcdBarrier xbar = xcd_barrier_post((unsigned*)(a.ws + WS_BAR), xst);
    const int vcu = (G % 8 == 0) ? (bx % 8) * (G / 8) + bx / 8 : bx;
    const int gw = vcu * 8 + wave, NGW = G * 8;
    unsigned char* ws = a.ws;
    float* X = a.out;
    bf16_t* XB = (bf16_t*)(ws + WS_XB); float* SSQ = (float*)(ws + WS_SSQ); float* SSQZ = (float*)(ws + WS_SSQZ);
    float* ROPEC = (float*)(ws + WS_ROPE); float* ROPES = ROPEC + SEQ * 32;
    bf16_t* Z = (bf16_t*)(ws + WS_R0); bf16_t* H = (bf16_t*)(ws + WS_R0); float* MG = (float*)(ws + WS_R0); bf16_t* MB = (bf16_t*)(ws + WS_R0 + 64 * MiB);
    bf16_t* GT = (bf16_t*)(ws + WS_G); bf16_t* QC = (bf16_t*)(ws + WS_QC); bf16_t* KC = (bf16_t*)(ws + WS_KC); bf16_t* VC = (bf16_t*)(ws + WS_VC);
    bf16_t* O3 = (bf16_t*)(ws + WS_O3); float* SCR = (float*)(ws + WS_SCR) + (size_t)bx * (512 * 64);

    {
        const float* xin = a.in[I_X]; const int lane = lane_id();
        for (int m = gw; m < M_TOK; m += NGW) {
            const f32x4* xr = (const f32x4*)(xin + (size_t)m * DM) + lane; u32x2* bo = (u32x2*)(XB + (size_t)m * DM) + lane;
            float s = 0.f;
#pragma unroll
            for (int j = 0; j < 4; ++j) { const f32x4 v = xr[64 * j]; s += dot4(v); u32x2 w; w.x = cvt_pk_bf16(v[0], v[1]); w.y = cvt_pk_bf16(v[2], v[3]); bo[64 * j] = w; }
            s = wave_sum(s);
            if (lane < 16) SSQ[(size_t)m * 16 + lane] = lane == 0 ? s : 0.f;
        }
        for (int i = gw * 64 + lane; i < SEQ * 32; i += NGW * 64) {
            const int pos = i >> 5, j = i & 31;
            const float inv_freq = (float)exp2(-(double)(2 * j) / 64.0 * 13.287712379549449);
            const float ang = (float)pos * inv_freq;
            const double rev = (double)ang * 0.15915494309189535; const float f = (float)(rev - floor(rev));
            ROPEC[i] = __builtin_amdgcn_cosf(f); ROPES[i] = __builtin_amdgcn_sinf(f);
        }
#ifndef NO_CONV
        convert_layer(a, 0, lds, gw, NGW, wave);
#endif
    }
    GSYNC();

    for (int l = 0; l < DEPTH; ++l) {
        for (int half = 0; half < 2; ++half) {
#ifndef NO_FFNUP
            { pg8::Gemm g{XB, (const bf16_t*)(ws + (half ? WS_W13B : WS_W13A)), M_TOK, 2 * FF, DM, DM, 31, 0}; pg8::StaticOrder S; S.init(M_TOK, 2 * FF, G, bx);
              EpiSwiGLU E{H, SSQ}; pg8::gemm_phase(lds, g, S, E, wave); }
#endif
            GSYNC();
#ifndef NO_FFNDN
            { pg8::Gemm g{H, (const bf16_t*)(ws + (half ? WS_W2B : WS_W2A)), M_TOK, DM, FF, FF, 31, 0}; pg8::StaticOrder S; S.init(M_TOK, DM, G, bx);
              EpiResid E{(l == 0 && half == 0) ? a.in[I_X] : (const float*)X, X, XB, SSQ, 0.5f};   pg8::gemm_phase(lds, g, S, E, wave); }
#endif
            if (half == 1) { if (l + 1 < DEPTH) convert_layer(a, l + 1, lds, gw, NGW, wave, 1); }
            else if (l > 0) convert_layer(a, l, lds, gw, NGW, wave, 2);
            GSYNC();
            if (half == 1) break;
#ifndef NO_INPROJ
            { pg8::Gemm g{XB, (const bf16_t*)(ws + WS_WIG), M_TOK, 6144, DM, DM, 31, 0}; pg8::StaticOrder S; S.init(M_TOK, 6144, G, bx);
              EpiInProj E{Z, GT, KC, SSQ, SSQZ, a.in[I_BGATE] + l * 3072, ROPEC, ROPES}; pg8::gemm_phase(lds, g, S, E, wave); }
#endif
            GSYNC();
#ifndef NO_UQ
            { pg8::Gemm g{Z + Z_CQ, (const bf16_t*)(ws + WS_WUQ), M_TOK, 768, 384, ZC, 31, 0}; pg8::StaticOrder S; S.init(M_TOK, 768, G, bx);
              EpiUQ E{QC, SSQZ, ROPEC, ROPES}; pg8::gemm_phase(lds, g, S, E, wave); }
#endif
#ifndef NO_UKV
            { pg8::Gemm g{Z + Z_CKV, (const bf16_t*)(ws + WS_WUKV), M_TOK, 1024, 256, ZC, 31, 0}; pg8::StaticOrder S; S.init(M_TOK, 1024, G, G - 1 - bx);
              EpiUKV E{KC, VC, SSQZ}; pg8::gemm_phase(lds, g, S, E, wave); }
#endif
            { unsigned* NRM = (unsigned*)(ws + WS_BAR + 32768) + l * 32; const int lane = lane_id(); float mx0 = 0.f, mx1 = 0.f;
#pragma unroll 4
              for (int m = gw; m < M_TOK; m += NGW) { const u32x4* zp = (const u32x4*)(Z + (size_t)m * ZC + lane * 16); const u32x4 w0 = zp[0], w1 = zp[1]; float sq = 0.f;
#pragma unroll
                  for (int i = 0; i < 4; ++i) { const float a0 = bf16_lo(w0[i]), a1 = bf16_hi(w0[i]), b0 = bf16_lo(w1[i]), b1 = bf16_hi(w1[i]); sq += (a0 * a0 + a1 * a1) + (b0 * b0 + b1 * b1); }
                  sq += shfl_xor_f(sq, 1); sq += shfl_xor_f(sq, 2);
                  if (m < SEQ) mx0 = fmaxf(mx0, sq); else mx1 = fmaxf(mx1, sq); }
              if ((lane & 3) == 0) { __hip_atomic_fetch_max(NRM + (lane >> 2), __float_as_uint(mx0), __ATOMIC_RELAXED, __HIP_MEMORY_SCOPE_AGENT);
                                     __hip_atomic_fetch_max(NRM + 16 + (lane >> 2), __float_as_uint(mx1), __ATOMIC_RELAXED, __HIP_MEMORY_SCOPE_AGENT); } }
            GSYNC();
            {
                LAS char* al = (LAS char*)lds;
                const int nslot = (G == 256) ? 6 : (1024 + G - 1) / G;
                for (int k_ = 0; k_ < nslot; ++k_) {
                    int L;
                    if (G == 256) {
                        if (vcu < 128) L = k_ < 2 ? 2 * vcu + k_ : k_ < 4 ? 512 + 2 * vcu + (k_ - 2) : (k_ == 4 && (vcu & 1)) ? 512 + 256 + (vcu >> 1) : -1;
                        else { const int u = (vcu - 128) & 63, hi_ = vcu >= 192, hh = k_ == 0 ? (hi_ ? 2 : 3) : (hi_ ? 1 : 0);
                               L = k_ < 2 ? 256 + (((u >> 5) * 4 + hh) << 5) + (u & 31) : hi_ ? (k_ < 4 ? 512 + 384 + 2 * u + (k_ - 2) : -1) : (k_ == 2 ? 512 + 320 + u : -1); }
                    } else { L = vcu + k_ * G; if (L >= 1024) L = -1; }
                    if (L < 0) continue;
                    if (L < 256) {
#ifndef NO_C
                        const int bh = L >> 5, qb = L & 31, b = bh >> 2, h = bh & 3; const size_t r0 = (size_t)b * SEQ + qb * 256;
                        att::EpiStoreBf16<4> E{O3 + r0 * 1536 + 1024 + h * 128, 1536};
                        att::attn_body_simple<192, 128, 0, 768, 768, 512>(QC + r0 * 768 + h * 192, KC + (size_t)b * SEQ * 768 + h * 192, VC + (size_t)b * SEQ * 512 + h * 128,
                                                                     0, SEQ / 64, qb * 256, 0.07216878364870322f, 0.f, 0.f, al, E, wave);
#endif
                    } else if (L < 512) {
#ifndef NO_A
                        const int u = L - 256, bh = u >> 5, qb = u & 31, b = bh >> 2, h = bh & 3; const size_t r0 = (size_t)b * SEQ + qb * 256;
                        int li = l; asm volatile("" : "+s"(li));
                        const float lam_init = __uint_as_float(li == 0 ? 0x3e4ccccdu : li == 1 ? 0x3eb60549u : li == 2 ? 0x3ef1014cu : 0x3f0e59d5u);
                        const float* lp = a.in[I_ALAM] + l * 256; const int lane = lane_id();
                        const float s01 = wave_sum(lp[lane] * lp[64 + lane]), s23 = wave_sum(lp[128 + lane] * lp[192 + lane]);
                        const float lam = uni(expf(s01) - expf(s23) + lam_init);
                        const float slope = uni(exp2f(-2.f * (float)(h + 1)));
                        const bf16_t* zb = Z + (size_t)b * SEQ * ZC;
                        int ks0, nt0, ks1, nt1, sf0 = 0, sf1 = 0;
                        { const unsigned* NRM = (const unsigned*)(ws + WS_BAR + 32768) + l * 32 + b * 16;
#pragma unroll
                          for (int mp = 0; mp < 2; ++mp) {
                              const float q2 = __uint_as_float(__hip_atomic_load(NRM + h * 2 + mp, __ATOMIC_RELAXED, __HIP_MEMORY_SCOPE_AGENT)), k2 = __uint_as_float(__hip_atomic_load(NRM + 8 + h * 2 + mp, __ATOMIC_RELAXED, __HIP_MEMORY_SCOPE_AGENT));
                              const float dmax = uni((2.f * 0.125f * sqrtf(q2 * k2) * 1.01f + 32.f) / slope);
                              const float lo_f = (float)(qb * 256) - dmax, hi_f = (float)(qb * 256 + 256) + dmax;
                              const int lo_i = lo_f <= 0.f ? 0 : ((int)lo_f >> 7) << 7; const int hi_i = hi_f >= (float)SEQ ? SEQ : ((((int)hi_f + 127) >> 7) << 7);
                              const int hi_c = hi_i > SEQ ? SEQ : hi_i;
                              const int sf = (2.f * 0.125f * sqrtf(q2 * k2) * 1.01f + 8.f) < 70.f;
                              if (mp == 0) { ks0 = lo_i; nt0 = (hi_c - lo_i) >> 6; sf0 = sf; } else { ks1 = lo_i; nt1 = (hi_c - lo_i) >> 6; sf1 = sf; } } }
                        { att::EpiDiff0 E{SCR};
                          ATT_A_BODY(Z + r0 * ZC + Z_AQ + h * 128, zb + Z_AK + h * 128, zb + Z_AV + h * 128, ks0, nt0, qb * 256, 0.125f, slope, 0.f, al, E, wave, sf0); }
                        { att::EpiDiff1 E{SCR, O3 + r0 * 1536 + h * 128, 1536, a.in[I_ASUB] + l * 128, lam, 1.f - lam_init};
                          ATT_A_BODY(Z + r0 * ZC + Z_AQ + h * 128 + 64, zb + Z_AK + h * 128 + 64, zb + Z_AV + h * 128, ks1, nt1, qb * 256, 0.125f, slope, 0.f, al, E, wave, sf1); }
#endif
                    } else {
#ifndef NO_B
                        const int u = L - 512, bh = u >> 5, qb = u & 31, b = bh >> 3, hq = bh & 7; const size_t r0 = (size_t)b * SEQ + qb * 256;
                        const int ks = qb * 256 - 128 < 0 ? 0 : qb * 256 - 128, ke = qb * 256 + 384 > SEQ ? SEQ : qb * 256 + 384;
                        const float slope = uni(exp2f(-(float)(hq + 1))); const float sink = uni(a.in[I_BSINK][l * 8 + hq]);
                        const bf16_t* zb = Z + (size_t)b * SEQ * ZC;
                        att::EpiStoreBf16<2> E{O3 + r0 * 1536 + 512 + hq * 64, 1536};
                        att::attn_body<64, 64, 2, 2, ZC, ZC, ZC>(Z + r0 * ZC + Z_BQ + hq * 64, zb + Z_BK + (hq >> 2) * 64, zb + Z_BV + (hq >> 2) * 64, ks, (ke - ks) / 64, qb * 256, 0.125f, slope, sink * LOG2E, al, E, wave);
#endif
                    }
                }
                __syncthreads();
            }
            GSYNC();
#ifndef NO_BR
            { pg8::Gemm g{O3, (const bf16_t*)(ws + WS_WB), M_TOK, 3072, 512, 1536, 2, 1024}; pg8::BranchOrder S; S.init(G, bx);
              EpiGateAcc E{GT, MG, MB}; pg8::gemm_phase(lds, g, S, E, wave); }
#endif
            GSYNC();
#ifndef NO_WOUT
            { pg8::Gemm g{MB, (const bf16_t*)(ws + WS_WO), M_TOK, DM, DM, DM, 31, 0}; pg8::StaticOrder S; S.init(M_TOK, DM, G, bx);
              EpiResid E{X, X, XB, SSQ, 1.0f}; pg8::gemm_phase(lds, g, S, E, wave); }
#endif
            GSYNC();
        }
    }
    {
        const float* fg = a.in[I_FINN]; const int lane = lane_id();
        for (int m = gw; m < M_TOK; m += NGW) {
            const float r = rinv_sum(SSQ + (size_t)m * 16, 4, 1.f / DM);
            f32x4* xo = (f32x4*)(X + (size_t)m * DM) + lane; const f32x4* gp = (const f32x4*)fg + lane;
#pragma unroll
            for (int j = 0; j < 4; ++j) { f32x4 v = xo[64 * j]; v = v * r * gp[64 * j]; xo[64 * j] = v; }
        }
    }
}

extern "C" void kernel_launch(void* const* d_in, const int* in_sizes, int n_in, void* d_out, int out_size, void* d_ws, size_t ws_size, hipStream_t stream) {
    static int grid = 0;
    if (grid == 0) {
        if (n_in != 21 || in_sizes[0] != M_TOK * DM || out_size != M_TOK * DM || ws_size < WS_END) {
            fprintf(stderr, "kernel_launch: shape/workspace mismatch (n_in %d, in0 %d, out %d, ws %zu, need %zu)\n", n_in, n_in > 0 ? in_sizes[0] : -1, out_size, ws_size, (size_t)WS_END); grid = -1; return; }
        int dev = 0, cus = 0, per_cu = 0;
        hipGetDevice(&dev); hipDeviceGetAttribute(&cus, hipDeviceAttributeMultiprocessorCount, dev);
        if (hipFuncSetAttribute((const void*)fwd_megakernel, hipFuncAttributeMaxDynamicSharedMemorySize, LDS_BYTES) != hipSuccess) { fprintf(stderr, "kernel_launch: hipFuncSetAttribute failed\n"); grid = -1; return; }
        if (hipOccupancyMaxActiveBlocksPerMultiprocessor(&per_cu, (const void*)fwd_megakernel, 512, LDS_BYTES) != hipSuccess || per_cu < 1) { fprintf(stderr, "kernel_launch: occupancy query failed (%d)\n", per_cu); per_cu = 1; }
        (void)hipGetLastError();
        grid = cus;
    }
    if (grid < 0) return;
    if (hipMemsetAsync((char*)d_ws + WS_BAR, 0, BAR_BYTES, stream) != hipSuccess) { fprintf(stderr, "kernel_launch: memset failed\n"); return; }
    Args a{};
    for (int i = 0; i < 21; ++i) a.in[i] = (const float*)d_in[i];
    a.out = (float*)d_out; a.ws = (unsigned char*)d_ws; a.ph_lo = 0; a.ph_hi = 0;
    void* args[] = {&a};
    hipError_t e = hipLaunchCooperativeKernel((const void*)fwd_megakernel, dim3(grid), dim3(512), args, LDS_BYTES, stream);
    if (e != hipSuccess) fprintf(stderr, "cooperative launch failed: %s (grid %d)\n", hipGetErrorString(e), grid);
}
```
